# Optimizing an MI355X kernel written in HIP

```python
import jax, jax.numpy as jnp
from jax import lax
import numpy as np

D_MODEL = 1024
BATCH = 8
SEQ = 4096
DEPTH = 2

CHUNK = 64
HEAD_DIM = 64
D_MIX = D_MODEL
A_WIDTH = D_MIX // 4
R_WIDTH = 3 * D_MIX // 8
F_WIDTH = 3 * D_MIX // 8
A_GROUPS = A_WIDTH // HEAD_DIM
R_HEADS = R_WIDTH // HEAD_DIM
F_HEADS = F_WIDTH // HEAD_DIM
A_BLOCK = 128
Q_BLOCK = 128
ROPE_THETA = 10000.0
EPS = 1e-6

A_COLS = 3 * A_WIDTH
R_COLS = 4 * R_WIDTH
F_COLS = 4 * F_WIDTH + F_HEADS
D_IN = A_COLS + R_COLS + F_COLS

kernel_name = "hybrid_gmlp_retention_fox_block"


def _rms_norm(x, gain):
    xf = x.astype(jnp.float32)
    y = xf * lax.rsqrt(jnp.mean(xf * xf, axis=-1, keepdims=True) + EPS)
    return (y * gain.astype(jnp.float32)).astype(x.dtype)


def _layer_norm(x, gain=None):
    xf = x.astype(jnp.float32)
    mu = jnp.mean(xf, axis=-1, keepdims=True)
    var = jnp.mean(jnp.square(xf - mu), axis=-1, keepdims=True)
    y = (xf - mu) * lax.rsqrt(var + EPS)
    if gain is not None:
        y = y * gain.astype(jnp.float32)
    return y.astype(x.dtype)


def _rope(x):
    s, d = x.shape[1], x.shape[3]
    half = d // 2
    inv = ROPE_THETA ** (-jnp.arange(half, dtype=jnp.float32) / half)
    ang = jnp.arange(s, dtype=jnp.float32)[:, None] * inv[None, :]
    cos = jnp.cos(ang)[:, None, :].astype(x.dtype)
    sin = jnp.sin(ang)[:, None, :].astype(x.dtype)
    x1, x2 = x[..., :half], x[..., half:]
    return jnp.concatenate([x1 * cos - x2 * sin, x1 * sin + x2 * cos], axis=-1)


def _spatial_gating(u, v, ln_gain, w_s, b_s):
    b, s, _ = v.shape
    v = _layer_norm(v.reshape(b, s, A_GROUPS, HEAD_DIM), ln_gain)
    v = v.reshape(b, s // A_BLOCK, A_BLOCK, A_GROUPS, HEAD_DIM)
    pos = jnp.arange(A_BLOCK)
    allowed = (pos[None, :] // CHUNK) <= (pos[:, None] // CHUNK)
    w = jnp.where(allowed[None], w_s, jnp.zeros_like(w_s))
    mixed = jnp.einsum('gij,bnjgc->bnigc', w, v) + b_s.T[:, :, None]
    return u * mixed.reshape(b, s, A_WIDTH)


def _retention(q, k, v):
    b, s, h, d = q.shape
    nc = s // CHUNK
    dt = v.dtype
    q = _rope(q) * (d ** -0.5)
    k = _rope(k)
    log_gamma = jnp.log(1.0 - jnp.exp2(-5.0 - jnp.arange(h, dtype=jnp.float32)))
    pos = jnp.arange(CHUNK, dtype=jnp.float32)
    dist = jnp.abs(pos[:, None] - pos[None, :])
    intra_decay = jnp.exp(log_gamma[:, None, None] * dist).astype(dt)
    k_decay = jnp.exp(log_gamma[None, :] * (CHUNK - 1 - pos)[:, None]).astype(dt)
    q_decay = jnp.exp(log_gamma[None, :] * (pos + 1.0)[:, None]).astype(dt)
    chunk_decay = jnp.exp(log_gamma * CHUNK).astype(dt)
    qc = q.reshape(b, nc, CHUNK, h, d)
    kc = k.reshape(b, nc, CHUNK, h, d)
    vc = v.reshape(b, nc, CHUNK, h, d)
    scores = jnp.einsum('bnihd,bnjhd->bnhij', qc, kc) * intra_decay
    intra = jnp.einsum('bnhij,bnjhe->bnihe', scores, vc)
    kv = jnp.einsum('bnjhd,bnjhe->nbhde', kc * k_decay[:, :, None], vc)

    def step(state, kv_c):
        return state * chunk_decay[:, None, None] + kv_c, state

    _, s_prev = lax.scan(step, jnp.zeros((b, h, d, d), dt), kv)
    cross = jnp.einsum('bnihd,nbhde->bnihe', qc * q_decay[:, :, None], s_prev)
    out = (intra + cross).reshape(b, s, h, d)
    return _layer_norm(out)


def _forgetting_attention(q, k, v, f_logit):
    b, s, h, d = q.shape
    scale = d ** -0.5
    cum_f = jnp.cumsum(jax.nn.log_sigmoid(f_logit.astype(jnp.float32)), axis=1)
    cum_f = jnp.transpose(cum_f, (0, 2, 1))
    outs = []
    for i in range(s // Q_BLOCK):
        q0, q1 = i * Q_BLOCK, (i + 1) * Q_BLOCK
        qb = q[:, q0:q1]
        kb = k[:, :q1]
        vb = v[:, :q1]
        logits = jnp.einsum('bqhd,bkhd->bhqk', qb, kb).astype(jnp.float32) * scale
        logits = logits + cum_f[:, :, q0:q1, None] - cum_f[:, :, None, :q1]
        qpos = q0 + jnp.arange(Q_BLOCK)
        kpos = jnp.arange(q1)
        causal = kpos[None, :] <= qpos[:, None]
        logits = jnp.where(causal, logits, -jnp.inf)
        p = jax.nn.softmax(logits, axis=-1).astype(v.dtype)
        outs.append(jnp.einsum('bhqk,bkhd->bqhd', p, vb))
    return jnp.concatenate(outs, axis=1)


def _hybrid_layer(x, pre_g, post_g, w_in, b_f, a_ln_g, a_ws, a_bs, w_out):
    b, s, _ = x.shape
    h = _rms_norm(x, pre_g)
    z = jnp.einsum('bsd,de->bse', h, w_in)
    a_z, r_z, f_z = jnp.split(z, [A_COLS, A_COLS + R_COLS], axis=-1)

    a_u, a_v, a_g = jnp.split(a_z, 3, axis=-1)
    a_out = _spatial_gating(jax.nn.gelu(a_u), jax.nn.gelu(a_v), a_ln_g, a_ws, a_bs) * jax.nn.silu(a_g)

    r_q, r_k, r_v, r_g = jnp.split(r_z, 4, axis=-1)
    hs = (b, s, R_HEADS, HEAD_DIM)
    r_out = _retention(r_q.reshape(hs), r_k.reshape(hs), r_v.reshape(hs)).reshape(b, s, R_WIDTH)
    r_out = r_out * jax.nn.silu(r_g)

    f_q, f_k, f_v, f_g, f_lg = jnp.split(
        f_z, [F_WIDTH, 2 * F_WIDTH, 3 * F_WIDTH, 4 * F_WIDTH], axis=-1)
    hs = (b, s, F_HEADS, HEAD_DIM)
    f_out = _forgetting_attention(f_q.reshape(hs), f_k.reshape(hs), f_v.reshape(hs), f_lg + b_f)
    f_out = f_out.reshape(b, s, F_WIDTH) * jax.nn.silu(f_g)

    y = jnp.concatenate([a_out, r_out, f_out], axis=-1)
    o = jnp.einsum('bse,ed->bsd', y, w_out)
    return x + _rms_norm(o, post_g)


def setup_inputs(seed: int = 0) -> dict:
    key = jax.random.key(seed)
    ks = jax.random.split(key, 9)
    f32 = jnp.float32
    x = jax.random.normal(ks[0], (BATCH, SEQ, D_MODEL), f32)
    pre_gain = 1.0 + 0.02 * jax.random.normal(ks[1], (DEPTH, D_MODEL), f32)
    post_gain = 1.0 + 0.02 * jax.random.normal(ks[2], (DEPTH, D_MODEL), f32)
    w_in = jax.random.normal(ks[3], (DEPTH, D_MODEL, D_IN), f32) * (D_MODEL ** -0.5)
    b_forget = 3.0 + 0.5 * jax.random.normal(ks[4], (DEPTH, F_HEADS), f32)
    a_norm_gain = 1.0 + 0.02 * jax.random.normal(ks[5], (DEPTH, A_GROUPS, HEAD_DIM), f32)
    a_spatial_w = jax.random.normal(ks[6], (DEPTH, A_GROUPS, A_BLOCK, A_BLOCK), f32) * (A_BLOCK ** -0.5)
    a_spatial_b = 1.0 + 0.02 * jax.random.normal(ks[7], (DEPTH, A_GROUPS, A_BLOCK), f32)
    w_out = jax.random.normal(ks[8], (DEPTH, D_MIX, D_MODEL), f32) * (D_MIX ** -0.5)
    return {"x": x, "pre_gain": pre_gain, "post_gain": post_gain, "w_in": w_in,
            "b_forget": b_forget, "a_norm_gain": a_norm_gain, "a_spatial_w": a_spatial_w,
            "a_spatial_b": a_spatial_b, "w_out": w_out}


def reference(x, pre_gain, post_gain, w_in, b_forget, a_norm_gain, a_spatial_w, a_spatial_b, w_out):
    for l in range(DEPTH):
        x = _hybrid_layer(x, pre_gain[l], post_gain[l], w_in[l], b_forget[l],
                          a_norm_gain[l], a_spatial_w[l], a_spatial_b[l], w_out[l])
    return x
```

```cpp
#include <hip/hip_runtime.h>
#include <hip/hip_cooperative_groups.h>
#include <cstdint>
#include <cstdio>
namespace cg = cooperative_groups;

#ifndef PROBE_PH
#define PROBE_PH -1
#endif
#ifndef MEGA
#define MEGA 1
#endif

#define DI __device__ __forceinline__
typedef unsigned short bf16_t;
typedef short bf16x8 __attribute__((ext_vector_type(8)));
typedef short s16x4 __attribute__((ext_vector_type(4)));
typedef float f32x4 __attribute__((ext_vector_type(4)));
typedef float f32x16 __attribute__((ext_vector_type(16)));

constexpr int NB = 8, SEQ = 4096, DM = 1024, NTOK = NB * SEQ, DIN = 3846, ZLD = 3072, NPAD = 3968;
constexpr int NTHREADS = 256;
constexpr float EPS = 1e-6f;
constexpr float LOG2E = 1.4426950408889634f;
constexpr float SKIP_T = 40.f;
constexpr int C_AU = 0, C_AV = 256, C_AG = 512, C_RQ = 768, C_RK = 1152, C_RG = 1536, C_FQ = 1920, C_FK = 2304, C_FG = 2688;
constexpr int LDS_MAIN = 2 * 2 * 128 * 72 * 2;
constexpr int LDS_BYTES = LDS_MAIN + 64;

struct Params {
    const float *x, *pre_g, *post_g, *w_in, *b_f, *a_ng, *a_sw, *a_sb, *w_out;
    float* out;
    bf16_t *WinT, *WoutT, *WsA, *hb, *z, *y, *vTf, *vTr, *x1b;
    bf16_t* o;
    float *kv, *lf, *cf, *rope, *kn, *rs;
    unsigned* ctr;
    unsigned* bar;
    int never;
    int pad0;
};

constexpr size_t WS_CTR = 0;
constexpr size_t WS_BAR = 256;
constexpr size_t WS_WINT = 256 + 16384;
constexpr size_t WS_WOUTT = WS_WINT + (size_t)2 * NPAD * 1024 * 2;
constexpr size_t WS_WSA = WS_WOUTT + (size_t)2 * 1024 * 1024 * 2;
constexpr size_t WS_ROPE = WS_WSA + (size_t)2 * 4 * 128 * 128 * 2;
constexpr size_t WS_LF = WS_ROPE + (size_t)4096 * 32 * 2 * 4;
constexpr size_t WS_CF = WS_LF + (size_t)48 * 4096 * 4;
constexpr size_t WS_VTF = WS_CF + (size_t)48 * 4096 * 4;
constexpr size_t WS_VTR = WS_VTF + (size_t)48 * 64 * 4096 * 2;
constexpr size_t WS_HB = WS_VTR + (size_t)48 * 64 * 4096 * 2;
constexpr size_t WS_Y = WS_HB + (size_t)NTOK * 1024 * 2;
constexpr size_t WS_KV = WS_Y + (size_t)NTOK * 1024 * 2;
constexpr size_t WS_Z = WS_KV + (size_t)3072 * 4096 * 4;
constexpr size_t WS_X1B = WS_Z + (size_t)NTOK * ZLD * 2;
constexpr size_t WS_KN = WS_X1B + (size_t)NTOK * 1024 * 2;
constexpr size_t WS_RS = WS_KN + 16384;
constexpr size_t WS_END = WS_RS + (size_t)NTOK * 4;

DI int ltid() { int t = threadIdx.x; asm volatile("" : "+v"(t)); return t; }
DI float bf2f(unsigned v) { return __uint_as_float(v << 16); }
typedef __bf16 bf16v2_t __attribute__((ext_vector_type(2)));
typedef float f32x2_t __attribute__((ext_vector_type(2)));
DI unsigned pk2(float lo, float hi) { const f32x2_t v = {lo, hi}; return __builtin_bit_cast(unsigned, __builtin_convertvector(v, bf16v2_t)); }
DI bf16_t f2bf(float x) { return (bf16_t)(pk2(x, 0.f) & 0xffffu); }
DI float lo_f(unsigned w) { return __uint_as_float(w << 16); }
DI float hi_f(unsigned w) { return __uint_as_float(w & 0xffff0000u); }
DI int crow(int reg, int h) { return (reg & 3) + 8 * (reg >> 2) + 4 * h; }
#define IDX4(jj) ((lane + 64 * ((jj) >> 1)) * 2 + ((jj) & 1))
DI float wave_sum(float v) {
#pragma unroll
    for (int o = 1; o < 64; o <<= 1) v += __shfl_xor(v, o);
    return v;
}
DI float silu_f(float x) { return x * __builtin_amdgcn_rcpf(1.f + __builtin_amdgcn_exp2f(-LOG2E * x)); }
DI float gelu_tanh_f(float x) { const float u = (-2.f * LOG2E * 0.7978845608028654f) * (x + 0.044715f * x * x * x); return x * __builtin_amdgcn_rcpf(1.f + __builtin_amdgcn_exp2f(u)); }
DI float logsigmoid_f(float x) { return fminf(x, 0.f) - log1pf(__expf(-fabsf(x))); }
#define MFMA32(a, b, c) __builtin_amdgcn_mfma_f32_32x32x16_bf16((a), (b), (c), 0, 0, 0)
#define MFMA16(a, b, c) __builtin_amdgcn_mfma_f32_16x16x32_bf16((a), (b), (c), 0, 0, 0)
DI f32x16 zero16() { f32x16 z; for (int i = 0; i < 16; ++i) z[i] = 0.f; return z; }

#define XB_TMO      128
#define XB_XCNT(j)  (256  + 64 * (j))
#define XB_XSUB(j)  (1280 + 64 * (j))
#define XB_XGEN(j)  (2304 + 64 * (j))
#define XB_TOP      3328
#define XB_TOPGEN   3392
#define XCD_BAR_WORDS 3456
#define XB_SPIN_CAP (1u << 18)
#define LAS __attribute__((address_space(3)))

__device__ __forceinline__ unsigned xb_ld(unsigned* p)              { return __hip_atomic_load(p, __ATOMIC_RELAXED, __HIP_MEMORY_SCOPE_AGENT); }
__device__ __forceinline__ unsigned xb_add(unsigned* p, unsigned v) { return __hip_atomic_fetch_add(p, v, __ATOMIC_RELAXED, __HIP_MEMORY_SCOPE_AGENT); }
__device__ __forceinline__ unsigned xb_xcc_id() { return (unsigned)__builtin_amdgcn_s_getreg((3 << 11) | 20) & 0xFu; }
#define XB_SPIN(cond, bar) do { unsigned _sp = 0; while (cond) { __builtin_amdgcn_s_sleep(1); \
    if ((++_sp & 255u) == 0u) { if (xb_ld(&(bar)[XB_TMO])) break; if (_sp > XB_SPIN_CAP) { atomicAdd(&(bar)[XB_TMO], 1u); break; } } } } while (0)

struct XcdBarrier {
    unsigned* bar; unsigned x;
    volatile LAS unsigned* st;
};

__device__ __forceinline__ XcdBarrier xcd_barrier_post(unsigned* bar, volatile LAS unsigned* st) {
    XcdBarrier b; b.bar = bar; b.x = xb_xcc_id(); b.st = st;
    if (threadIdx.x == 0) (void)xb_add(&bar[XB_XCNT(b.x)], 1u);
    return b;
}
__device__ __forceinline__ void xcd_barrier_complete(unsigned* bar, unsigned x, unsigned& nloc, unsigned& nx) {
    const unsigned G = gridDim.x * gridDim.y * gridDim.z;
    unsigned sum, cnt, mine, sp = 0u;
    for (;;) {
        sum = 0u; cnt = 0u; mine = 0u;
#pragma unroll
        for (unsigned j = 0; j < 16; ++j) { const unsigned c = xb_ld(&bar[XB_XCNT(j)]); sum += c; cnt += (c > 0u) ? 1u : 0u; mine = (j == x) ? c : mine; }
        if (sum == G) break;
        __builtin_amdgcn_s_sleep(1);
        if ((++sp & 255u) == 0u) { if (xb_ld(&bar[XB_TMO])) break; if (sp > XB_SPIN_CAP) { atomicAdd(&bar[XB_TMO], 1u); break; } }
    }
    nloc = mine > 0u ? mine : 1u; nx = cnt > 0u ? cnt : 1u;
}

__device__ __forceinline__ void xcd_barrier(const XcdBarrier& b) {
    asm volatile("s_waitcnt vmcnt(0)" ::: "memory");
    __syncthreads();
    if (threadIdx.x == 0) {
        unsigned* bar = b.bar;
        __builtin_amdgcn_s_waitcnt(0);
        unsigned nloc = b.st[0], nx = b.st[1];
        if (nloc == 0u) { xcd_barrier_complete(bar, b.x, nloc, nx); b.st[0] = nloc; b.st[1] = nx; }
        const unsigned old = xb_add(&bar[XB_XSUB(b.x)], 1u);
        const unsigned gen = old / nloc;
        if (old + 1u == (gen + 1u) * nloc) {
            __builtin_amdgcn_fence(__ATOMIC_RELEASE, "agent");
            asm volatile("s_waitcnt vmcnt(0)" ::: "memory");
            const unsigned og = xb_add(&bar[XB_TOP], 1u);
            const unsigned tg = og / nx;
            if (og + 1u == (tg + 1u) * nx) xb_add(&bar[XB_TOPGEN], 1u);
            else XB_SPIN(xb_ld(&bar[XB_TOPGEN]) == tg, bar);
            __builtin_amdgcn_fence(__ATOMIC_ACQUIRE, "agent");
            xb_add(&bar[XB_XGEN(b.x)], 1u);
            asm volatile("s_waitcnt vmcnt(0)" ::: "memory");
        } else {
            XB_SPIN(xb_ld(&bar[XB_XGEN(b.x)]) == gen, bar);
            __builtin_amdgcn_fence(__ATOMIC_ACQUIRE, "agent");
            asm volatile("s_waitcnt vmcnt(0)" ::: "memory");
        }
    }
    __syncthreads();
}

DI void transpose_item(const float* __restrict__ W, int N, int NP, bf16_t* __restrict__ WT, int item, float* scr, const float* __restrict__ gain = nullptr) {
    const int tid = ltid();
    const int nblk = NP / 64, kb = item / nblk, nb = item % nblk, k0 = kb * 64, n0 = nb * 64;
#pragma unroll
    for (int i = 0; i < 16; ++i) {
        const int kk = i * 4 + (tid >> 6), nn = tid & 63;
        scr[kk * 65 + nn] = (n0 + nn < N) ? W[(size_t)(k0 + kk) * N + n0 + nn] * (gain ? gain[k0 + kk] : 1.f) : 0.f;
    }
    __syncthreads();
    const int n = tid >> 2, c = tid & 3;
    uint4 o0, o1;
    const float* s = scr + (c * 16) * 65 + n;
    o0.x = pk2(s[0 * 65], s[1 * 65]); o0.y = pk2(s[2 * 65], s[3 * 65]); o0.z = pk2(s[4 * 65], s[5 * 65]); o0.w = pk2(s[6 * 65], s[7 * 65]);
    o1.x = pk2(s[8 * 65], s[9 * 65]); o1.y = pk2(s[10 * 65], s[11 * 65]); o1.z = pk2(s[12 * 65], s[13 * 65]); o1.w = pk2(s[14 * 65], s[15 * 65]);
    uint4* dst = (uint4*)(WT + (size_t)(n0 + n) * 1024 + k0 + c * 16);
    dst[0] = o0; dst[1] = o1;
    __syncthreads();
}

DI void rms_row_to_bf16(const float* xrow, const float* gain, bf16_t* orow, int lane) {
    f32x4 v[4]; float ss = 0.f;
#pragma unroll
    for (int j = 0; j < 4; ++j) { v[j] = ((const f32x4*)xrow)[lane + 64 * j]; ss += (v[j].x * v[j].x + v[j].y * v[j].y) + (v[j].z * v[j].z + v[j].w * v[j].w); }
    const float rstd = rsqrtf(wave_sum(ss) * (1.f / 1024.f) + EPS);
#pragma unroll
    for (int j = 0; j < 4; ++j) {
        const f32x4 g = ((const f32x4*)gain)[lane + 64 * j];
        uint2 w; w.x = pk2(v[j].x * rstd * g.x, v[j].y * rstd * g.y); w.y = pk2(v[j].z * rstd * g.z, v[j].w * rstd * g.w);
        ((uint2*)orow)[lane + 64 * j] = w;
    }
}

constexpr int I_IN = 16 * (NPAD / 64), I_OUT = 16 * 16;
DI void wt_item(const Params& p, int l, int it, float* scr) {
    if (it < I_IN) transpose_item(p.w_in + (size_t)l * 1024 * DIN, DIN, NPAD, p.WinT + (size_t)l * NPAD * 1024, it, scr, l == 1 ? p.pre_g + 1024 : nullptr);
    else transpose_item(p.w_out + (size_t)l * 1024 * 1024, 1024, 1024, p.WoutT + (size_t)l * 1024 * 1024, it - I_IN, scr);
}
DI void phase0(const Params& p, char* smem) {
    const int tid = ltid(), G = gridDim.x;
    if (blockIdx.x == 0 && tid < 8) p.ctr[tid] = 0u;
    float* scr = (float*)smem;
    for (int it = blockIdx.x; it < I_IN + I_OUT; it += G) wt_item(p, 0, it, scr);
    const int gt = blockIdx.x * NTHREADS + tid, GT = G * NTHREADS;
    for (int idx = gt; idx < 2 * 4 * 128 * 128; idx += GT) {
        const int i = (idx >> 7) & 127, j = idx & 127;
        const float w = p.a_sw[idx];
        p.WsA[idx] = f2bf(((j >> 6) <= (i >> 6)) ? w : 0.f);
    }
    for (int idx = gt; idx < 4096 * 32; idx += GT) {
        const int pos = idx >> 5, i = idx & 31;
        const float inv = powf(10000.f, -(float)i / 32.f);
        const float ang = (float)pos * inv;
        float sn, cs; sincosf(ang, &sn, &cs);
        p.rope[2 * idx] = cs; p.rope[2 * idx + 1] = sn;
    }
    const int wv = tid >> 6, lane = tid & 63;
    for (int row = (blockIdx.x * 4 + wv) * 2; row < NTOK; row += G * 8) {
        f32x4 v[2][4]; float ss[2] = {0.f, 0.f};
#pragma unroll
        for (int q = 0; q < 2; ++q)
#pragma unroll
            for (int j = 0; j < 4; ++j) v[q][j] = ((const f32x4*)(p.x + (size_t)(row + q) * 1024))[IDX4(j)];
#pragma unroll
        for (int q = 0; q < 2; ++q)
#pragma unroll
            for (int j = 0; j < 4; ++j) ss[q] += (v[q][j].x * v[q][j].x + v[q][j].y * v[q][j].y) + (v[q][j].z * v[q][j].z + v[q][j].w * v[q][j].w);
#pragma unroll
        for (int o = 1; o < 64; o <<= 1) { ss[0] += __shfl_xor(ss[0], o); ss[1] += __shfl_xor(ss[1], o); }
#pragma unroll
        for (int q = 0; q < 2; ++q) {
            const float rstd = rsqrtf(ss[q] * (1.f / 1024.f) + EPS);
#pragma unroll
            for (int j = 0; j < 2; ++j) {
                const f32x4 ga = ((const f32x4*)p.pre_g)[IDX4(2 * j)], gb = ((const f32x4*)p.pre_g)[IDX4(2 * j + 1)], va = v[q][2 * j], vb = v[q][2 * j + 1];
                uint4 w2; w2.x = pk2(va.x * rstd * ga.x, va.y * rstd * ga.y); w2.y = pk2(va.z * rstd * ga.z, va.w * rstd * ga.w);
                w2.z = pk2(vb.x * rstd * gb.x, vb.y * rstd * gb.y); w2.w = pk2(vb.z * rstd * gb.z, vb.w * rstd * gb.w);
                ((uint4*)(p.hb + (size_t)(row + q) * 1024))[lane + 64 * j] = w2;
            }
        }
    }
}

template <int MODE>
DI void gemm_phase(const Params& p, int layer, char* smem) {
    const bf16_t* __restrict__ A = MODE == 0 ? (layer == 0 ? p.hb : p.x1b) : p.y;
    const float* __restrict__ rsp = (MODE == 0 && layer != 0) ? p.rs : nullptr;
    const bf16_t* __restrict__ Bt = MODE == 0 ? p.WinT + (size_t)layer * NPAD * 1024 : p.WoutT + (size_t)layer * 1024 * 1024;
    constexpr int NTN = MODE == 0 ? 30 : 8, K = 1024, NKT = K / 64;
    const int ntiles = 256 * NTN;
    bf16_t* As = (bf16_t*)smem;
    bf16_t* Bs = As + 2 * 128 * 72;
    const int tid = ltid(), w = tid >> 6, lane = tid & 63, r = lane & 31, h = lane >> 5, wm = w >> 1, wn = w & 1;
    const bool xmap = (gridDim.x & 7) == 0;
    const int xcd = blockIdx.x & 7, nper = gridDim.x >> 3;
    const int tstart = xmap ? (int)(blockIdx.x >> 3) : (int)blockIdx.x, tend = xmap ? 32 * NTN : ntiles, tstep = xmap ? nper : (int)gridDim.x;
#define TILE_MN(t_, m0_, n0_, nt_) { const int grp_ = (t_) / (8 * NTN), rr_ = (t_) % (8 * NTN); nt_ = rr_ >> 3; m0_ = ((xmap ? xcd * 32 : 0) + grp_ * 8 + (rr_ & 7)) * 128; n0_ = nt_ * 128; }
    int goff[4];
#pragma unroll
    for (int i = 0; i < 4; ++i) { const int R = w * 32 + i * 8 + (lane >> 3); goff[i] = R * K + (((lane & 7) ^ ((R >> 1) & 7)) * 8); }
    LAS unsigned char* lds = (LAS unsigned char*)smem;
#define DMA_SLAB(pa, pb, koff, bufi) { _Pragma("unroll") for (int i_ = 0; i_ < 4; ++i_) { \
        __builtin_amdgcn_global_load_lds((const unsigned*)((pa) + goff[i_] + (koff)), (LAS unsigned*)(lds + (bufi) * 32768 + (w * 4 + i_) * 1024), 16, 0, 0); \
        __builtin_amdgcn_global_load_lds((const unsigned*)((pb) + goff[i_] + (koff)), (LAS unsigned*)(lds + (bufi) * 32768 + 16384 + (w * 4 + i_) * 1024), 16, 0, 0); } }
    const bf16_t *ga = A, *gb = Bt;
    if (tstart < tend) {
        int m0f, n0f, ntf;
        TILE_MN(tstart, m0f, n0f, ntf)
        ga = A + (size_t)m0f * K; gb = Bt + (size_t)n0f * K;
        DMA_SLAB(ga, gb, 0, 0)
    }
    asm volatile("s_waitcnt vmcnt(0)" ::: "memory");
    __syncthreads();
    const int l15 = lane & 15, q4 = lane >> 4, fsw = (l15 >> 1) & 7;
    for (int t = tstart; t < tend; t += tstep) {
        int m0, n0, nt;
        TILE_MN(t, m0, n0, nt)
        const bf16_t *gan = ga, *gbn = gb;
        if (t + tstep < tend) { int m0n, n0n, ntn; TILE_MN(t + tstep, m0n, n0n, ntn) gan = A + (size_t)m0n * K; gbn = Bt + (size_t)n0n * K; }
        const bool isv = MODE == 0 && ((nt >= 12 && nt < 15) || (nt >= 24 && nt < 27));
        const int offm = isv ? 16384 + (wn * 64 + l15) * 128 : (wm * 64 + l15) * 128;
        const int offn = isv ? (wm * 64 + l15) * 128 : 16384 + (wn * 64 + l15) * 128;
        f32x4 acc[4][4];
#pragma unroll
        for (int a = 0; a < 4; ++a)
#pragma unroll
            for (int b = 0; b < 4; ++b) acc[a][b] = (f32x4){0.f, 0.f, 0.f, 0.f};
#pragma unroll
        for (int kt = 0; kt < NKT; ++kt) {
            const int buf = kt & 1;
            if (kt + 1 < NKT) { DMA_SLAB(ga, gb, (kt + 1) * 64, buf ^ 1) } else { DMA_SLAB(gan, gbn, 0, buf ^ 1) }
            const char* as = smem + buf * 32768 + offm;
            const char* bs = smem + buf * 32768 + offn;
#pragma unroll
            for (int kk = 0; kk < 2; ++kk) {
                const int co = ((4 * kk + q4) ^ fsw) * 16;
                bf16x8 fn[4], fm[4];
#pragma unroll
                for (int t4 = 0; t4 < 4; ++t4) { fn[t4] = *(const bf16x8*)(bs + t4 * 16 * 128 + co); fm[t4] = *(const bf16x8*)(as + t4 * 16 * 128 + co); }
#pragma unroll
                for (int tn = 0; tn < 4; ++tn)
#pragma unroll
                    for (int tm = 0; tm < 4; ++tm) acc[tn][tm] = MFMA16(fn[tn], fm[tm], acc[tn][tm]);
            }
            asm volatile("s_waitcnt vmcnt(0)" ::: "memory");
            __syncthreads();
        }
        ga = gan; gb = gbn;
        if (MODE == 1) {
            bf16_t* Cs = (bf16_t*)(smem + 32768);
#pragma unroll
            for (int tm = 0; tm < 4; ++tm)
#pragma unroll
                for (int tn = 0; tn < 4; ++tn) {
                    uint2 v; v.x = pk2(acc[tn][tm][0], acc[tn][tm][1]); v.y = pk2(acc[tn][tm][2], acc[tn][tm][3]);
                    *(uint2*)(Cs + (wm * 64 + tm * 16 + l15) * 136 + wn * 64 + tn * 16 + 4 * q4) = v;
                }
            __syncthreads();
#pragma unroll
            for (int i = 0; i < 8; ++i) {
                const int c = tid + i * 256, row = c >> 4, cc = c & 15;
                *(uint4*)(p.o + (size_t)(m0 + row) * 1024 + n0 + cc * 8) = *(const uint4*)&Cs[row * 136 + cc * 8];
            }
            __syncthreads();
        } else {
            if (nt == 30) {
                if (wn == 0 && q4 < 2) {
#pragma unroll
                    for (int tm = 0; tm < 4; ++tm) {
                        const int tok = m0 + wm * 64 + tm * 16 + l15, b = tok >> 12, sq = tok & 4095;
#pragma unroll
                        for (int u = 0; u < 4; ++u) {
                            const int n = 4 * q4 + u;
                            if (n < 6) p.lf[(size_t)(b * 6 + n) * 4096 + sq] = logsigmoid_f(acc[0][tm][u] + p.b_f[layer * 6 + n]);
                        }
                    }
                }
            } else {
                int kind;
                if (nt < 4) kind = 1; else if (nt < 6) kind = 2; else if (nt < 9) kind = 3; else if (nt < 12) kind = 4; else if (nt < 15) kind = 0;
                else if (nt < 18) kind = 2; else if (nt < 21) kind = 5; else if (nt < 27) kind = 0; else kind = 2;
                if (rsp) {
                    if (isv) {
#pragma unroll
                        for (int a2 = 0; a2 < 4; ++a2) {
                            const f32x4 rv = *(const f32x4*)(rsp + m0 + wm * 64 + a2 * 16 + 4 * q4);
#pragma unroll
                            for (int b2 = 0; b2 < 4; ++b2) acc[a2][b2] = acc[a2][b2] * rv;
                        }
                    } else {
#pragma unroll
                        for (int tm = 0; tm < 4; ++tm) {
                            const float rv = rsp[m0 + wm * 64 + tm * 16 + l15];
#pragma unroll
                            for (int tn = 0; tn < 4; ++tn) acc[tn][tm] = acc[tn][tm] * rv;
                        }
                    }
                }
                if (nt >= 21 && nt < 24) {
                    float mxn = 0.f;
#pragma unroll
                    for (int tm = 0; tm < 4; ++tm) {
                        float ssq = 0.f;
#pragma unroll
                        for (int tn = 0; tn < 4; ++tn)
#pragma unroll
                            for (int i = 0; i < 4; ++i) ssq += acc[tn][tm][i] * acc[tn][tm][i];
                        ssq += __shfl_xor(ssq, 16); ssq += __shfl_xor(ssq, 32);
                        mxn = fmaxf(mxn, ssq);
                    }
#pragma unroll
                    for (int o = 1; o < 16; o <<= 1) mxn = fmaxf(mxn, __shfl_xor(mxn, o));
                    if (lane == 0) p.kn[((m0 >> 12) * 6 + (nt - 21) * 2 + wn) * 64 + (((m0 & 4095) + wm * 64) >> 6)] = sqrtf(mxn);
                }
                bf16_t* Cs = (bf16_t*)(smem + 32768);
#pragma unroll
                for (int tm = 0; tm < 4; ++tm) {
                    if (kind == 3 || kind == 4) {
                        const float sc = kind == 3 ? 0.125f : 1.f;
                        const int pos = (m0 + wm * 64 + tm * 16 + l15) & 4095;
                        const float* rp = p.rope + (size_t)pos * 64 + 8 * q4;
#pragma unroll
                        for (int tn = 0; tn < 2; ++tn) {
                            const f32x4 c0 = *(const f32x4*)(rp + 32 * tn), c1 = *(const f32x4*)(rp + 32 * tn + 4);
                            const float cs[4] = {c0.x, c0.z, c1.x, c1.z}, sn[4] = {c0.y, c0.w, c1.y, c1.w};
#pragma unroll
                            for (int u = 0; u < 4; ++u) {
                                const float x1 = acc[tn][tm][u], x2 = acc[tn + 2][tm][u];
                                acc[tn][tm][u] = (x1 * cs[u] - x2 * sn[u]) * sc;
                                acc[tn + 2][tm][u] = (x1 * sn[u] + x2 * cs[u]) * sc;
                            }
                        }
                    }
#pragma unroll
                    for (int tn = 0; tn < 4; ++tn) {
                        if (kind == 1) {
#pragma unroll
                            for (int i = 0; i < 4; ++i) acc[tn][tm][i] = gelu_tanh_f(acc[tn][tm][i]);
                        } else if (kind == 2) {
#pragma unroll
                            for (int i = 0; i < 4; ++i) acc[tn][tm][i] = silu_f(acc[tn][tm][i]);
                        } else if (kind == 5) {
#pragma unroll
                            for (int i = 0; i < 4; ++i) acc[tn][tm][i] *= 0.125f * LOG2E;
                        }
                        uint2 v; v.x = pk2(acc[tn][tm][0], acc[tn][tm][1]); v.y = pk2(acc[tn][tm][2], acc[tn][tm][3]);
                        if (isv) *(uint2*)(Cs + (wn * 64 + tm * 16 + l15) * 136 + wm * 64 + tn * 16 + 4 * q4) = v;
                        else *(uint2*)(Cs + (wm * 64 + tm * 16 + l15) * 136 + wn * 64 + tn * 16 + 4 * q4) = v;
                    }
                    __builtin_amdgcn_sched_barrier(0);
                }
                __syncthreads();
                if (isv) {
                    const int te = ltid();
#pragma unroll
                    for (int i = 0; i < 8; ++i) {
                        const int c = te + i * 256, n = c >> 4, cc = c & 15;
                        const int hd = (nt >= 24 ? nt - 24 : nt - 12) * 2 + (n >> 6), e = n & 63;
                        bf16_t* dst = (nt >= 24 ? p.vTf : p.vTr) + ((size_t)((m0 >> 12) * 6 + hd) * 64 + e) * 4096 + (m0 & 4095) + cc * 8;
                        *(uint4*)dst = *(const uint4*)&Cs[n * 136 + cc * 8];
                    }
                } else {
                    const int n0z = n0 - (nt >= 27 ? 768 : (nt >= 15 ? 384 : 0));
#pragma unroll
                    for (int i = 0; i < 8; ++i) {
                        const int c = tid + i * 256, row = c >> 4, cc = c & 15;
                        *(uint4*)(p.z + (size_t)(m0 + row) * ZLD + n0z + cc * 8) = *(const uint4*)&Cs[row * 136 + cc * 8];
                    }
                }
                __syncthreads();
            }
        }
    }
    if (MODE == 0) {
        const bf16_t* gbl = Bt + (size_t)3840 * K;
        const int wb = w & 1;
        const int goffb = (wb * 8 + (lane >> 3)) * K + (((lane & 7) ^ (((wb * 8 + (lane >> 3)) >> 1) & 7)) * 8);
#define LG_DMA(pa, st, sl) { _Pragma("unroll") for (int i_ = 0; i_ < 4; ++i_) \
        __builtin_amdgcn_global_load_lds((const unsigned*)((pa) + goff[i_] + (st) * 64), (LAS unsigned*)(lds + (sl) * 16384 + (w * 4 + i_) * 1024), 16, 0, 0); \
        __builtin_amdgcn_global_load_lds((const unsigned*)(gbl + goffb + (st) * 64), (LAS unsigned*)(lds + 65536 + (sl) * 2048 + wb * 1024), 16, 0, 0); }
        for (int mt = blockIdx.x; mt < NTOK / 128; mt += gridDim.x) {
            const int m0 = mt * 128;
            const bf16_t* gal = A + (size_t)m0 * K;
            f32x4 lacc[2] = {(f32x4){0.f, 0.f, 0.f, 0.f}, (f32x4){0.f, 0.f, 0.f, 0.f}};
            LG_DMA(gal, 0, 0) LG_DMA(gal, 1, 1) LG_DMA(gal, 2, 2)
#pragma unroll
            for (int kt = 0; kt < NKT; ++kt) {
                if (kt + 2 < NKT) asm volatile("s_waitcnt vmcnt(10)" ::: "memory"); else if (kt + 1 < NKT) asm volatile("s_waitcnt vmcnt(5)" ::: "memory"); else asm volatile("s_waitcnt vmcnt(0)" ::: "memory");
                __syncthreads();
                if (kt + 3 < NKT) LG_DMA(gal, kt + 3, (kt + 3) & 3)
                const char* as = smem + (kt & 3) * 16384 + (w * 32 + l15) * 128;
                const char* bs = smem + 65536 + (kt & 3) * 2048 + l15 * 128;
#pragma unroll
                for (int kk = 0; kk < 2; ++kk) {
                    const int co = ((4 * kk + q4) ^ fsw) * 16;
                    const bf16x8 fnl = *(const bf16x8*)(bs + co);
                    const bf16x8 fm0 = *(const bf16x8*)(as + co), fm1 = *(const bf16x8*)(as + 16 * 128 + co);
                    lacc[0] = MFMA16(fnl, fm0, lacc[0]); lacc[1] = MFMA16(fnl, fm1, lacc[1]);
                }
            }
            __syncthreads();
            if (q4 < 2) {
#pragma unroll
                for (int tm = 0; tm < 2; ++tm) {
                    const int tok = m0 + w * 32 + tm * 16 + l15, b = tok >> 12, sq = tok & 4095;
#pragma unroll
                    for (int u = 0; u < 4; ++u) {
                        const int n = 4 * q4 + u;
                        if (n < 6) p.lf[(size_t)(b * 6 + n) * 4096 + sq] = logsigmoid_f(lacc[tm][u] * (rsp ? rsp[tok] : 1.f) + p.b_f[layer * 6 + n]);
                    }
                }
            }
        }
    }
}

DI void unpack8(const uint4 v, float* f) { f[0] = lo_f(v.x); f[1] = hi_f(v.x); f[2] = lo_f(v.y); f[3] = hi_f(v.y); f[4] = lo_f(v.z); f[5] = hi_f(v.z); f[6] = lo_f(v.w); f[7] = hi_f(v.w); }

DI void abranch_item(const Params& p, int layer, int item, char* smem) {
    const int g = item & 3, nb = (item >> 2) & 31, b = item >> 7;
    const int t0 = b * 4096 + nb * 128;
    bf16_t* vnT = (bf16_t*)smem;
    const int tid = ltid(), w = tid >> 6, lane = tid & 63, r = lane & 31, h = lane >> 5;
    {
        const int tok = tid >> 1, half = tid & 1;
        const uint4* src = (const uint4*)(p.z + (size_t)(t0 + tok) * ZLD + C_AV + g * 64 + half * 32);
        float v[32];
#pragma unroll
        for (int i = 0; i < 4; ++i) unpack8(src[i], v + 8 * i);
        float s = 0.f;
#pragma unroll
        for (int i = 0; i < 32; ++i) s += v[i];
        s += __shfl_xor(s, 1);
        const float mean = s * (1.f / 64.f);
        float q = 0.f;
#pragma unroll
        for (int i = 0; i < 32; ++i) { v[i] -= mean; q += v[i] * v[i]; }
        q += __shfl_xor(q, 1);
        const float rstd = rsqrtf(q * (1.f / 64.f) + EPS);
        const float* gain = p.a_ng + layer * 256 + g * 64 + half * 32;
#pragma unroll
        for (int i = 0; i < 32; ++i) vnT[(half * 32 + i) * 136 + tok] = f2bf(v[i] * rstd * gain[i]);
    }
    __syncthreads();
    f32x16 acc[2] = {zero16(), zero16()};
    const bf16_t* wrow = p.WsA + ((size_t)(layer * 4 + g) * 128 + w * 32 + r) * 128 + h * 8;
    const int kmax = (w < 2) ? 4 : 8;
    for (int ks = 0; ks < kmax; ++ks) {
        const bf16x8 bfr = *(const bf16x8*)(wrow + ks * 16);
#pragma unroll
        for (int ct = 0; ct < 2; ++ct) {
            const bf16x8 afr = *(const bf16x8*)&vnT[(ct * 32 + r) * 136 + ks * 16 + h * 8];
            acc[ct] = MFMA32(afr, bfr, acc[ct]);
        }
    }
    const int i = w * 32 + r, tok = t0 + i;
    const float bias = p.a_sb[(layer * 4 + g) * 128 + i];
#pragma unroll
    for (int ct = 0; ct < 2; ++ct)
#pragma unroll
        for (int gq = 0; gq < 4; ++gq) {
            const int c0 = ct * 32 + 8 * gq + 4 * h;
            const uint2 u = *(const uint2*)(p.z + (size_t)tok * ZLD + C_AU + g * 64 + c0);
            const uint2 sg = *(const uint2*)(p.z + (size_t)tok * ZLD + C_AG + g * 64 + c0);
            const float o0 = lo_f(u.x) * (acc[ct][4 * gq] + bias) * lo_f(sg.x), o1 = hi_f(u.x) * (acc[ct][4 * gq + 1] + bias) * hi_f(sg.x);
            const float o2 = lo_f(u.y) * (acc[ct][4 * gq + 2] + bias) * lo_f(sg.y), o3 = hi_f(u.y) * (acc[ct][4 * gq + 3] + bias) * hi_f(sg.y);
            uint2 ov; ov.x = pk2(o0, o1); ov.y = pk2(o2, o3);
            *(uint2*)(p.y + (size_t)tok * 1024 + g * 64 + c0) = ov;
        }
    __syncthreads();
}

DI void kv_item(const Params& p, int item, char* smem) {
    const int n = item & 63, bh = item >> 6, hd = bh % 6, b = bh / 6;
    const int t0 = b * 4096 + n * 64;
    bf16_t* KT = (bf16_t*)smem;
    bf16_t* VT = KT + 64 * 72;
    const int tid = ltid(), w = tid >> 6, lane = tid & 63, r = lane & 31, h = lane >> 5;
    {
        const int j = tid >> 2, part = tid & 3;
        const uint4* ks = (const uint4*)(p.z + (size_t)(t0 + j) * ZLD + C_RK + hd * 64 + part * 16);
        const uint4* vs = (const uint4*)(p.vTr + ((size_t)bh * 64 + j) * 4096 + n * 64 + part * 16);
        float kf[16]; unpack8(ks[0], kf); unpack8(ks[1], kf + 8);
        *(uint4*)&VT[j * 72 + part * 16] = vs[0]; *(uint4*)&VT[j * 72 + part * 16 + 8] = vs[1];
        const float lg = logf(1.f - exp2f(-5.f - (float)hd));
        const float kd = expf(lg * (float)(63 - j));
#pragma unroll
        for (int q = 0; q < 16; ++q) {
            KT[(part * 16 + q) * 72 + j] = f2bf(kf[q] * kd);
        }
    }
    __syncthreads();
    const int dt = w >> 1, et = w & 1;
    f32x16 acc = zero16();
#pragma unroll
    for (int ks = 0; ks < 4; ++ks) {
        const bf16x8 a = *(const bf16x8*)&KT[(dt * 32 + r) * 72 + ks * 16 + h * 8];
        const bf16x8 bb = *(const bf16x8*)&VT[(et * 32 + r) * 72 + ks * 16 + h * 8];
        acc = MFMA32(a, bb, acc);
    }
    float* dst = p.kv + (size_t)item * 4096 + (et * 32 + r) * 64 + dt * 32 + 4 * h;
#pragma unroll
    for (int gq = 0; gq < 4; ++gq) { f32x4 v = {acc[4 * gq], acc[4 * gq + 1], acc[4 * gq + 2], acc[4 * gq + 3]}; *(f32x4*)(dst + 8 * gq) = v; }
    __syncthreads();
}

DI void cumsum_item(const Params& p, int item, char* smem) {
    const float* src = p.lf + (size_t)item * 4096;
    float* dst = p.cf + (size_t)item * 4096;
    float* wt = (float*)smem;
    const int tid = ltid(), w = tid >> 6, lane = tid & 63;
    float v[16];
#pragma unroll
    for (int i = 0; i < 4; ++i) { const f32x4 t = ((const f32x4*)src)[tid * 4 + i]; v[4 * i] = t.x; v[4 * i + 1] = t.y; v[4 * i + 2] = t.z; v[4 * i + 3] = t.w; }
#pragma unroll
    for (int i = 1; i < 16; ++i) v[i] += v[i - 1];
    const float total = v[15];
    float x = total;
#pragma unroll
    for (int o = 1; o < 64; o <<= 1) { const float y = __shfl_up(x, o); if (lane >= o) x += y; }
    if (lane == 63) wt[w] = x;
    __syncthreads();
    float off = x - total;
    for (int i = 0; i < w; ++i) off += wt[i];
#pragma unroll
    for (int i = 0; i < 4; ++i) { f32x4 t = {v[4 * i] + off, v[4 * i + 1] + off, v[4 * i + 2] + off, v[4 * i + 3] + off}; ((f32x4*)dst)[tid * 4 + i] = t; }
    __syncthreads();
}

DI void phase2a(const Params& p, int layer, char* smem) {
    constexpr int N_CS = 48, N_KV = 3072;
    for (int it = blockIdx.x; it < N_CS + N_KV; it += gridDim.x) {
        if (it < N_CS) cumsum_item(p, it, smem);
        else kv_item(p, it - N_CS, smem);
    }
}

DI void ret_item(const Params& p, int item, char* smem) {
    const int seg = item & 7, bh = item >> 3, hd = bh % 6, b = bh / 6;
    bf16_t* Qs = (bf16_t*)smem;
    bf16_t* Qds = Qs + 64 * 72;
    bf16_t* Ks = Qds + 64 * 72;
    bf16_t* VT = Ks + 64 * 72;
    bf16_t* ST = VT + 64 * 72;
    bf16_t* Ps = ST + 64 * 72;
    float* red = (float*)(Ps + 64 * 72);
    const int tid = ltid(), w = tid >> 6, lane = tid & 63, r = lane & 31, h = lane >> 5;
    const float lg = logf(1.f - exp2f(-5.f - (float)hd));
    const float cd = expf(lg * 64.f);
    const int e_own = tid >> 2, dpart = tid & 3;
    float st[16];
#pragma unroll
    for (int q = 0; q < 16; ++q) st[q] = 0.f;
    const float* kvb = p.kv + (size_t)bh * 64 * 4096 + e_own * 64 + dpart * 16;
#pragma unroll 8
    for (int m = 0; m < seg * 8; ++m) {
        const f32x4* s4 = (const f32x4*)(kvb + (size_t)m * 4096);
#pragma unroll
        for (int i = 0; i < 4; ++i) { const f32x4 t = s4[i]; st[4 * i] = st[4 * i] * cd + t.x; st[4 * i + 1] = st[4 * i + 1] * cd + t.y; st[4 * i + 2] = st[4 * i + 2] * cd + t.z; st[4 * i + 3] = st[4 * i + 3] * cd + t.w; }
    }
    const int lj = tid >> 2, lpart = tid & 3;
    const bf16_t* zr0 = p.z + (size_t)(b * 4096 + seg * 512 + lj) * ZLD + hd * 64 + lpart * 16;
    const bf16_t* vs0 = p.vTr + ((size_t)bh * 64 + lj) * 4096 + seg * 512 + lpart * 16;
    const float* kvs = kvb + (size_t)(seg * 8) * 4096;
    uint4 pq0 = *(const uint4*)(zr0 + C_RQ), pq1 = *(const uint4*)(zr0 + C_RQ + 8), pk0 = *(const uint4*)(zr0 + C_RK), pk1 = *(const uint4*)(zr0 + C_RK + 8);
    uint4 pv0 = *(const uint4*)vs0, pv1 = *(const uint4*)(vs0 + 8);
    f32x4 pkv0 = ((const f32x4*)kvs)[0], pkv1 = ((const f32x4*)kvs)[1], pkv2 = ((const f32x4*)kvs)[2], pkv3 = ((const f32x4*)kvs)[3];
    const float qd_c = expf(lg * (float)(lj + 1));
    float dec[16];
    {
        const int i_ = (w & 1) * 32 + r, jt_ = w >> 1;
#pragma unroll
        for (int q = 0; q < 16; ++q) { const int dd = i_ - (jt_ * 32 + crow(q, h)); dec[q] = expf(lg * (float)(dd < 0 ? -dd : dd)); }
    }
    for (int c = 0; c < 8; ++c) {
        const int n = seg * 8 + c, t0 = b * 4096 + n * 64;
        uint2 sgr[4];
        {
            uint4 s0, s1;
            s0.x = pk2(st[0], st[1]); s0.y = pk2(st[2], st[3]); s0.z = pk2(st[4], st[5]); s0.w = pk2(st[6], st[7]);
            s1.x = pk2(st[8], st[9]); s1.y = pk2(st[10], st[11]); s1.z = pk2(st[12], st[13]); s1.w = pk2(st[14], st[15]);
            *(uint4*)&ST[e_own * 72 + dpart * 16] = s0; *(uint4*)&ST[e_own * 72 + dpart * 16 + 8] = s1;
            const int j = lj, part = lpart;
            const uint4 q0 = pq0, q1 = pq1, k0 = pk0, k1 = pk1, v0 = pv0, v1 = pv1;
            *(uint4*)&Qs[j * 72 + part * 16] = q0; *(uint4*)&Qs[j * 72 + part * 16 + 8] = q1;
            *(uint4*)&Ks[j * 72 + part * 16] = k0; *(uint4*)&Ks[j * 72 + part * 16 + 8] = k1;
            const float qd = qd_c;
            float qf[16]; unpack8(q0, qf); unpack8(q1, qf + 8);
            uint4 d0, d1;
            d0.x = pk2(qf[0] * qd, qf[1] * qd); d0.y = pk2(qf[2] * qd, qf[3] * qd); d0.z = pk2(qf[4] * qd, qf[5] * qd); d0.w = pk2(qf[6] * qd, qf[7] * qd);
            d1.x = pk2(qf[8] * qd, qf[9] * qd); d1.y = pk2(qf[10] * qd, qf[11] * qd); d1.z = pk2(qf[12] * qd, qf[13] * qd); d1.w = pk2(qf[14] * qd, qf[15] * qd);
            *(uint4*)&Qds[j * 72 + part * 16] = d0; *(uint4*)&Qds[j * 72 + part * 16 + 8] = d1;
            *(uint4*)&VT[j * 72 + part * 16] = v0; *(uint4*)&VT[j * 72 + part * 16 + 8] = v1;
            if (c + 1 < 8) {
                const bf16_t* zr = zr0 + (size_t)(c + 1) * 64 * ZLD;
                pq0 = *(const uint4*)(zr + C_RQ); pq1 = *(const uint4*)(zr + C_RQ + 8); pk0 = *(const uint4*)(zr + C_RK); pk1 = *(const uint4*)(zr + C_RK + 8);
                pv0 = *(const uint4*)(vs0 + (c + 1) * 64); pv1 = *(const uint4*)(vs0 + (c + 1) * 64 + 8);
            }
            {
                const int i_ = (w & 1) * 32 + r, et_ = w >> 1;
                const bf16_t* gsrc = p.z + (size_t)(t0 + i_) * ZLD + C_RG + hd * 64 + et_ * 32 + 4 * h;
#pragma unroll
                for (int gq = 0; gq < 4; ++gq) sgr[gq] = *(const uint2*)(gsrc + 8 * gq);
            }
            __builtin_amdgcn_sched_barrier(0);
        }
        __syncthreads();
        {
            const int it = w & 1, jt = w >> 1;
            f32x16 acc = zero16();
#pragma unroll
            for (int ks = 0; ks < 4; ++ks) {
                const bf16x8 a = *(const bf16x8*)&Ks[(jt * 32 + r) * 72 + ks * 16 + h * 8];
                const bf16x8 bb = *(const bf16x8*)&Qs[(it * 32 + r) * 72 + ks * 16 + h * 8];
                acc = MFMA32(a, bb, acc);
            }
            const int i = it * 32 + r;
#pragma unroll
            for (int gq = 0; gq < 4; ++gq) {
                const int j0 = jt * 32 + 8 * gq + 4 * h;
                float pv[4];
#pragma unroll
                for (int u = 0; u < 4; ++u) pv[u] = acc[4 * gq + u] * dec[4 * gq + u];
                uint2 o; o.x = pk2(pv[0], pv[1]); o.y = pk2(pv[2], pv[3]);
                *(uint2*)&Ps[i * 72 + j0] = o;
            }
        }
        __syncthreads();
        const int it = w & 1, et = w >> 1;
        f32x16 acc = zero16();
#pragma unroll
        for (int ks = 0; ks < 4; ++ks) {
            const bf16x8 a = *(const bf16x8*)&VT[(et * 32 + r) * 72 + ks * 16 + h * 8];
            const bf16x8 bb = *(const bf16x8*)&Ps[(it * 32 + r) * 72 + ks * 16 + h * 8];
            acc = MFMA32(a, bb, acc);
        }
#pragma unroll
        for (int ks = 0; ks < 4; ++ks) {
            const bf16x8 a = *(const bf16x8*)&ST[(et * 32 + r) * 72 + ks * 16 + h * 8];
            const bf16x8 bb = *(const bf16x8*)&Qds[(it * 32 + r) * 72 + ks * 16 + h * 8];
            acc = MFMA32(a, bb, acc);
        }
        float s1 = 0.f, s2 = 0.f;
#pragma unroll
        for (int q = 0; q < 16; ++q) { s1 += acc[q]; s2 += acc[q] * acc[q]; }
        s1 += __shfl_xor(s1, 32); s2 += __shfl_xor(s2, 32);
        const int i = it * 32 + r;
        if (h == 0) { red[(et * 64 + i) * 2] = s1; red[(et * 64 + i) * 2 + 1] = s2; }
        __syncthreads();
        {
            const float t1 = red[i * 2] + red[(64 + i) * 2], t2 = red[i * 2 + 1] + red[(64 + i) * 2 + 1];
            const float mean = t1 * (1.f / 64.f);
            const float var = fmaxf(t2 * (1.f / 64.f) - mean * mean, 0.f);
            const float rstd = rsqrtf(var + EPS);
            const int tok = t0 + i;
#pragma unroll
            for (int gq = 0; gq < 4; ++gq) {
                const int e0 = et * 32 + 8 * gq + 4 * h;
                const uint2 sg = sgr[gq];
                uint2 o;
                o.x = pk2((acc[4 * gq] - mean) * rstd * lo_f(sg.x), (acc[4 * gq + 1] - mean) * rstd * hi_f(sg.x));
                o.y = pk2((acc[4 * gq + 2] - mean) * rstd * lo_f(sg.y), (acc[4 * gq + 3] - mean) * rstd * hi_f(sg.y));
                *(uint2*)(p.y + (size_t)tok * 1024 + 256 + hd * 64 + e0) = o;
            }
        }
        {
            const f32x4 kq[4] = {pkv0, pkv1, pkv2, pkv3};
#pragma unroll
            for (int i2 = 0; i2 < 4; ++i2) { const f32x4 t = kq[i2]; st[4 * i2] = st[4 * i2] * cd + t.x; st[4 * i2 + 1] = st[4 * i2 + 1] * cd + t.y; st[4 * i2 + 2] = st[4 * i2 + 2] * cd + t.z; st[4 * i2 + 3] = st[4 * i2 + 3] * cd + t.w; }
            if (c + 1 < 8) { const f32x4* s4 = (const f32x4*)(kvs + (size_t)(c + 1) * 4096); pkv0 = s4[0]; pkv1 = s4[1]; pkv2 = s4[2]; pkv3 = s4[3]; }
            __builtin_amdgcn_sched_barrier(0);
        }
    }
    __syncthreads();
}

DI void attn_item(const Params& p, int item, char* smem) {
    const int qb = 31 - item / 48, bh = item % 48, hd = bh % 6, b = bh / 6;
    float* Fall = (float*)smem;
    LAS unsigned char* lds = (LAS unsigned char*)smem;
    const int tid = ltid(), w = tid >> 6, lane = tid & 63, r = lane & 31, h = lane >> 5;
    const int q0w = qb * 128 + w * 32, qrow = q0w + r;
    const size_t tokq = (size_t)b * 4096 + qrow;
    const float* cfb = p.cf + (size_t)bh * 4096;
    const int nkt = 2 * qb + 2;
    int koff[2], voff[2];
#pragma unroll
    for (int i = 0; i < 2; ++i) { const int R = (w * 2 + i) * 8 + (lane >> 3), c = (lane & 7) ^ ((R >> 1) & 7); koff[i] = R * ZLD + c * 8; voff[i] = R * 4096 + c * 8; }
    const bf16_t* kbase = p.z + (size_t)b * 4096 * ZLD + C_FK + hd * 64;
    const bf16_t* vbase = p.vTf + (size_t)bh * 64 * 4096;
#define ATT_DMA(kt_, s_) { _Pragma("unroll") for (int i_ = 0; i_ < 2; ++i_) { \
        __builtin_amdgcn_global_load_lds((const unsigned*)(kbase + (size_t)(kt_) * 64 * ZLD + koff[i_]), (LAS unsigned*)(lds + 16384 + (s_) * 16384 + (w * 2 + i_) * 1024), 16, 0, 0); \
        __builtin_amdgcn_global_load_lds((const unsigned*)(vbase + (kt_) * 64 + voff[i_]), (LAS unsigned*)(lds + 16384 + (s_) * 16384 + 8192 + (w * 2 + i_) * 1024), 16, 0, 0); } }
    __syncthreads();
    ATT_DMA(nkt - 1, (nkt - 1) % 3)
    ATT_DMA(nkt - 2, (nkt - 2) % 3)
#pragma unroll
    for (int i = 0; i < 4; ++i) {
        const int i4 = tid + i * NTHREADS;
        if (i4 * 4 < nkt * 64) { const f32x4 c = ((const f32x4*)cfb)[i4]; ((f32x4*)Fall)[i4] = c * LOG2E; }
    }
    bf16x8 qf[4];
#pragma unroll
    for (int ks = 0; ks < 4; ++ks) qf[ks] = *(const bf16x8*)(p.z + tokq * ZLD + C_FQ + hd * 64 + ks * 16 + h * 8);
    const float Fi = cfb[qrow] * LOG2E;
    float* knp = (float*)(smem + 65536);
    int* flg = (int*)(smem + 65536 + 256);
    if (w == 0) {
        float kv = (lane < nkt) ? p.kn[bh * 64 + lane] : 0.f;
#pragma unroll
        for (int o = 1; o < 64; o <<= 1) { const float y = __shfl_up(kv, o); if (lane >= o) kv = fmaxf(kv, y); }
        knp[lane] = kv * 1.02f;
    }
    float qn;
    {
        float ssq = 0.f;
#pragma unroll
        for (int ks = 0; ks < 4; ++ks)
#pragma unroll
            for (int j = 0; j < 8; ++j) { const float qv = bf2f((unsigned)(unsigned short)qf[ks][j]); ssq += qv * qv; }
        ssq += __shfl_xor(ssq, 32);
        qn = sqrtf(ssq);
    }
    f32x16 O[2] = {zero16(), zero16()};
    float m = -INFINITY, l = 0.f;
    const int fsw = (r >> 1) & 7;
    for (int kt = nkt - 1; kt >= 0; --kt) {
        bool wdone = false;
        if (kt < nkt - 1) { const float bnd = qn * knp[kt] + Fi - Fall[kt * 64 + 63]; wdone = (__ballot(!(bnd < m - SKIP_T)) == 0ull); }
        if (lane == 0) flg[(kt & 3) * 4 + w] = wdone ? 1 : 0;
        if (kt > 0) asm volatile("s_waitcnt vmcnt(4)" ::: "memory"); else asm volatile("s_waitcnt vmcnt(0)" ::: "memory");
        __syncthreads();
        {
            const int4 fl = *(const int4*)&flg[(kt & 3) * 4];
            if (fl.x & fl.y & fl.z & fl.w) break;
        }
        if (kt >= 2) ATT_DMA(kt - 2, (kt - 2) % 3)
        const int kmin = kt * 64;
        if (!wdone && kmin <= q0w + 31) {
            const char* Kt = smem + 16384 + (kt % 3) * 16384;
            const char* Vt = Kt + 8192;
            f32x16 S[2];
#pragma unroll
            for (int jt = 0; jt < 2; ++jt)
#pragma unroll
                for (int gq = 0; gq < 4; ++gq) {
                    const f32x4 fk = *(const f32x4*)&Fall[kmin + jt * 32 + 8 * gq + 4 * h];
                    S[jt][4 * gq] = Fi - fk.x; S[jt][4 * gq + 1] = Fi - fk.y; S[jt][4 * gq + 2] = Fi - fk.z; S[jt][4 * gq + 3] = Fi - fk.w;
                }
#pragma unroll
            for (int jt = 0; jt < 2; ++jt)
#pragma unroll
                for (int ks = 0; ks < 4; ++ks) {
                    const bf16x8 a = *(const bf16x8*)(Kt + (jt * 32 + r) * 128 + (((2 * ks + h) ^ fsw) * 16));
                    S[jt] = MFMA32(a, qf[ks], S[jt]);
                }
            if (kmin + 63 > q0w) {
#pragma unroll
                for (int jt = 0; jt < 2; ++jt)
#pragma unroll
                    for (int q = 0; q < 16; ++q) { const int key = kmin + jt * 32 + crow(q, h); if (key > qrow) S[jt][q] = -INFINITY; }
            }
            float mx = S[0][0];
#pragma unroll
            for (int q = 1; q < 16; ++q) mx = fmaxf(mx, S[0][q]);
#pragma unroll
            for (int q = 0; q < 16; ++q) mx = fmaxf(mx, S[1][q]);
            mx = fmaxf(mx, __shfl_xor(mx, 32));
            if (__ballot(mx > m - SKIP_T) != 0ull) {
                const float mnew = fmaxf(m, mx);
                const float alpha = __builtin_amdgcn_exp2f(m - mnew);
                m = mnew;
                float ls = 0.f;
#pragma unroll
                for (int jt = 0; jt < 2; ++jt)
#pragma unroll
                    for (int q = 0; q < 16; ++q) { const float pv = __builtin_amdgcn_exp2f(S[jt][q] - mnew); S[jt][q] = pv; ls += pv; }
                l = l * alpha + ls;
                if (__ballot(alpha != 1.f) != 0ull) {
#pragma unroll
                    for (int et = 0; et < 2; ++et)
#pragma unroll
                        for (int q = 0; q < 16; ++q) O[et][q] *= alpha;
                }
#pragma unroll
                for (int jt = 0; jt < 2; ++jt)
#pragma unroll
                    for (int s2 = 0; s2 < 2; ++s2) {
                        uint4 pw;
                        pw.x = pk2(S[jt][8 * s2], S[jt][8 * s2 + 1]); pw.y = pk2(S[jt][8 * s2 + 2], S[jt][8 * s2 + 3]);
                        pw.z = pk2(S[jt][8 * s2 + 4], S[jt][8 * s2 + 5]); pw.w = pk2(S[jt][8 * s2 + 6], S[jt][8 * s2 + 7]);
                        const bf16x8 pf = __builtin_bit_cast(bf16x8, pw);
#pragma unroll
                        for (int et = 0; et < 2; ++et) {
                            const char* vrow = Vt + (et * 32 + r) * 128 + 8 * h;
                            const s16x4 lo = *(const s16x4*)(vrow + (((4 * jt + 2 * s2) ^ fsw) * 16)), hi = *(const s16x4*)(vrow + (((4 * jt + 2 * s2 + 1) ^ fsw) * 16));
                            const bf16x8 vf = __builtin_shufflevector(lo, hi, 0, 1, 2, 3, 4, 5, 6, 7);
                            O[et] = MFMA32(vf, pf, O[et]);
                        }
                    }
            }
        }
    }
    asm volatile("s_waitcnt vmcnt(0)" ::: "memory");
    l += __shfl_xor(l, 32);
    const float inv = 1.f / l;
#pragma unroll
    for (int et = 0; et < 2; ++et)
#pragma unroll
        for (int gq = 0; gq < 4; ++gq) {
            const int e0 = et * 32 + 8 * gq + 4 * h;
            const uint2 sg = *(const uint2*)(p.z + tokq * ZLD + C_FG + hd * 64 + e0);
            uint2 o;
            o.x = pk2(O[et][4 * gq] * inv * lo_f(sg.x), O[et][4 * gq + 1] * inv * hi_f(sg.x));
            o.y = pk2(O[et][4 * gq + 2] * inv * lo_f(sg.y), O[et][4 * gq + 3] * inv * hi_f(sg.y));
            *(uint2*)(p.y + tokq * 1024 + 640 + hd * 64 + e0) = o;
        }
}

DI void phase2b(const Params& p, int layer, char* smem, int cidx) {
    constexpr int N_ATT = 1536, N_RET = 384, N_A = 1024;
    const int n_w = (layer == 0) ? I_IN + I_OUT : 0;
    int* s_item = (int*)(smem + LDS_MAIN + 16);
    for (;;) {
        if (threadIdx.x == 0) *s_item = (int)atomicAdd(p.ctr + cidx, 1u);
        __syncthreads();
        const int it = *s_item;
        __syncthreads();
        if (it >= N_RET + N_ATT + N_A + n_w) break;
        if (it < N_RET) ret_item(p, it, smem);
        else if (it < N_RET + N_ATT) { __builtin_amdgcn_s_setprio(2); attn_item(p, it - N_RET, smem); __builtin_amdgcn_s_setprio(0); }
        else if (it < N_RET + N_ATT + N_A) abranch_item(p, layer, it - N_RET - N_ATT, smem);
        else wt_item(p, 1, it - N_RET - N_ATT - N_A, (float*)smem);
        __syncthreads();
    }
}

DI void phase4(const Params& p, int layer, char* smem) {
    const int tid = ltid(), wv = tid >> 6, lane = tid & 63;
    const f32x4* pg = (const f32x4*)(p.post_g + layer * 1024);
    for (int row = (blockIdx.x * 4 + wv) * 2; row < NTOK; row += gridDim.x * 8) {
        f32x4 v[2][4], xv[2][4]; float ss[2] = {0.f, 0.f};
#pragma unroll
        for (int q = 0; q < 2; ++q)
#pragma unroll
            for (int j = 0; j < 2; ++j) { const uint4 ow = ((const uint4*)(p.o + (size_t)(row + q) * 1024))[lane + 64 * j]; v[q][2 * j] = (f32x4){lo_f(ow.x), hi_f(ow.x), lo_f(ow.y), hi_f(ow.y)}; v[q][2 * j + 1] = (f32x4){lo_f(ow.z), hi_f(ow.z), lo_f(ow.w), hi_f(ow.w)};
                if (layer == 0) { xv[q][2 * j] = ((const f32x4*)(p.x + (size_t)(row + q) * 1024))[IDX4(2 * j)]; xv[q][2 * j + 1] = ((const f32x4*)(p.x + (size_t)(row + q) * 1024))[IDX4(2 * j + 1)]; }
                else { const uint4 xw = ((const uint4*)(p.x1b + (size_t)(row + q) * 1024))[lane + 64 * j]; xv[q][2 * j] = (f32x4){lo_f(xw.x), hi_f(xw.x), lo_f(xw.y), hi_f(xw.y)}; xv[q][2 * j + 1] = (f32x4){lo_f(xw.z), hi_f(xw.z), lo_f(xw.w), hi_f(xw.w)}; } }
#pragma unroll
        for (int q = 0; q < 2; ++q)
#pragma unroll
            for (int j = 0; j < 4; ++j) ss[q] += (v[q][j].x * v[q][j].x + v[q][j].y * v[q][j].y) + (v[q][j].z * v[q][j].z + v[q][j].w * v[q][j].w);
#pragma unroll
        for (int o = 1; o < 64; o <<= 1) { ss[0] += __shfl_xor(ss[0], o); ss[1] += __shfl_xor(ss[1], o); }
        float s2[2] = {0.f, 0.f};
#pragma unroll
        for (int q = 0; q < 2; ++q) {
            const float rstd = rsqrtf(ss[q] * (1.f / 1024.f) + EPS);
#pragma unroll
            for (int j = 0; j < 4; ++j) {
                const f32x4 g = pg[IDX4(j)];
                v[q][j] = xv[q][j] + v[q][j] * rstd * g;
                if (layer != 0) ((f32x4*)(p.out + (size_t)(row + q) * 1024))[IDX4(j)] = v[q][j];
                s2[q] += (v[q][j].x * v[q][j].x + v[q][j].y * v[q][j].y) + (v[q][j].z * v[q][j].z + v[q][j].w * v[q][j].w);
            }
        }
        if (layer == 0) {
#pragma unroll
            for (int o = 1; o < 64; o <<= 1) { s2[0] += __shfl_xor(s2[0], o); s2[1] += __shfl_xor(s2[1], o); }
#pragma unroll
            for (int q = 0; q < 2; ++q) {
                if (lane == 0) p.rs[row + q] = rsqrtf(s2[q] * (1.f / 1024.f) + EPS);
#pragma unroll
                for (int j = 0; j < 2; ++j) {
                    const f32x4 va = v[q][2 * j], vb = v[q][2 * j + 1];
                    uint4 xw; xw.x = pk2(va.x, va.y); xw.y = pk2(va.z, va.w); xw.z = pk2(vb.x, vb.y); xw.w = pk2(vb.z, vb.w);
                    ((uint4*)(p.x1b + (size_t)(row + q) * 1024))[lane + 64 * j] = xw;
                }
            }
        }
    }
}

template <int PH>
__global__ void __launch_bounds__(NTHREADS, 2) __attribute__((amdgpu_waves_per_eu(2, 2))) k_phase(Params p, int layer) {
    extern __shared__ __attribute__((aligned(16))) char smem[];
    if (PH == 0) phase0(p, smem);
    else if (PH == 1) gemm_phase<0>(p, layer, smem);
    else if (PH == 2) phase2a(p, layer, smem);
    else if (PH == 3) phase2b(p, layer, smem, layer);
    else if (PH == 4) gemm_phase<1>(p, layer, smem);
    else phase4(p, layer, smem);
}

#if MEGA
__global__ void __launch_bounds__(NTHREADS, 2) __attribute__((amdgpu_waves_per_eu(2, 2))) k_mega(Params p) {
    extern __shared__ __attribute__((aligned(16))) char smem[];
    cg::grid_group grid = cg::this_grid();
    volatile LAS unsigned* st = (volatile LAS unsigned*)(smem + LDS_MAIN);
    if (threadIdx.x < 2) st[threadIdx.x] = 0u;
    __syncthreads();
    const XcdBarrier xb = xcd_barrier_post(p.bar, st);
    phase0(p, smem);
    if (p.never) grid.sync();
    xcd_barrier(xb);
    if (PROBE_PH == 10) { for (int i = 0; i < 10; ++i) xcd_barrier(xb); }
#pragma nounroll
    for (int layer = 0; layer < 2; ++layer) {
        gemm_phase<0>(p, layer, smem);
        xcd_barrier(xb);
        if ((PROBE_PH == 1 && layer == 0) || (PROBE_PH == 11 && layer == 1)) { gemm_phase<0>(p, layer, smem); xcd_barrier(xb); }
        phase2a(p, layer, smem);
        xcd_barrier(xb);
        if (PROBE_PH == 2 && layer == 0) { phase2a(p, layer, smem); xcd_barrier(xb); }
        phase2b(p, layer, smem, layer);
        xcd_barrier(xb);
        if (PROBE_PH == 3 && layer == 0) { phase2b(p, layer, smem, 2); xcd_barrier(xb); }
        gemm_phase<1>(p, layer, smem);
        xcd_barrier(xb);
        if (PROBE_PH == 4 && layer == 0) { gemm_phase<1>(p, layer, smem); xcd_barrier(xb); }
        phase4(p, layer, smem);
        if (PROBE_PH == 5 && layer == 0) { xcd_barrier(xb); phase4(p, layer, smem); }
        if (layer == 0) xcd_barrier(xb);
    }
}
#endif

extern "C" void kernel_launch(void* const* d_in, const int* in_sizes, int n_in, void* d_out, int out_size, void* d_ws, size_t ws_size, hipStream_t stream) {
    static int grid_blocks = 0;
    if (grid_blocks == 0) {
        if (ws_size < WS_END) { fprintf(stderr, "kernel_launch: workspace too small: %zu < %zu\n", ws_size, (size_t)WS_END); grid_blocks = -1; return; }
        int dev = 0, cus = 0, per_cu = 0;
        hipGetDevice(&dev);
        hipDeviceGetAttribute(&cus, hipDeviceAttributeMultiprocessorCount, dev);
#if MEGA
        hipFuncSetAttribute((const void*)k_mega, hipFuncAttributeMaxDynamicSharedMemorySize, LDS_BYTES);
        hipOccupancyMaxActiveBlocksPerMultiprocessor(&per_cu, (const void*)k_mega, NTHREADS, LDS_BYTES);
#else
        hipFuncSetAttribute((const void*)k_phase<0>, hipFuncAttributeMaxDynamicSharedMemorySize, LDS_BYTES);
        hipFuncSetAttribute((const void*)k_phase<1>, hipFuncAttributeMaxDynamicSharedMemorySize, LDS_BYTES);
        hipFuncSetAttribute((const void*)k_phase<2>, hipFuncAttributeMaxDynamicSharedMemorySize, LDS_BYTES);
        hipFuncSetAttribute((const void*)k_phase<3>, hipFuncAttributeMaxDynamicSharedMemorySize, LDS_BYTES);
        hipFuncSetAttribute((const void*)k_phase<4>, hipFuncAttributeMaxDynamicSharedMemorySize, LDS_BYTES);
        hipFuncSetAttribute((const void*)k_phase<5>, hipFuncAttributeMaxDynamicSharedMemorySize, LDS_BYTES);
        per_cu = 2;
#endif
        if (per_cu < 1) per_cu = 1;
        if (per_cu > 2) per_cu = 2;
        grid_blocks = cus * per_cu;
    }
    if (grid_blocks < 0) return;
    Params p{};
    p.x = (const float*)d_in[0]; p.pre_g = (const float*)d_in[1]; p.post_g = (const float*)d_in[2]; p.w_in = (const float*)d_in[3];
    p.b_f = (const float*)d_in[4]; p.a_ng = (const float*)d_in[5]; p.a_sw = (const float*)d_in[6]; p.a_sb = (const float*)d_in[7]; p.w_out = (const float*)d_in[8];
    p.out = (float*)d_out;
    char* ws = (char*)d_ws;
    p.ctr = (unsigned*)(ws + WS_CTR);
    p.bar = (unsigned*)(ws + WS_BAR);
    p.WinT = (bf16_t*)(ws + WS_WINT); p.WoutT = (bf16_t*)(ws + WS_WOUTT); p.WsA = (bf16_t*)(ws + WS_WSA);
    p.rope = (float*)(ws + WS_ROPE); p.lf = (float*)(ws + WS_LF); p.cf = (float*)(ws + WS_CF);
    p.vTf = (bf16_t*)(ws + WS_VTF); p.vTr = (bf16_t*)(ws + WS_VTR);
    p.hb = (bf16_t*)(ws + WS_HB); p.y = (bf16_t*)(ws + WS_Y); p.kv = (float*)(ws + WS_KV);
    p.z = (bf16_t*)(ws + WS_Z); p.kn = (float*)(ws + WS_KN); p.rs = (float*)(ws + WS_RS); p.x1b = (bf16_t*)(ws + WS_X1B); p.o = (bf16_t*)(ws + WS_HB);
#if MEGA
    hipMemsetAsync(ws + WS_BAR, 0, XCD_BAR_WORDS * 4, stream);
    void* args[] = {&p};
    hipError_t e = hipLaunchCooperativeKernel((void*)k_mega, dim3(grid_blocks), dim3(NTHREADS), args, LDS_BYTES, stream);
    if (e != hipSuccess) fprintf(stderr, "cooperative launch failed: %s (grid %d)\n", hipGetErrorString(e), grid_blocks);
#else
    const dim3 g(grid_blocks), bl(NTHREADS);
    hipLaunchKernelGGL(k_phase<0>, g, bl, LDS_BYTES, stream, p, 0);
    for (int layer = 0; layer < 2; ++layer) {
        hipLaunchKernelGGL(k_phase<1>, g, bl, LDS_BYTES, stream, p, layer);
        hipLaunchKernelGGL(k_phase<2>, g, bl, LDS_BYTES, stream, p, layer);
        hipLaunchKernelGGL(k_phase<3>, g, bl, LDS_BYTES, stream, p, layer);
        hipLaunchKernelGGL(k_phase<4>, g, bl, LDS_BYTES, stream, p, layer);
        hipLaunchKernelGGL(k_phase<5>, g, bl, LDS_BYTES, stream, p, layer);
    }
#endif
}
```

```cpp
#include <hip/hip_runtime.h>
#include <hip/hip_cooperative_groups.h>
#include <cstdint>
#include <cstdio>
namespace cg = cooperative_groups;

#ifndef PROBE_PH
#define PROBE_PH -1
#endif
#ifndef MEGA
#define MEGA 1
#endif

#define DI __device__ __forceinline__
typedef unsigned short bf16_t;
typedef short bf16x8 __attribute__((ext_vector_type(8)));
typedef short s16x4 __attribute__((ext_vector_type(4)));
typedef float f32x4 __attribute__((ext_vector_type(4)));
typedef float f32x16 __attribute__((ext_vector_type(16)));

constexpr int NB = 8, SEQ = 4096, DM = 1024, NTOK = NB * SEQ, DIN = 3846, ZLD = 3072, NPAD = 3968;
constexpr int NTHREADS = 256;
constexpr float EPS = 1e-6f;
constexpr float LOG2E = 1.4426950408889634f;
constexpr float SKIP_T = 40.f;
constexpr int C_AU = 0, C_AV = 256, C_AG = 512, C_RQ = 768, C_RK = 1152, C_RG = 1536, C_FQ = 1920, C_FK = 2304, C_FG = 2688;
constexpr int LDS_MAIN = 2 * 2 * 128 * 72 * 2;
constexpr int LDS_BYTES = LDS_MAIN + 64;

struct Params {
    const float *x, *pre_g, *post_g, *w_in, *b_f, *a_ng, *a_sw, *a_sb, *w_out;
    float* out;
    bf16_t *WinT, *WoutT, *WsA, *hb, *z, *y, *vTf, *vTr, *x1b;
    bf16_t* o;
    float *kv, *lf, *cf, *rope, *kn;
    unsigned* ctr;
    unsigned* bar;
    int never;
    int pad0;
};

constexpr size_t WS_CTR = 0;
constexpr size_t WS_BAR = 256;
constexpr size_t WS_WINT = 256 + 16384;
constexpr size_t WS_WOUTT = WS_WINT + (size_t)2 * NPAD * 1024 * 2;
constexpr size_t WS_WSA = WS_WOUTT + (size_t)2 * 1024 * 1024 * 2;
constexpr size_t WS_ROPE = WS_WSA + (size_t)2 * 4 * 128 * 128 * 2;
constexpr size_t WS_LF = WS_ROPE + (size_t)4096 * 32 * 2 * 4;
constexpr size_t WS_CF = WS_LF + (size_t)48 * 4096 * 4;
constexpr size_t WS_VTF = WS_CF + (size_t)48 * 4096 * 4;
constexpr size_t WS_VTR = WS_VTF + (size_t)48 * 64 * 4096 * 2;
constexpr size_t WS_HB = WS_VTR + (size_t)48 * 64 * 4096 * 2;
constexpr size_t WS_Y = WS_HB + (size_t)NTOK * 1024 * 2;
constexpr size_t WS_KV = WS_Y + (size_t)NTOK * 1024 * 2;
constexpr size_t WS_Z = WS_KV + (size_t)3072 * 4096 * 4;
constexpr size_t WS_X1B = WS_Z + (size_t)NTOK * ZLD * 2;
constexpr size_t WS_KN = WS_X1B + (size_t)NTOK * 1024 * 2;
constexpr size_t WS_END = WS_KN + 16384;

DI int ltid() { int t = threadIdx.x; asm volatile("" : "+v"(t)); return t; }
DI float bf2f(unsigned v) { return __uint_as_float(v << 16); }
typedef __bf16 bf16v2_t __attribute__((ext_vector_type(2)));
typedef float f32x2_t __attribute__((ext_vector_type(2)));
DI unsigned pk2(float lo, float hi) { const f32x2_t v = {lo, hi}; return __builtin_bit_cast(unsigned, __builtin_convertvector(v, bf16v2_t)); }
DI bf16_t f2bf(float x) { return (bf16_t)(pk2(x, 0.f) & 0xffffu); }
DI float lo_f(unsigned w) { return __uint_as_float(w << 16); }
DI float hi_f(unsigned w) { return __uint_as_float(w & 0xffff0000u); }
DI int crow(int reg, int h) { return (reg & 3) + 8 * (reg >> 2) + 4 * h; }
#define IDX4(jj) ((lane + 64 * ((jj) >> 1)) * 2 + ((jj) & 1))
DI float wave_sum(float v) {
#pragma unroll
    for (int o = 1; o < 64; o <<= 1) v += __shfl_xor(v, o);
    return v;
}
DI float silu_f(float x) { return x * __builtin_amdgcn_rcpf(1.f + __builtin_amdgcn_exp2f(-LOG2E * x)); }
DI float gelu_tanh_f(float x) { const float u = (-2.f * LOG2E * 0.7978845608028654f) * (x + 0.044715f * x * x * x); return x * __builtin_amdgcn_rcpf(1.f + __builtin_amdgcn_exp2f(u)); }
DI float logsigmoid_f(float x) { return fminf(x, 0.f) - log1pf(__expf(-fabsf(x))); }
#define MFMA32(a, b, c) __builtin_amdgcn_mfma_f32_32x32x16_bf16((a), (b), (c), 0, 0, 0)
#define MFMA16(a, b, c) __builtin_amdgcn_mfma_f32_16x16x32_bf16((a), (b), (c), 0, 0, 0)
DI f32x16 zero16() { f32x16 z; for (int i = 0; i < 16; ++i) z[i] = 0.f; return z; }

#define XB_TMO      128
#define XB_XCNT(j)  (256  + 64 * (j))
#define XB_XSUB(j)  (1280 + 64 * (j))
#define XB_XGEN(j)  (2304 + 64 * (j))
#define XB_TOP      3328
#define XB_TOPGEN   3392
#define XCD_BAR_WORDS 3456
#define XB_SPIN_CAP (1u << 18)
#define LAS __attribute__((address_space(3)))

__device__ __forceinline__ unsigned xb_ld(unsigned* p)              { return __hip_atomic_load(p, __ATOMIC_RELAXED, __HIP_MEMORY_SCOPE_AGENT); }
__device__ __forceinline__ unsigned xb_add(unsigned* p, unsigned v) { return __hip_atomic_fetch_add(p, v, __ATOMIC_RELAXED, __HIP_MEMORY_SCOPE_AGENT); }
__device__ __forceinline__ unsigned xb_xcc_id() { return (unsigned)__builtin_amdgcn_s_getreg((3 << 11) | 20) & 0xFu; }
#define XB_SPIN(cond, bar) do { unsigned _sp = 0; while (cond) { __builtin_amdgcn_s_sleep(1); \
    if ((++_sp & 255u) == 0u) { if (xb_ld(&(bar)[XB_TMO])) break; if (_sp > XB_SPIN_CAP) { atomicAdd(&(bar)[XB_TMO], 1u); break; } } } } while (0)

struct XcdBarrier {
    unsigned* bar; unsigned x;
    volatile LAS unsigned* st;
};

__device__ __forceinline__ XcdBarrier xcd_barrier_post(unsigned* bar, volatile LAS unsigned* st) {
    XcdBarrier b; b.bar = bar; b.x = xb_xcc_id(); b.st = st;
    if (threadIdx.x == 0) (void)xb_add(&bar[XB_XCNT(b.x)], 1u);
    return b;
}
__device__ __forceinline__ void xcd_barrier_complete(unsigned* bar, unsigned x, unsigned& nloc, unsigned& nx) {
    const unsigned G = gridDim.x * gridDim.y * gridDim.z;
    unsigned sum, cnt, mine, sp = 0u;
    for (;;) {
        sum = 0u; cnt = 0u; mine = 0u;
#pragma unroll
        for (unsigned j = 0; j < 16; ++j) { const unsigned c = xb_ld(&bar[XB_XCNT(j)]); sum += c; cnt += (c > 0u) ? 1u : 0u; mine = (j == x) ? c : mine; }
        if (sum == G) break;
        __builtin_amdgcn_s_sleep(1);
        if ((++sp & 255u) == 0u) { if (xb_ld(&bar[XB_TMO])) break; if (sp > XB_SPIN_CAP) { atomicAdd(&bar[XB_TMO], 1u); break; } }
    }
    nloc = mine > 0u ? mine : 1u; nx = cnt > 0u ? cnt : 1u;
}

__device__ __forceinline__ void xcd_barrier(const XcdBarrier& b) {
    asm volatile("s_waitcnt vmcnt(0)" ::: "memory");
    __syncthreads();
    if (threadIdx.x == 0) {
        unsigned* bar = b.bar;
        __builtin_amdgcn_s_waitcnt(0);
        unsigned nloc = b.st[0], nx = b.st[1];
        if (nloc == 0u) { xcd_barrier_complete(bar, b.x, nloc, nx); b.st[0] = nloc; b.st[1] = nx; }
        const unsigned old = xb_add(&bar[XB_XSUB(b.x)], 1u);
        const unsigned gen = old / nloc;
        if (old + 1u == (gen + 1u) * nloc) {
            __builtin_amdgcn_fence(__ATOMIC_RELEASE, "agent");
            asm volatile("s_waitcnt vmcnt(0)" ::: "memory");
            const unsigned og = xb_add(&bar[XB_TOP], 1u);
            const unsigned tg = og / nx;
            if (og + 1u == (tg + 1u) * nx) xb_add(&bar[XB_TOPGEN], 1u);
            else XB_SPIN(xb_ld(&bar[XB_TOPGEN]) == tg, bar);
            __builtin_amdgcn_fence(__ATOMIC_ACQUIRE, "agent");
            xb_add(&bar[XB_XGEN(b.x)], 1u);
            asm volatile("s_waitcnt vmcnt(0)" ::: "memory");
        } else {
            XB_SPIN(xb_ld(&bar[XB_XGEN(b.x)]) == gen, bar);
            __builtin_amdgcn_fence(__ATOMIC_ACQUIRE, "agent");
            asm volatile("s_waitcnt vmcnt(0)" ::: "memory");
        }
    }
    __syncthreads();
}

DI void transpose_item(const float* __restrict__ W, int N, int NP, bf16_t* __restrict__ WT, int item, float* scr) {
    const int tid = ltid();
    const int nblk = NP / 64, kb = item / nblk, nb = item % nblk, k0 = kb * 64, n0 = nb * 64;
#pragma unroll
    for (int i = 0; i < 16; ++i) {
        const int kk = i * 4 + (tid >> 6), nn = tid & 63;
        scr[kk * 65 + nn] = (n0 + nn < N) ? W[(size_t)(k0 + kk) * N + n0 + nn] : 0.f;
    }
    __syncthreads();
    const int n = tid >> 2, c = tid & 3;
    uint4 o0, o1;
    const float* s = scr + (c * 16) * 65 + n;
    o0.x = pk2(s[0 * 65], s[1 * 65]); o0.y = pk2(s[2 * 65], s[3 * 65]); o0.z = pk2(s[4 * 65], s[5 * 65]); o0.w = pk2(s[6 * 65], s[7 * 65]);
    o1.x = pk2(s[8 * 65], s[9 * 65]); o1.y = pk2(s[10 * 65], s[11 * 65]); o1.z = pk2(s[12 * 65], s[13 * 65]); o1.w = pk2(s[14 * 65], s[15 * 65]);
    uint4* dst = (uint4*)(WT + (size_t)(n0 + n) * 1024 + k0 + c * 16);
    dst[0] = o0; dst[1] = o1;
    __syncthreads();
}

DI void rms_row_to_bf16(const float* xrow, const float* gain, bf16_t* orow, int lane) {
    f32x4 v[4]; float ss = 0.f;
#pragma unroll
    for (int j = 0; j < 4; ++j) { v[j] = ((const f32x4*)xrow)[lane + 64 * j]; ss += (v[j].x * v[j].x + v[j].y * v[j].y) + (v[j].z * v[j].z + v[j].w * v[j].w); }
    const float rstd = rsqrtf(wave_sum(ss) * (1.f / 1024.f) + EPS);
#pragma unroll
    for (int j = 0; j < 4; ++j) {
        const f32x4 g = ((const f32x4*)gain)[lane + 64 * j];
        uint2 w; w.x = pk2(v[j].x * rstd * g.x, v[j].y * rstd * g.y); w.y = pk2(v[j].z * rstd * g.z, v[j].w * rstd * g.w);
        ((uint2*)orow)[lane + 64 * j] = w;
    }
}

constexpr int I_IN = 16 * (NPAD / 64), I_OUT = 16 * 16;
DI void wt_item(const Params& p, int l, int it, float* scr) {
    if (it < I_IN) transpose_item(p.w_in + (size_t)l * 1024 * DIN, DIN, NPAD, p.WinT + (size_t)l * NPAD * 1024, it, scr);
    else transpose_item(p.w_out + (size_t)l * 1024 * 1024, 1024, 1024, p.WoutT + (size_t)l * 1024 * 1024, it - I_IN, scr);
}
DI void phase0(const Params& p, char* smem) {
    const int tid = ltid(), G = gridDim.x;
    if (blockIdx.x == 0 && tid < 8) p.ctr[tid] = 0u;
    float* scr = (float*)smem;
    for (int it = blockIdx.x; it < I_IN + I_OUT; it += G) wt_item(p, 0, it, scr);
    const int gt = blockIdx.x * NTHREADS + tid, GT = G * NTHREADS;
    for (int idx = gt; idx < 2 * 4 * 128 * 128; idx += GT) {
        const int i = (idx >> 7) & 127, j = idx & 127;
        const float w = p.a_sw[idx];
        p.WsA[idx] = f2bf(((j >> 6) <= (i >> 6)) ? w : 0.f);
    }
    for (int idx = gt; idx < 4096 * 32; idx += GT) {
        const int pos = idx >> 5, i = idx & 31;
        const float inv = powf(10000.f, -(float)i / 32.f);
        const float ang = (float)pos * inv;
        float sn, cs; sincosf(ang, &sn, &cs);
        p.rope[2 * idx] = cs; p.rope[2 * idx + 1] = sn;
    }
    const int wv = tid >> 6, lane = tid & 63;
    for (int row = (blockIdx.x * 4 + wv) * 2; row < NTOK; row += G * 8) {
        f32x4 v[2][4]; float ss[2] = {0.f, 0.f};
#pragma unroll
        for (int q = 0; q < 2; ++q)
#pragma unroll
            for (int j = 0; j < 4; ++j) v[q][j] = ((const f32x4*)(p.x + (size_t)(row + q) * 1024))[IDX4(j)];
#pragma unroll
        for (int q = 0; q < 2; ++q)
#pragma unroll
            for (int j = 0; j < 4; ++j) ss[q] += (v[q][j].x * v[q][j].x + v[q][j].y * v[q][j].y) + (v[q][j].z * v[q][j].z + v[q][j].w * v[q][j].w);
#pragma unroll
        for (int o = 1; o < 64; o <<= 1) { ss[0] += __shfl_xor(ss[0], o); ss[1] += __shfl_xor(ss[1], o); }
#pragma unroll
        for (int q = 0; q < 2; ++q) {
            const float rstd = rsqrtf(ss[q] * (1.f / 1024.f) + EPS);
#pragma unroll
            for (int j = 0; j < 2; ++j) {
                const f32x4 ga = ((const f32x4*)p.pre_g)[IDX4(2 * j)], gb = ((const f32x4*)p.pre_g)[IDX4(2 * j + 1)], va = v[q][2 * j], vb = v[q][2 * j + 1];
                uint4 w2; w2.x = pk2(va.x * rstd * ga.x, va.y * rstd * ga.y); w2.y = pk2(va.z * rstd * ga.z, va.w * rstd * ga.w);
                w2.z = pk2(vb.x * rstd * gb.x, vb.y * rstd * gb.y); w2.w = pk2(vb.z * rstd * gb.z, vb.w * rstd * gb.w);
                ((uint4*)(p.hb + (size_t)(row + q) * 1024))[lane + 64 * j] = w2;
            }
        }
    }
}

template <int MODE>
DI void gemm_phase(const Params& p, int layer, char* smem) {
    const bf16_t* __restrict__ A = MODE == 0 ? p.hb : p.y;
    const bf16_t* __restrict__ Bt = MODE == 0 ? p.WinT + (size_t)layer * NPAD * 1024 : p.WoutT + (size_t)layer * 1024 * 1024;
    constexpr int NTN = MODE == 0 ? 30 : 8, K = 1024, NKT = K / 64;
    const int ntiles = 256 * NTN;
    bf16_t* As = (bf16_t*)smem;
    bf16_t* Bs = As + 2 * 128 * 72;
    const int tid = ltid(), w = tid >> 6, lane = tid & 63, r = lane & 31, h = lane >> 5, wm = w >> 1, wn = w & 1;
    const bool xmap = (gridDim.x & 7) == 0;
    const int xcd = blockIdx.x & 7, nper = gridDim.x >> 3;
    const int tstart = xmap ? (int)(blockIdx.x >> 3) : (int)blockIdx.x, tend = xmap ? 32 * NTN : ntiles, tstep = xmap ? nper : (int)gridDim.x;
#define TILE_MN(t_, m0_, n0_, nt_) { const int grp_ = (t_) / (8 * NTN), rr_ = (t_) % (8 * NTN); nt_ = rr_ >> 3; m0_ = ((xmap ? xcd * 32 : 0) + grp_ * 8 + (rr_ & 7)) * 128; n0_ = nt_ * 128; }
    int goff[4];
#pragma unroll
    for (int i = 0; i < 4; ++i) { const int R = w * 32 + i * 8 + (lane >> 3); goff[i] = R * K + (((lane & 7) ^ ((R >> 1) & 7)) * 8); }
    LAS unsigned char* lds = (LAS unsigned char*)smem;
#define DMA_SLAB(pa, pb, koff, bufi) { _Pragma("unroll") for (int i_ = 0; i_ < 4; ++i_) { \
        __builtin_amdgcn_global_load_lds((const unsigned*)((pa) + goff[i_] + (koff)), (LAS unsigned*)(lds + (bufi) * 32768 + (w * 4 + i_) * 1024), 16, 0, 0); \
        __builtin_amdgcn_global_load_lds((const unsigned*)((pb) + goff[i_] + (koff)), (LAS unsigned*)(lds + (bufi) * 32768 + 16384 + (w * 4 + i_) * 1024), 16, 0, 0); } }
    const bf16_t *ga = A, *gb = Bt;
    if (tstart < tend) {
        int m0f, n0f, ntf;
        TILE_MN(tstart, m0f, n0f, ntf)
        ga = A + (size_t)m0f * K; gb = Bt + (size_t)n0f * K;
        DMA_SLAB(ga, gb, 0, 0)
    }
    asm volatile("s_waitcnt vmcnt(0)" ::: "memory");
    __syncthreads();
    const int l15 = lane & 15, q4 = lane >> 4, fsw = (l15 >> 1) & 7;
    for (int t = tstart; t < tend; t += tstep) {
        int m0, n0, nt;
        TILE_MN(t, m0, n0, nt)
        const bf16_t *gan = ga, *gbn = gb;
        if (t + tstep < tend) { int m0n, n0n, ntn; TILE_MN(t + tstep, m0n, n0n, ntn) gan = A + (size_t)m0n * K; gbn = Bt + (size_t)n0n * K; }
        f32x4 acc[4][4];
#pragma unroll
        for (int a = 0; a < 4; ++a)
#pragma unroll
            for (int b = 0; b < 4; ++b) acc[a][b] = (f32x4){0.f, 0.f, 0.f, 0.f};
#pragma unroll
        for (int kt = 0; kt < NKT; ++kt) {
            const int buf = kt & 1;
            if (kt + 1 < NKT) { DMA_SLAB(ga, gb, (kt + 1) * 64, buf ^ 1) } else { DMA_SLAB(gan, gbn, 0, buf ^ 1) }
            const char* as = smem + buf * 32768 + (wm * 64 + l15) * 128;
            const char* bs = smem + buf * 32768 + 16384 + (wn * 64 + l15) * 128;
#pragma unroll
            for (int kk = 0; kk < 2; ++kk) {
                const int co = ((4 * kk + q4) ^ fsw) * 16;
                bf16x8 fn[4], fm[4];
#pragma unroll
                for (int t4 = 0; t4 < 4; ++t4) { fn[t4] = *(const bf16x8*)(bs + t4 * 16 * 128 + co); fm[t4] = *(const bf16x8*)(as + t4 * 16 * 128 + co); }
#pragma unroll
                for (int tn = 0; tn < 4; ++tn)
#pragma unroll
                    for (int tm = 0; tm < 4; ++tm) acc[tn][tm] = MFMA16(fn[tn], fm[tm], acc[tn][tm]);
            }
            asm volatile("s_waitcnt vmcnt(0)" ::: "memory");
            __syncthreads();
        }
        ga = gan; gb = gbn;
        if (MODE == 1) {
            bf16_t* Cs = (bf16_t*)(smem + 32768);
#pragma unroll
            for (int tm = 0; tm < 4; ++tm)
#pragma unroll
                for (int tn = 0; tn < 4; ++tn) {
                    uint2 v; v.x = pk2(acc[tn][tm][0], acc[tn][tm][1]); v.y = pk2(acc[tn][tm][2], acc[tn][tm][3]);
                    *(uint2*)(Cs + (wm * 64 + tm * 16 + l15) * 136 + wn * 64 + tn * 16 + 4 * q4) = v;
                }
            __syncthreads();
#pragma unroll
            for (int i = 0; i < 8; ++i) {
                const int c = tid + i * 256, row = c >> 4, cc = c & 15;
                *(uint4*)(p.o + (size_t)(m0 + row) * 1024 + n0 + cc * 8) = *(const uint4*)&Cs[row * 136 + cc * 8];
            }
            __syncthreads();
        } else {
            if (nt == 30) {
                if (wn == 0 && q4 < 2) {
#pragma unroll
                    for (int tm = 0; tm < 4; ++tm) {
                        const int tok = m0 + wm * 64 + tm * 16 + l15, b = tok >> 12, sq = tok & 4095;
#pragma unroll
                        for (int u = 0; u < 4; ++u) {
                            const int n = 4 * q4 + u;
                            if (n < 6) p.lf[(size_t)(b * 6 + n) * 4096 + sq] = logsigmoid_f(acc[0][tm][u] + p.b_f[layer * 6 + n]);
                        }
                    }
                }
            } else {
                int kind;
                if (nt < 4) kind = 1; else if (nt < 6) kind = 2; else if (nt < 9) kind = 3; else if (nt < 12) kind = 4; else if (nt < 15) kind = 0;
                else if (nt < 18) kind = 2; else if (nt < 21) kind = 5; else if (nt < 27) kind = 0; else kind = 2;
                if (nt >= 21 && nt < 24) {
                    float mxn = 0.f;
#pragma unroll
                    for (int tm = 0; tm < 4; ++tm) {
                        float ssq = 0.f;
#pragma unroll
                        for (int tn = 0; tn < 4; ++tn)
#pragma unroll
                            for (int i = 0; i < 4; ++i) ssq += acc[tn][tm][i] * acc[tn][tm][i];
                        ssq += __shfl_xor(ssq, 16); ssq += __shfl_xor(ssq, 32);
                        mxn = fmaxf(mxn, ssq);
                    }
#pragma unroll
                    for (int o = 1; o < 16; o <<= 1) mxn = fmaxf(mxn, __shfl_xor(mxn, o));
                    if (lane == 0) p.kn[((m0 >> 12) * 6 + (nt - 21) * 2 + wn) * 64 + (((m0 & 4095) + wm * 64) >> 6)] = sqrtf(mxn);
                }
                bf16_t* Cs = (bf16_t*)(smem + 32768);
#pragma unroll
                for (int tm = 0; tm < 4; ++tm) {
                    if (kind == 3 || kind == 4) {
                        const float sc = kind == 3 ? 0.125f : 1.f;
                        const int pos = (m0 + wm * 64 + tm * 16 + l15) & 4095;
                        const float* rp = p.rope + (size_t)pos * 64 + 8 * q4;
#pragma unroll
                        for (int tn = 0; tn < 2; ++tn) {
                            const f32x4 c0 = *(const f32x4*)(rp + 32 * tn), c1 = *(const f32x4*)(rp + 32 * tn + 4);
                            const float cs[4] = {c0.x, c0.z, c1.x, c1.z}, sn[4] = {c0.y, c0.w, c1.y, c1.w};
#pragma unroll
                            for (int u = 0; u < 4; ++u) {
                                const float x1 = acc[tn][tm][u], x2 = acc[tn + 2][tm][u];
                                acc[tn][tm][u] = (x1 * cs[u] - x2 * sn[u]) * sc;
                                acc[tn + 2][tm][u] = (x1 * sn[u] + x2 * cs[u]) * sc;
                            }
                        }
                    }
#pragma unroll
                    for (int tn = 0; tn < 4; ++tn) {
                        if (kind == 1) {
#pragma unroll
                            for (int i = 0; i < 4; ++i) acc[tn][tm][i] = gelu_tanh_f(acc[tn][tm][i]);
                        } else if (kind == 2) {
#pragma unroll
                            for (int i = 0; i < 4; ++i) acc[tn][tm][i] = silu_f(acc[tn][tm][i]);
                        } else if (kind == 5) {
#pragma unroll
                            for (int i = 0; i < 4; ++i) acc[tn][tm][i] *= 0.125f * LOG2E;
                        }
                        uint2 v; v.x = pk2(acc[tn][tm][0], acc[tn][tm][1]); v.y = pk2(acc[tn][tm][2], acc[tn][tm][3]);
                        *(uint2*)(Cs + (wm * 64 + tm * 16 + l15) * 136 + wn * 64 + tn * 16 + 4 * q4) = v;
                    }
                    __builtin_amdgcn_sched_barrier(0);
                }
                __syncthreads();
                if ((nt >= 12 && nt < 15) || (nt >= 24 && nt < 27)) {
                    const int n = tid >> 1, mh = tid & 1;
                    const int hd = (nt >= 24 ? nt - 24 : nt - 12) * 2 + (n >> 6), e = n & 63, bb = m0 >> 12, s0 = (m0 & 4095) + mh * 64;
                    bf16_t* dst = (nt >= 24 ? p.vTf : p.vTr) + ((size_t)(bb * 6 + hd) * 64 + e) * 4096 + s0;
                    const bf16_t* src = Cs + (mh * 64) * 136 + n;
#pragma unroll
                    for (int g8 = 0; g8 < 8; ++g8) {
                        uint4 o;
                        o.x = (unsigned)src[(g8 * 8 + 0) * 136] | ((unsigned)src[(g8 * 8 + 1) * 136] << 16);
                        o.y = (unsigned)src[(g8 * 8 + 2) * 136] | ((unsigned)src[(g8 * 8 + 3) * 136] << 16);
                        o.z = (unsigned)src[(g8 * 8 + 4) * 136] | ((unsigned)src[(g8 * 8 + 5) * 136] << 16);
                        o.w = (unsigned)src[(g8 * 8 + 6) * 136] | ((unsigned)src[(g8 * 8 + 7) * 136] << 16);
                        *(uint4*)(dst + g8 * 8) = o;
                    }
                } else {
                    const int n0z = n0 - (nt >= 27 ? 768 : (nt >= 15 ? 384 : 0));
#pragma unroll
                    for (int i = 0; i < 8; ++i) {
                        const int c = tid + i * 256, row = c >> 4, cc = c & 15;
                        *(uint4*)(p.z + (size_t)(m0 + row) * ZLD + n0z + cc * 8) = *(const uint4*)&Cs[row * 136 + cc * 8];
                    }
                }
                __syncthreads();
            }
        }
    }
    if (MODE == 0) {
        const bf16_t* gbl = Bt + (size_t)3840 * K;
        const int wb = w & 1;
        const int goffb = (wb * 8 + (lane >> 3)) * K + (((lane & 7) ^ (((wb * 8 + (lane >> 3)) >> 1) & 7)) * 8);
#define LG_DMA(pa, st, sl) { _Pragma("unroll") for (int i_ = 0; i_ < 4; ++i_) \
        __builtin_amdgcn_global_load_lds((const unsigned*)((pa) + goff[i_] + (st) * 64), (LAS unsigned*)(lds + (sl) * 16384 + (w * 4 + i_) * 1024), 16, 0, 0); \
        __builtin_amdgcn_global_load_lds((const unsigned*)(gbl + goffb + (st) * 64), (LAS unsigned*)(lds + 65536 + (sl) * 2048 + wb * 1024), 16, 0, 0); }
        for (int mt = blockIdx.x; mt < NTOK / 128; mt += gridDim.x) {
            const int m0 = mt * 128;
            const bf16_t* gal = A + (size_t)m0 * K;
            f32x4 lacc[2] = {(f32x4){0.f, 0.f, 0.f, 0.f}, (f32x4){0.f, 0.f, 0.f, 0.f}};
            LG_DMA(gal, 0, 0) LG_DMA(gal, 1, 1) LG_DMA(gal, 2, 2)
#pragma unroll
            for (int kt = 0; kt < NKT; ++kt) {
                if (kt + 2 < NKT) asm volatile("s_waitcnt vmcnt(10)" ::: "memory"); else if (kt + 1 < NKT) asm volatile("s_waitcnt vmcnt(5)" ::: "memory"); else asm volatile("s_waitcnt vmcnt(0)" ::: "memory");
                __syncthreads();
                if (kt + 3 < NKT) LG_DMA(gal, kt + 3, (kt + 3) & 3)
                const char* as = smem + (kt & 3) * 16384 + (w * 32 + l15) * 128;
                const char* bs = smem + 65536 + (kt & 3) * 2048 + l15 * 128;
#pragma unroll
                for (int kk = 0; kk < 2; ++kk) {
                    const int co = ((4 * kk + q4) ^ fsw) * 16;
                    const bf16x8 fnl = *(const bf16x8*)(bs + co);
                    const bf16x8 fm0 = *(const bf16x8*)(as + co), fm1 = *(const bf16x8*)(as + 16 * 128 + co);
                    lacc[0] = MFMA16(fnl, fm0, lacc[0]); lacc[1] = MFMA16(fnl, fm1, lacc[1]);
                }
            }
            __syncthreads();
            if (q4 < 2) {
#pragma unroll
                for (int tm = 0; tm < 2; ++tm) {
                    const int tok = m0 + w * 32 + tm * 16 + l15, b = tok >> 12, sq = tok & 4095;
#pragma unroll
                    for (int u = 0; u < 4; ++u) {
                        const int n = 4 * q4 + u;
                        if (n < 6) p.lf[(size_t)(b * 6 + n) * 4096 + sq] = logsigmoid_f(lacc[tm][u] + p.b_f[layer * 6 + n]);
                    }
                }
            }
        }
    }
}

DI void unpack8(const uint4 v, float* f) { f[0] = lo_f(v.x); f[1] = hi_f(v.x); f[2] = lo_f(v.y); f[3] = hi_f(v.y); f[4] = lo_f(v.z); f[5] = hi_f(v.z); f[6] = lo_f(v.w); f[7] = hi_f(v.w); }

DI void abranch_item(const Params& p, int layer, int item, char* smem) {
    const int g = item & 3, nb = (item >> 2) & 31, b = item >> 7;
    const int t0 = b * 4096 + nb * 128;
    bf16_t* vnT = (bf16_t*)smem;
    const int tid = ltid(), w = tid >> 6, lane = tid & 63, r = lane & 31, h = lane >> 5;
    {
        const int tok = tid >> 1, half = tid & 1;
        const uint4* src = (const uint4*)(p.z + (size_t)(t0 + tok) * ZLD + C_AV + g * 64 + half * 32);
        float v[32];
#pragma unroll
        for (int i = 0; i < 4; ++i) unpack8(src[i], v + 8 * i);
        float s = 0.f;
#pragma unroll
        for (int i = 0; i < 32; ++i) s += v[i];
        s += __shfl_xor(s, 1);
        const float mean = s * (1.f / 64.f);
        float q = 0.f;
#pragma unroll
        for (int i = 0; i < 32; ++i) { v[i] -= mean; q += v[i] * v[i]; }
        q += __shfl_xor(q, 1);
        const float rstd = rsqrtf(q * (1.f / 64.f) + EPS);
        const float* gain = p.a_ng + layer * 256 + g * 64 + half * 32;
#pragma unroll
        for (int i = 0; i < 32; ++i) vnT[(half * 32 + i) * 136 + tok] = f2bf(v[i] * rstd * gain[i]);
    }
    __syncthreads();
    f32x16 acc[2] = {zero16(), zero16()};
    const bf16_t* wrow = p.WsA + ((size_t)(layer * 4 + g) * 128 + w * 32 + r) * 128 + h * 8;
    const int kmax = (w < 2) ? 4 : 8;
    for (int ks = 0; ks < kmax; ++ks) {
        const bf16x8 bfr = *(const bf16x8*)(wrow + ks * 16);
#pragma unroll
        for (int ct = 0; ct < 2; ++ct) {
            const bf16x8 afr = *(const bf16x8*)&vnT[(ct * 32 + r) * 136 + ks * 16 + h * 8];
            acc[ct] = MFMA32(afr, bfr, acc[ct]);
        }
    }
    const int i = w * 32 + r, tok = t0 + i;
    const float bias = p.a_sb[(layer * 4 + g) * 128 + i];
#pragma unroll
    for (int ct = 0; ct < 2; ++ct)
#pragma unroll
        for (int gq = 0; gq < 4; ++gq) {
            const int c0 = ct * 32 + 8 * gq + 4 * h;
            const uint2 u = *(const uint2*)(p.z + (size_t)tok * ZLD + C_AU + g * 64 + c0);
            const uint2 sg = *(const uint2*)(p.z + (size_t)tok * ZLD + C_AG + g * 64 + c0);
            const float o0 = lo_f(u.x) * (acc[ct][4 * gq] + bias) * lo_f(sg.x), o1 = hi_f(u.x) * (acc[ct][4 * gq + 1] + bias) * hi_f(sg.x);
            const float o2 = lo_f(u.y) * (acc[ct][4 * gq + 2] + bias) * lo_f(sg.y), o3 = hi_f(u.y) * (acc[ct][4 * gq + 3] + bias) * hi_f(sg.y);
            uint2 ov; ov.x = pk2(o0, o1); ov.y = pk2(o2, o3);
            *(uint2*)(p.y + (size_t)tok * 1024 + g * 64 + c0) = ov;
        }
    __syncthreads();
}

DI void kv_item(const Params& p, int item, char* smem) {
    const int n = item & 63, bh = item >> 6, hd = bh % 6, b = bh / 6;
    const int t0 = b * 4096 + n * 64;
    bf16_t* KT = (bf16_t*)smem;
    bf16_t* VT = KT + 64 * 72;
    const int tid = ltid(), w = tid >> 6, lane = tid & 63, r = lane & 31, h = lane >> 5;
    {
        const int j = tid >> 2, part = tid & 3;
        const uint4* ks = (const uint4*)(p.z + (size_t)(t0 + j) * ZLD + C_RK + hd * 64 + part * 16);
        const uint4* vs = (const uint4*)(p.vTr + ((size_t)bh * 64 + j) * 4096 + n * 64 + part * 16);
        float kf[16]; unpack8(ks[0], kf); unpack8(ks[1], kf + 8);
        *(uint4*)&VT[j * 72 + part * 16] = vs[0]; *(uint4*)&VT[j * 72 + part * 16 + 8] = vs[1];
        const float lg = logf(1.f - exp2f(-5.f - (float)hd));
        const float kd = expf(lg * (float)(63 - j));
#pragma unroll
        for (int q = 0; q < 16; ++q) {
            KT[(part * 16 + q) * 72 + j] = f2bf(kf[q] * kd);
        }
    }
    __syncthreads();
    const int dt = w >> 1, et = w & 1;
    f32x16 acc = zero16();
#pragma unroll
    for (int ks = 0; ks < 4; ++ks) {
        const bf16x8 a = *(const bf16x8*)&KT[(dt * 32 + r) * 72 + ks * 16 + h * 8];
        const bf16x8 bb = *(const bf16x8*)&VT[(et * 32 + r) * 72 + ks * 16 + h * 8];
        acc = MFMA32(a, bb, acc);
    }
    float* dst = p.kv + (size_t)item * 4096 + (et * 32 + r) * 64 + dt * 32 + 4 * h;
#pragma unroll
    for (int gq = 0; gq < 4; ++gq) { f32x4 v = {acc[4 * gq], acc[4 * gq + 1], acc[4 * gq + 2], acc[4 * gq + 3]}; *(f32x4*)(dst + 8 * gq) = v; }
    __syncthreads();
}

DI void cumsum_item(const Params& p, int item, char* smem) {
    const float* src = p.lf + (size_t)item * 4096;
    float* dst = p.cf + (size_t)item * 4096;
    float* wt = (float*)smem;
    const int tid = ltid(), w = tid >> 6, lane = tid & 63;
    float v[16];
#pragma unroll
    for (int i = 0; i < 4; ++i) { const f32x4 t = ((const f32x4*)src)[tid * 4 + i]; v[4 * i] = t.x; v[4 * i + 1] = t.y; v[4 * i + 2] = t.z; v[4 * i + 3] = t.w; }
#pragma unroll
    for (int i = 1; i < 16; ++i) v[i] += v[i - 1];
    const float total = v[15];
    float x = total;
#pragma unroll
    for (int o = 1; o < 64; o <<= 1) { const float y = __shfl_up(x, o); if (lane >= o) x += y; }
    if (lane == 63) wt[w] = x;
    __syncthreads();
    float off = x - total;
    for (int i = 0; i < w; ++i) off += wt[i];
#pragma unroll
    for (int i = 0; i < 4; ++i) { f32x4 t = {v[4 * i] + off, v[4 * i + 1] + off, v[4 * i + 2] + off, v[4 * i + 3] + off}; ((f32x4*)dst)[tid * 4 + i] = t; }
    __syncthreads();
}

DI void phase2a(const Params& p, int layer, char* smem) {
    constexpr int N_CS = 48, N_KV = 3072;
    for (int it = blockIdx.x; it < N_CS + N_KV; it += gridDim.x) {
        if (it < N_CS) cumsum_item(p, it, smem);
        else kv_item(p, it - N_CS, smem);
    }
}

DI void ret_item(const Params& p, int item, char* smem) {
    const int seg = item & 7, bh = item >> 3, hd = bh % 6, b = bh / 6;
    bf16_t* Qs = (bf16_t*)smem;
    bf16_t* Qds = Qs + 64 * 72;
    bf16_t* Ks = Qds + 64 * 72;
    bf16_t* VT = Ks + 64 * 72;
    bf16_t* ST = VT + 64 * 72;
    bf16_t* Ps = ST + 64 * 72;
    float* red = (float*)(Ps + 64 * 72);
    const int tid = ltid(), w = tid >> 6, lane = tid & 63, r = lane & 31, h = lane >> 5;
    const float lg = logf(1.f - exp2f(-5.f - (float)hd));
    const float cd = expf(lg * 64.f);
    const int e_own = tid >> 2, dpart = tid & 3;
    float st[16];
#pragma unroll
    for (int q = 0; q < 16; ++q) st[q] = 0.f;
    const float* kvb = p.kv + (size_t)bh * 64 * 4096 + e_own * 64 + dpart * 16;
#pragma unroll 8
    for (int m = 0; m < seg * 8; ++m) {
        const f32x4* s4 = (const f32x4*)(kvb + (size_t)m * 4096);
#pragma unroll
        for (int i = 0; i < 4; ++i) { const f32x4 t = s4[i]; st[4 * i] = st[4 * i] * cd + t.x; st[4 * i + 1] = st[4 * i + 1] * cd + t.y; st[4 * i + 2] = st[4 * i + 2] * cd + t.z; st[4 * i + 3] = st[4 * i + 3] * cd + t.w; }
    }
    const int lj = tid >> 2, lpart = tid & 3;
    const bf16_t* zr0 = p.z + (size_t)(b * 4096 + seg * 512 + lj) * ZLD + hd * 64 + lpart * 16;
    const bf16_t* vs0 = p.vTr + ((size_t)bh * 64 + lj) * 4096 + seg * 512 + lpart * 16;
    const float* kvs = kvb + (size_t)(seg * 8) * 4096;
    uint4 pq0 = *(const uint4*)(zr0 + C_RQ), pq1 = *(const uint4*)(zr0 + C_RQ + 8), pk0 = *(const uint4*)(zr0 + C_RK), pk1 = *(const uint4*)(zr0 + C_RK + 8);
    uint4 pv0 = *(const uint4*)vs0, pv1 = *(const uint4*)(vs0 + 8);
    f32x4 pkv0 = ((const f32x4*)kvs)[0], pkv1 = ((const f32x4*)kvs)[1], pkv2 = ((const f32x4*)kvs)[2], pkv3 = ((const f32x4*)kvs)[3];
    for (int c = 0; c < 8; ++c) {
        const int n = seg * 8 + c, t0 = b * 4096 + n * 64;
        uint2 sgr[4];
        {
            uint4 s0, s1;
            s0.x = pk2(st[0], st[1]); s0.y = pk2(st[2], st[3]); s0.z = pk2(st[4], st[5]); s0.w = pk2(st[6], st[7]);
            s1.x = pk2(st[8], st[9]); s1.y = pk2(st[10], st[11]); s1.z = pk2(st[12], st[13]); s1.w = pk2(st[14], st[15]);
            *(uint4*)&ST[e_own * 72 + dpart * 16] = s0; *(uint4*)&ST[e_own * 72 + dpart * 16 + 8] = s1;
            const int j = lj, part = lpart;
            const uint4 q0 = pq0, q1 = pq1, k0 = pk0, k1 = pk1, v0 = pv0, v1 = pv1;
            *(uint4*)&Qs[j * 72 + part * 16] = q0; *(uint4*)&Qs[j * 72 + part * 16 + 8] = q1;
            *(uint4*)&Ks[j * 72 + part * 16] = k0; *(uint4*)&Ks[j * 72 + part * 16 + 8] = k1;
            const float qd = expf(lg * (float)(j + 1));
            float qf[16]; unpack8(q0, qf); unpack8(q1, qf + 8);
            uint4 d0, d1;
            d0.x = pk2(qf[0] * qd, qf[1] * qd); d0.y = pk2(qf[2] * qd, qf[3] * qd); d0.z = pk2(qf[4] * qd, qf[5] * qd); d0.w = pk2(qf[6] * qd, qf[7] * qd);
            d1.x = pk2(qf[8] * qd, qf[9] * qd); d1.y = pk2(qf[10] * qd, qf[11] * qd); d1.z = pk2(qf[12] * qd, qf[13] * qd); d1.w = pk2(qf[14] * qd, qf[15] * qd);
            *(uint4*)&Qds[j * 72 + part * 16] = d0; *(uint4*)&Qds[j * 72 + part * 16 + 8] = d1;
            *(uint4*)&VT[j * 72 + part * 16] = v0; *(uint4*)&VT[j * 72 + part * 16 + 8] = v1;
            if (c + 1 < 8) {
                const bf16_t* zr = zr0 + (size_t)(c + 1) * 64 * ZLD;
                pq0 = *(const uint4*)(zr + C_RQ); pq1 = *(const uint4*)(zr + C_RQ + 8); pk0 = *(const uint4*)(zr + C_RK); pk1 = *(const uint4*)(zr + C_RK + 8);
                pv0 = *(const uint4*)(vs0 + (c + 1) * 64); pv1 = *(const uint4*)(vs0 + (c + 1) * 64 + 8);
            }
            {
                const int i_ = (w & 1) * 32 + r, et_ = w >> 1;
                const bf16_t* gsrc = p.z + (size_t)(t0 + i_) * ZLD + C_RG + hd * 64 + et_ * 32 + 4 * h;
#pragma unroll
                for (int gq = 0; gq < 4; ++gq) sgr[gq] = *(const uint2*)(gsrc + 8 * gq);
            }
            __builtin_amdgcn_sched_barrier(0);
        }
        __syncthreads();
        {
            const int it = w & 1, jt = w >> 1;
            f32x16 acc = zero16();
#pragma unroll
            for (int ks = 0; ks < 4; ++ks) {
                const bf16x8 a = *(const bf16x8*)&Ks[(jt * 32 + r) * 72 + ks * 16 + h * 8];
                const bf16x8 bb = *(const bf16x8*)&Qs[(it * 32 + r) * 72 + ks * 16 + h * 8];
                acc = MFMA32(a, bb, acc);
            }
            const int i = it * 32 + r;
#pragma unroll
            for (int gq = 0; gq < 4; ++gq) {
                const int j0 = jt * 32 + 8 * gq + 4 * h;
                float pv[4];
#pragma unroll
                for (int u = 0; u < 4; ++u) { const int dd = i - (j0 + u); pv[u] = acc[4 * gq + u] * expf(lg * (float)(dd < 0 ? -dd : dd)); }
                uint2 o; o.x = pk2(pv[0], pv[1]); o.y = pk2(pv[2], pv[3]);
                *(uint2*)&Ps[i * 72 + j0] = o;
            }
        }
        __syncthreads();
        const int it = w & 1, et = w >> 1;
        f32x16 acc = zero16();
#pragma unroll
        for (int ks = 0; ks < 4; ++ks) {
            const bf16x8 a = *(const bf16x8*)&VT[(et * 32 + r) * 72 + ks * 16 + h * 8];
            const bf16x8 bb = *(const bf16x8*)&Ps[(it * 32 + r) * 72 + ks * 16 + h * 8];
            acc = MFMA32(a, bb, acc);
        }
#pragma unroll
        for (int ks = 0; ks < 4; ++ks) {
            const bf16x8 a = *(const bf16x8*)&ST[(et * 32 + r) * 72 + ks * 16 + h * 8];
            const bf16x8 bb = *(const bf16x8*)&Qds[(it * 32 + r) * 72 + ks * 16 + h * 8];
            acc = MFMA32(a, bb, acc);
        }
        float s1 = 0.f, s2 = 0.f;
#pragma unroll
        for (int q = 0; q < 16; ++q) { s1 += acc[q]; s2 += acc[q] * acc[q]; }
        s1 += __shfl_xor(s1, 32); s2 += __shfl_xor(s2, 32);
        const int i = it * 32 + r;
        if (h == 0) { red[(et * 64 + i) * 2] = s1; red[(et * 64 + i) * 2 + 1] = s2; }
        __syncthreads();
        {
            const float t1 = red[i * 2] + red[(64 + i) * 2], t2 = red[i * 2 + 1] + red[(64 + i) * 2 + 1];
            const float mean = t1 * (1.f / 64.f);
            const float var = fmaxf(t2 * (1.f / 64.f) - mean * mean, 0.f);
            const float rstd = rsqrtf(var + EPS);
            const int tok = t0 + i;
#pragma unroll
            for (int gq = 0; gq < 4; ++gq) {
                const int e0 = et * 32 + 8 * gq + 4 * h;
                const uint2 sg = sgr[gq];
                uint2 o;
                o.x = pk2((acc[4 * gq] - mean) * rstd * lo_f(sg.x), (acc[4 * gq + 1] - mean) * rstd * hi_f(sg.x));
                o.y = pk2((acc[4 * gq + 2] - mean) * rstd * lo_f(sg.y), (acc[4 * gq + 3] - mean) * rstd * hi_f(sg.y));
                *(uint2*)(p.y + (size_t)tok * 1024 + 256 + hd * 64 + e0) = o;
            }
        }
        {
            const f32x4 kq[4] = {pkv0, pkv1, pkv2, pkv3};
#pragma unroll
            for (int i2 = 0; i2 < 4; ++i2) { const f32x4 t = kq[i2]; st[4 * i2] = st[4 * i2] * cd + t.x; st[4 * i2 + 1] = st[4 * i2 + 1] * cd + t.y; st[4 * i2 + 2] = st[4 * i2 + 2] * cd + t.z; st[4 * i2 + 3] = st[4 * i2 + 3] * cd + t.w; }
            if (c + 1 < 8) { const f32x4* s4 = (const f32x4*)(kvs + (size_t)(c + 1) * 4096); pkv0 = s4[0]; pkv1 = s4[1]; pkv2 = s4[2]; pkv3 = s4[3]; }
            __builtin_amdgcn_sched_barrier(0);
        }
        __syncthreads();
    }
}

DI void attn_item(const Params& p, int item, char* smem) {
    const int qb = 15 - item / 48, bh = item % 48, hd = bh % 6, b = bh / 6;
    float* Fall = (float*)smem;
    LAS unsigned char* lds = (LAS unsigned char*)smem;
    const int tid = ltid(), w = tid >> 6, lane = tid & 63, r = lane & 31, h = lane >> 5;
    const int q0w = qb * 256 + w * 64;
    const float* cfb = p.cf + (size_t)bh * 4096;
    const int nkt = 4 * qb + 4;
    const bf16_t* kbase = p.z + (size_t)b * 4096 * ZLD + C_FK + hd * 64;
    const bf16_t* vbase = p.vTf + (size_t)bh * 64 * 4096;
#define ATT_DMA(kt_, s_) { const int ln_ = ltid() & 63; _Pragma("unroll") for (int i_ = 0; i_ < 2; ++i_) { \
        const int R_ = (w * 2 + i_) * 8 + (ln_ >> 3), c_ = ((ln_ & 7) ^ ((R_ >> 1) & 7)) * 8;     \
        __builtin_amdgcn_global_load_lds((const unsigned*)(kbase + (size_t)(kt_) * 64 * ZLD + R_ * ZLD + c_), (LAS unsigned*)(lds + 16384 + (s_) * 16384 + (w * 2 + i_) * 1024), 16, 0, 0); \
        __builtin_amdgcn_global_load_lds((const unsigned*)(vbase + (kt_) * 64 + R_ * 4096 + c_), (LAS unsigned*)(lds + 16384 + (s_) * 16384 + 8192 + (w * 2 + i_) * 1024), 16, 0, 0); } }
    __syncthreads();
    ATT_DMA(nkt - 1, (nkt - 1) % 3)
    ATT_DMA(nkt - 2, (nkt - 2) % 3)
#pragma unroll
    for (int i = 0; i < 4; ++i) {
        const int i4 = tid + i * NTHREADS;
        if (i4 * 4 < nkt * 64) { const f32x4 c = ((const f32x4*)cfb)[i4]; ((f32x4*)Fall)[i4] = c * LOG2E; }
    }
    bf16x8 qf[2][4];
    float* own = (float*)(smem + 66560) + tid * 4;
#pragma unroll
    for (int rg = 0; rg < 2; ++rg) {
        const size_t tq = (size_t)b * 4096 + q0w + rg * 32 + r;
#pragma unroll
        for (int ks = 0; ks < 4; ++ks) qf[rg][ks] = *(const bf16x8*)(p.z + tq * ZLD + C_FQ + hd * 64 + ks * 16 + h * 8);
        own[rg] = cfb[q0w + rg * 32 + r] * LOG2E;
    }
    float* knp = (float*)(smem + 65536);
    int* flg = (int*)(smem + 65536 + 256);
    if (w == 0) {
        float kv = (lane < nkt) ? p.kn[bh * 64 + lane] : 0.f;
#pragma unroll
        for (int o = 1; o < 64; o <<= 1) { const float y = __shfl_up(kv, o); if (lane >= o) kv = fmaxf(kv, y); }
        knp[lane] = kv * 1.02f;
    }
#pragma unroll
    for (int rg = 0; rg < 2; ++rg) {
        float ssq = 0.f;
#pragma unroll
        for (int ks = 0; ks < 4; ++ks)
#pragma unroll
            for (int j = 0; j < 8; ++j) { const float qv = bf2f((unsigned)(unsigned short)qf[rg][ks][j]); ssq += qv * qv; }
        ssq += __shfl_xor(ssq, 32);
        own[2 + rg] = sqrtf(ssq);
    }
    f32x16 O[2][2] = {{zero16(), zero16()}, {zero16(), zero16()}};
    float m[2] = {-INFINITY, -INFINITY}, l[2] = {0.f, 0.f};
    const int fsw = (r >> 1) & 7;
    for (int kt = nkt - 1; kt >= 0; --kt) {
        bool wdone = false;
        if (kt < nkt - 1) {
            const float fl_ = Fall[kt * 64 + 63], kp = knp[kt];
            const f32x4 ow = *(const f32x4*)own;
            const bool ok = (ow.z * kp + ow.x - fl_ < m[0] - SKIP_T) && (ow.w * kp + ow.y - fl_ < m[1] - SKIP_T);
            wdone = (__ballot(!ok) == 0ull);
        }
        if (lane == 0) flg[(kt & 3) * 4 + w] = wdone ? 1 : 0;
        if (kt > 0) asm volatile("s_waitcnt vmcnt(4)" ::: "memory"); else asm volatile("s_waitcnt vmcnt(0)" ::: "memory");
        __syncthreads();
        {
            const int4 fl = *(const int4*)&flg[(kt & 3) * 4];
            if (fl.x & fl.y & fl.z & fl.w) break;
        }
        if (kt >= 2) ATT_DMA(kt - 2, (kt - 2) % 3)
        const int kmin = kt * 64;
        if (!wdone && kmin <= q0w + 63) {
            const char* Kt = smem + 16384 + (kt % 3) * 16384;
            const char* Vt = Kt + 8192;
#pragma unroll
            for (int rg = 0; rg < 2; ++rg) {
                const int q0 = q0w + rg * 32, qrow = q0 + r;
                const float Fi_rg = own[rg];
                if (kmin <= q0 + 31) {
#pragma unroll
                    for (int jt = 1; jt >= 0; --jt) {
                        if (kmin + jt * 32 > q0 + 31) continue;
                        f32x16 S;
#pragma unroll
                        for (int gq = 0; gq < 4; ++gq) {
                            const f32x4 fk = *(const f32x4*)&Fall[kmin + jt * 32 + 8 * gq + 4 * h];
                            S[4 * gq] = Fi_rg - fk.x; S[4 * gq + 1] = Fi_rg - fk.y; S[4 * gq + 2] = Fi_rg - fk.z; S[4 * gq + 3] = Fi_rg - fk.w;
                        }
#pragma unroll
                        for (int ks = 0; ks < 4; ++ks) {
                            const bf16x8 a = *(const bf16x8*)(Kt + (jt * 32 + r) * 128 + (((2 * ks + h) ^ fsw) * 16));
                            S = MFMA32(a, qf[rg][ks], S);
                        }
                        if (kmin + jt * 32 + 31 > q0) {
#pragma unroll
                            for (int q = 0; q < 16; ++q) { const int key = kmin + jt * 32 + crow(q, h); if (key > qrow) S[q] = -INFINITY; }
                        }
                        float mx = S[0];
#pragma unroll
                        for (int q = 1; q < 16; ++q) mx = fmaxf(mx, S[q]);
                        mx = fmaxf(mx, __shfl_xor(mx, 32));
                        if (__ballot(mx > m[rg] - SKIP_T) != 0ull) {
                            const float mnew = fmaxf(m[rg], mx);
                            const float alpha = __builtin_amdgcn_exp2f(m[rg] - mnew);
                            m[rg] = mnew;
                            float ls = 0.f;
#pragma unroll
                            for (int q = 0; q < 16; ++q) { const float pv = __builtin_amdgcn_exp2f(S[q] - mnew); S[q] = pv; ls += pv; }
                            l[rg] = l[rg] * alpha + ls;
                            if (__ballot(alpha != 1.f) != 0ull) {
#pragma unroll
                                for (int et = 0; et < 2; ++et)
#pragma unroll
                                    for (int q = 0; q < 16; ++q) O[rg][et][q] *= alpha;
                            }
#pragma unroll
                            for (int s2 = 0; s2 < 2; ++s2) {
                                uint4 pw;
                                pw.x = pk2(S[8 * s2], S[8 * s2 + 1]); pw.y = pk2(S[8 * s2 + 2], S[8 * s2 + 3]);
                                pw.z = pk2(S[8 * s2 + 4], S[8 * s2 + 5]); pw.w = pk2(S[8 * s2 + 6], S[8 * s2 + 7]);
                                const bf16x8 pf = __builtin_bit_cast(bf16x8, pw);
#pragma unroll
                                for (int et = 0; et < 2; ++et) {
                                    const char* vrow = Vt + (et * 32 + r) * 128 + 8 * h;
                                    const s16x4 lo = *(const s16x4*)(vrow + (((4 * jt + 2 * s2) ^ fsw) * 16)), hi = *(const s16x4*)(vrow + (((4 * jt + 2 * s2 + 1) ^ fsw) * 16));
                                    const bf16x8 vf = __builtin_shufflevector(lo, hi, 0, 1, 2, 3, 4, 5, 6, 7);
                                    O[rg][et] = MFMA32(vf, pf, O[rg][et]);
                                }
                            }
                        }
                    }
                }
            }
        }
    }
    asm volatile("s_waitcnt vmcnt(0)" ::: "memory");
#pragma unroll
    for (int rg = 0; rg < 2; ++rg) {
        const size_t tokq = (size_t)b * 4096 + q0w + rg * 32 + r;
        float lt = l[rg];
        lt += __shfl_xor(lt, 32);
        const float inv = 1.f / lt;
#pragma unroll
        for (int et = 0; et < 2; ++et)
#pragma unroll
            for (int gq = 0; gq < 4; ++gq) {
                const int e0 = et * 32 + 8 * gq + 4 * h;
                const uint2 sg = *(const uint2*)(p.z + tokq * ZLD + C_FG + hd * 64 + e0);
                uint2 o;
                o.x = pk2(O[rg][et][4 * gq] * inv * lo_f(sg.x), O[rg][et][4 * gq + 1] * inv * hi_f(sg.x));
                o.y = pk2(O[rg][et][4 * gq + 2] * inv * lo_f(sg.y), O[rg][et][4 * gq + 3] * inv * hi_f(sg.y));
                *(uint2*)(p.y + tokq * 1024 + 640 + hd * 64 + e0) = o;
            }
    }
}

DI void phase2b(const Params& p, int layer, char* smem, int cidx) {
    constexpr int N_ATT = 768, N_RET = 384, N_A = 1024;
    const int n_w = (layer == 0) ? I_IN + I_OUT : 0;
    int* s_item = (int*)(smem + LDS_MAIN + 16);
    for (;;) {
        if (threadIdx.x == 0) *s_item = (int)atomicAdd(p.ctr + cidx, 1u);
        __syncthreads();
        const int it = *s_item;
        __syncthreads();
        if (it >= N_RET + N_ATT + N_A + n_w) break;
        if (it < N_RET) ret_item(p, it, smem);
        else if (it < N_RET + N_ATT) attn_item(p, it - N_RET, smem);
        else if (it < N_RET + N_ATT + N_A) abranch_item(p, layer, it - N_RET - N_ATT, smem);
        else wt_item(p, 1, it - N_RET - N_ATT - N_A, (float*)smem);
        __syncthreads();
    }
}

DI void phase4(const Params& p, int layer, char* smem) {
    const int tid = ltid(), wv = tid >> 6, lane = tid & 63;
    const f32x4* pg = (const f32x4*)(p.post_g + layer * 1024);
    const f32x4* g2 = (const f32x4*)(p.pre_g + 1024);
    for (int row = (blockIdx.x * 4 + wv) * 2; row < NTOK; row += gridDim.x * 8) {
        f32x4 v[2][4], xv[2][4]; float ss[2] = {0.f, 0.f};
#pragma unroll
        for (int q = 0; q < 2; ++q)
#pragma unroll
            for (int j = 0; j < 2; ++j) { const uint4 ow = ((const uint4*)(p.o + (size_t)(row + q) * 1024))[lane + 64 * j]; v[q][2 * j] = (f32x4){lo_f(ow.x), hi_f(ow.x), lo_f(ow.y), hi_f(ow.y)}; v[q][2 * j + 1] = (f32x4){lo_f(ow.z), hi_f(ow.z), lo_f(ow.w), hi_f(ow.w)};
                if (layer == 0) { xv[q][2 * j] = ((const f32x4*)(p.x + (size_t)(row + q) * 1024))[IDX4(2 * j)]; xv[q][2 * j + 1] = ((const f32x4*)(p.x + (size_t)(row + q) * 1024))[IDX4(2 * j + 1)]; }
                else { const uint4 xw = ((const uint4*)(p.x1b + (size_t)(row + q) * 1024))[lane + 64 * j]; xv[q][2 * j] = (f32x4){lo_f(xw.x), hi_f(xw.x), lo_f(xw.y), hi_f(xw.y)}; xv[q][2 * j + 1] = (f32x4){lo_f(xw.z), hi_f(xw.z), lo_f(xw.w), hi_f(xw.w)}; } }
#pragma unroll
        for (int q = 0; q < 2; ++q)
#pragma unroll
            for (int j = 0; j < 4; ++j) ss[q] += (v[q][j].x * v[q][j].x + v[q][j].y * v[q][j].y) + (v[q][j].z * v[q][j].z + v[q][j].w * v[q][j].w);
#pragma unroll
        for (int o = 1; o < 64; o <<= 1) { ss[0] += __shfl_xor(ss[0], o); ss[1] += __shfl_xor(ss[1], o); }
        float s2[2] = {0.f, 0.f};
#pragma unroll
        for (int q = 0; q < 2; ++q) {
            const float rstd = rsqrtf(ss[q] * (1.f / 1024.f) + EPS);
#pragma unroll
            for (int j = 0; j < 4; ++j) {
                const f32x4 g = pg[IDX4(j)];
                v[q][j] = xv[q][j] + v[q][j] * rstd * g;
                if (layer != 0) ((f32x4*)(p.out + (size_t)(row + q) * 1024))[IDX4(j)] = v[q][j];
                s2[q] += (v[q][j].x * v[q][j].x + v[q][j].y * v[q][j].y) + (v[q][j].z * v[q][j].z + v[q][j].w * v[q][j].w);
            }
        }
        if (layer == 0) {
#pragma unroll
            for (int o = 1; o < 64; o <<= 1) { s2[0] += __shfl_xor(s2[0], o); s2[1] += __shfl_xor(s2[1], o); }
#pragma unroll
            for (int q = 0; q < 2; ++q) {
                const float rstd2 = rsqrtf(s2[q] * (1.f / 1024.f) + EPS);
#pragma unroll
                for (int j = 0; j < 2; ++j) {
                    const f32x4 ga = g2[IDX4(2 * j)], gb = g2[IDX4(2 * j + 1)], va = v[q][2 * j], vb = v[q][2 * j + 1];
                    uint4 wv2; wv2.x = pk2(va.x * rstd2 * ga.x, va.y * rstd2 * ga.y); wv2.y = pk2(va.z * rstd2 * ga.z, va.w * rstd2 * ga.w);
                    wv2.z = pk2(vb.x * rstd2 * gb.x, vb.y * rstd2 * gb.y); wv2.w = pk2(vb.z * rstd2 * gb.z, vb.w * rstd2 * gb.w);
                    ((uint4*)(p.hb + (size_t)(row + q) * 1024))[lane + 64 * j] = wv2;
                    uint4 xw; xw.x = pk2(va.x, va.y); xw.y = pk2(va.z, va.w); xw.z = pk2(vb.x, vb.y); xw.w = pk2(vb.z, vb.w);
                    ((uint4*)(p.x1b + (size_t)(row + q) * 1024))[lane + 64 * j] = xw;
                }
            }
        }
    }
}

template <int PH>
__global__ void __launch_bounds__(NTHREADS, 2) __attribute__((amdgpu_waves_per_eu(2, 2))) k_phase(Params p, int layer) {
    extern __shared__ __attribute__((aligned(16))) char smem[];
    if (PH == 0) phase0(p, smem);
    else if (PH == 1) gemm_phase<0>(p, layer, smem);
    else if (PH == 2) phase2a(p, layer, smem);
    else if (PH == 3) phase2b(p, layer, smem, layer);
    else if (PH == 4) gemm_phase<1>(p, layer, smem);
    else phase4(p, layer, smem);
}

#if MEGA
__global__ void __launch_bounds__(NTHREADS, 2) __attribute__((amdgpu_waves_per_eu(2, 2))) k_mega(Params p) {
    extern __shared__ __attribute__((aligned(16))) char smem[];
    cg::grid_group grid = cg::this_grid();
    volatile LAS unsigned* st = (volatile LAS unsigned*)(smem + LDS_MAIN);
    if (threadIdx.x < 2) st[threadIdx.x] = 0u;
    __syncthreads();
    (void)xcd_barrier_post(p.bar, st);
#define XBAR() { XcdBarrier xb_; xb_.bar = p.bar; xb_.x = xb_xcc_id(); xb_.st = (volatile LAS unsigned*)(smem + LDS_MAIN); xcd_barrier(xb_); }
    phase0(p, smem);
    if (p.never) grid.sync();
    XBAR();
    if (PROBE_PH == 10) { for (int i = 0; i < 10; ++i) XBAR(); }
#pragma nounroll
    for (int layer = 0; layer < 2; ++layer) {
        gemm_phase<0>(p, layer, smem);
        XBAR();
        if ((PROBE_PH == 1 && layer == 0) || (PROBE_PH == 11 && layer == 1)) { gemm_phase<0>(p, layer, smem); XBAR(); }
        phase2a(p, layer, smem);
        XBAR();
        if (PROBE_PH == 2 && layer == 0) { phase2a(p, layer, smem); XBAR(); }
        phase2b(p, layer, smem, layer);
        XBAR();
        if (PROBE_PH == 3 && layer == 0) { phase2b(p, layer, smem, 2); XBAR(); }
        gemm_phase<1>(p, layer, smem);
        XBAR();
        if (PROBE_PH == 4 && layer == 0) { gemm_phase<1>(p, layer, smem); XBAR(); }
        phase4(p, layer, smem);
        if (PROBE_PH == 5 && layer == 0) { XBAR(); phase4(p, layer, smem); }
        if (layer == 0) XBAR();
    }
}
#endif

extern "C" void kernel_launch(void* const* d_in, const int* in_sizes, int n_in, void* d_out, int out_size, void* d_ws, size_t ws_size, hipStream_t stream) {
    static int grid_blocks = 0;
    if (grid_blocks == 0) {
        if (ws_size < WS_END) { fprintf(stderr, "kernel_launch: workspace too small: %zu < %zu\n", ws_size, (size_t)WS_END); grid_blocks = -1; return; }
        int dev = 0, cus = 0, per_cu = 0;
        hipGetDevice(&dev);
        hipDeviceGetAttribute(&cus, hipDeviceAttributeMultiprocessorCount, dev);
#if MEGA
        hipFuncSetAttribute((const void*)k_mega, hipFuncAttributeMaxDynamicSharedMemorySize, LDS_BYTES);
        hipOccupancyMaxActiveBlocksPerMultiprocessor(&per_cu, (const void*)k_mega, NTHREADS, LDS_BYTES);
#else
        hipFuncSetAttribute((const void*)k_phase<0>, hipFuncAttributeMaxDynamicSharedMemorySize, LDS_BYTES);
        hipFuncSetAttribute((const void*)k_phase<1>, hipFuncAttributeMaxDynamicSharedMemorySize, LDS_BYTES);
        hipFuncSetAttribute((const void*)k_phase<2>, hipFuncAttributeMaxDynamicSharedMemorySize, LDS_BYTES);
        hipFuncSetAttribute((const void*)k_phase<3>, hipFuncAttributeMaxDynamicSharedMemorySize, LDS_BYTES);
        hipFuncSetAttribute((const void*)k_phase<4>, hipFuncAttributeMaxDynamicSharedMemorySize, LDS_BYTES);
        hipFuncSetAttribute((const void*)k_phase<5>, hipFuncAttributeMaxDynamicSharedMemorySize, LDS_BYTES);
        per_cu = 2;
#endif
        if (per_cu < 1) per_cu = 1;
        if (per_cu > 2) per_cu = 2;
        grid_blocks = cus * per_cu;
    }
    if (grid_blocks < 0) return;
    Params p{};
    p.x = (const float*)d_in[0]; p.pre_g = (const float*)d_in[1]; p.post_g = (const float*)d_in[2]; p.w_in = (const float*)d_in[3];
    p.b_f = (const float*)d_in[4]; p.a_ng = (const float*)d_in[5]; p.a_sw = (const float*)d_in[6]; p.a_sb = (const float*)d_in[7]; p.w_out = (const float*)d_in[8];
    p.out = (float*)d_out;
    char* ws = (char*)d_ws;
    p.ctr = (unsigned*)(ws + WS_CTR);
    p.bar = (unsigned*)(ws + WS_BAR);
    p.WinT = (bf16_t*)(ws + WS_WINT); p.WoutT = (bf16_t*)(ws + WS_WOUTT); p.WsA = (bf16_t*)(ws + WS_WSA);
    p.rope = (float*)(ws + WS_ROPE); p.lf = (float*)(ws + WS_LF); p.cf = (float*)(ws + WS_CF);
    p.vTf = (bf16_t*)(ws + WS_VTF); p.vTr = (bf16_t*)(ws + WS_VTR);
    p.hb = (bf16_t*)(ws + WS_HB); p.y = (bf16_t*)(ws + WS_Y); p.kv = (float*)(ws + WS_KV);
    p.z = (bf16_t*)(ws + WS_Z); p.kn = (float*)(ws + WS_KN); p.x1b = (bf16_t*)(ws + WS_X1B); p.o = (bf16_t*)(ws + WS_HB);
#if MEGA
    hipMemsetAsync(ws + WS_BAR, 0, XCD_BAR_WORDS * 4, stream);
    void* args[] = {&p};
    hipError_t e = hipLaunchCooperativeKernel((void*)k_mega, dim3(grid_blocks), dim3(NTHREADS), args, LDS_BYTES, stream);
    if (e != hipSuccess) fprintf(stderr, "cooperative launch failed: %s (grid %d)\n", hipGetErrorString(e), grid_blocks);
#else
    const dim3 g(grid_blocks), bl(NTHREADS);
    hipLaunchKernelGGL(k_phase<0>, g, bl, LDS_BYTES, stream, p, 0);
    for (int layer = 0; layer < 2; ++layer) {
        hipLaunchKernelGGL(k_phase<1>, g, bl, LDS_BYTES, stream, p, layer);
        hipLaunchKernelGGL(k_phase<2>, g, bl, LDS_BYTES, stream, p, layer);
        hipLaunchKernelGGL(k_phase<3>, g, bl, LDS_BYTES, stream, p, layer);
        hipLaunchKernelGGL(k_phase<4>, g, bl, LDS_BYTES, stream, p, layer);
        hipLaunchKernelGGL(k_phase<5>, g, bl, LDS_BYTES, stream, p, layer);
    }
#endif
}
```

```cpp
#include <hip/hip_runtime.h>
#include <hip/hip_cooperative_groups.h>
#include <cstdint>
#include <cstdio>
namespace cg = cooperative_groups;

#ifndef PROBE_PH
#define PROBE_PH -1
#endif
#ifndef MEGA
#define MEGA 1
#endif

#define DI __device__ __forceinline__
typedef unsigned short bf16_t;
typedef short bf16x8 __attribute__((ext_vector_type(8)));
typedef short s16x4 __attribute__((ext_vector_type(4)));
typedef float f32x4 __attribute__((ext_vector_type(4)));
typedef float f32x16 __attribute__((ext_vector_type(16)));

constexpr int NB = 8, SEQ = 4096, DM = 1024, NTOK = NB * SEQ, DIN = 3846, ZLD = 3072, NPAD = 3968;
constexpr int NTHREADS = 256;
constexpr float EPS = 1e-6f;
constexpr float LOG2E = 1.4426950408889634f;
constexpr float SKIP_T = 40.f;
constexpr int C_AU = 0, C_AV = 256, C_AG = 512, C_RQ = 768, C_RK = 1152, C_RG = 1536, C_FQ = 1920, C_FK = 2304, C_FG = 2688;
constexpr int LDS_MAIN = 2 * 2 * 128 * 72 * 2;
constexpr int LDS_BYTES = LDS_MAIN + 64;

struct Params {
    const float *x, *pre_g, *post_g, *w_in, *b_f, *a_ng, *a_sw, *a_sb, *w_out;
    float* out;
    bf16_t *WinT, *WoutT, *WsA, *hb, *z, *y, *vTf, *vTr, *x1b;
    bf16_t* o;
    float *kv, *lf, *cf, *rope, *kn, *rs;
    unsigned* ctr;
    unsigned* bar;
    int never;
    int pad0;
};

constexpr size_t WS_CTR = 0;
constexpr size_t WS_BAR = 256;
constexpr size_t WS_WINT = 256 + 16384;
constexpr size_t WS_WOUTT = WS_WINT + (size_t)2 * NPAD * 1024 * 2;
constexpr size_t WS_WSA = WS_WOUTT + (size_t)2 * 1024 * 1024 * 2;
constexpr size_t WS_ROPE = WS_WSA + (size_t)2 * 4 * 128 * 128 * 2;
constexpr size_t WS_LF = WS_ROPE + (size_t)4096 * 32 * 2 * 4;
constexpr size_t WS_CF = WS_LF + (size_t)48 * 4096 * 4;
constexpr size_t WS_VTF = WS_CF + (size_t)48 * 4096 * 4;
constexpr size_t WS_VTR = WS_VTF + (size_t)48 * 64 * 4096 * 2;
constexpr size_t WS_HB = WS_VTR + (size_t)48 * 64 * 4096 * 2;
constexpr size_t WS_Y = WS_HB + (size_t)NTOK * 1024 * 2;
constexpr size_t WS_KV = WS_Y + (size_t)NTOK * 1024 * 2;
constexpr size_t WS_Z = WS_KV + (size_t)3072 * 4096 * 4;
constexpr size_t WS_X1B = WS_Z + (size_t)NTOK * ZLD * 2;
constexpr size_t WS_KN = WS_X1B + (size_t)NTOK * 1024 * 2;
constexpr size_t WS_RS = WS_KN + 16384;
constexpr size_t WS_END = WS_RS + (size_t)NTOK * 4;

DI int ltid() { int t = threadIdx.x; asm volatile("" : "+v"(t)); return t; }
DI float bf2f(unsigned v) { return __uint_as_float(v << 16); }
typedef __bf16 bf16v2_t __attribute__((ext_vector_type(2)));
typedef float f32x2_t __attribute__((ext_vector_type(2)));
DI unsigned pk2(float lo, float hi) { const f32x2_t v = {lo, hi}; return __builtin_bit_cast(unsigned, __builtin_convertvector(v, bf16v2_t)); }
DI bf16_t f2bf(float x) { return (bf16_t)(pk2(x, 0.f) & 0xffffu); }
DI float lo_f(unsigned w) { return __uint_as_float(w << 16); }
DI float hi_f(unsigned w) { return __uint_as_float(w & 0xffff0000u); }
DI int crow(int reg, int h) { return (reg & 3) + 8 * (reg >> 2) + 4 * h; }
#define IDX4(jj) ((lane + 64 * ((jj) >> 1)) * 2 + ((jj) & 1))
DI float wave_sum(float v) {
#pragma unroll
    for (int o = 1; o < 64; o <<= 1) v += __shfl_xor(v, o);
    return v;
}
DI float silu_f(float x) { return x * __builtin_amdgcn_rcpf(1.f + __builtin_amdgcn_exp2f(-LOG2E * x)); }
DI float gelu_tanh_f(float x) { const float u = (-2.f * LOG2E * 0.7978845608028654f) * (x + 0.044715f * x * x * x); return x * __builtin_amdgcn_rcpf(1.f + __builtin_amdgcn_exp2f(u)); }
DI float logsigmoid_f(float x) { return fminf(x, 0.f) - log1pf(__expf(-fabsf(x))); }
#define MFMA32(a, b, c) __builtin_amdgcn_mfma_f32_32x32x16_bf16((a), (b), (c), 0, 0, 0)
#define MFMA16(a, b, c) __builtin_amdgcn_mfma_f32_16x16x32_bf16((a), (b), (c), 0, 0, 0)
DI f32x16 zero16() { f32x16 z; for (int i = 0; i < 16; ++i) z[i] = 0.f; return z; }

#define XB_TMO      128
#define XB_XCNT(j)  (256  + 64 * (j))
#define XB_XSUB(j)  (1280 + 64 * (j))
#define XB_XGEN(j)  (2304 + 64 * (j))
#define XB_TOP      3328
#define XB_TOPGEN   3392
#define XCD_BAR_WORDS 3456
#define XB_SPIN_CAP (1u << 18)
#define LAS __attribute__((address_space(3)))

__device__ __forceinline__ unsigned xb_ld(unsigned* p)              { return __hip_atomic_load(p, __ATOMIC_RELAXED, __HIP_MEMORY_SCOPE_AGENT); }
__device__ __forceinline__ unsigned xb_add(unsigned* p, unsigned v) { return __hip_atomic_fetch_add(p, v, __ATOMIC_RELAXED, __HIP_MEMORY_SCOPE_AGENT); }
__device__ __forceinline__ unsigned xb_xcc_id() { return (unsigned)__builtin_amdgcn_s_getreg((3 << 11) | 20) & 0xFu; }
#define XB_SPIN(cond, bar) do { unsigned _sp = 0; while (cond) { __builtin_amdgcn_s_sleep(1); \
    if ((++_sp & 255u) == 0u) { if (xb_ld(&(bar)[XB_TMO])) break; if (_sp > XB_SPIN_CAP) { atomicAdd(&(bar)[XB_TMO], 1u); break; } } } } while (0)

struct XcdBarrier {
    unsigned* bar; unsigned x;
    volatile LAS unsigned* st;
};

__device__ __forceinline__ XcdBarrier xcd_barrier_post(unsigned* bar, volatile LAS unsigned* st) {
    XcdBarrier b; b.bar = bar; b.x = xb_xcc_id(); b.st = st;
    if (threadIdx.x == 0) (void)xb_add(&bar[XB_XCNT(b.x)], 1u);
    return b;
}
__device__ __forceinline__ void xcd_barrier_complete(unsigned* bar, unsigned x, unsigned& nloc, unsigned& nx) {
    const unsigned G = gridDim.x * gridDim.y * gridDim.z;
    unsigned sum, cnt, mine, sp = 0u;
    for (;;) {
        sum = 0u; cnt = 0u; mine = 0u;
#pragma unroll
        for (unsigned j = 0; j < 16; ++j) { const unsigned c = xb_ld(&bar[XB_XCNT(j)]); sum += c; cnt += (c > 0u) ? 1u : 0u; mine = (j == x) ? c : mine; }
        if (sum == G) break;
        __builtin_amdgcn_s_sleep(1);
        if ((++sp & 255u) == 0u) { if (xb_ld(&bar[XB_TMO])) break; if (sp > XB_SPIN_CAP) { atomicAdd(&bar[XB_TMO], 1u); break; } }
    }
    nloc = mine > 0u ? mine : 1u; nx = cnt > 0u ? cnt : 1u;
}

__device__ __forceinline__ void xcd_barrier(const XcdBarrier& b) {
    asm volatile("s_waitcnt vmcnt(0)" ::: "memory");
    __syncthreads();
    if (threadIdx.x == 0) {
        unsigned* bar = b.bar;
        __builtin_amdgcn_s_waitcnt(0);
        unsigned nloc = b.st[0], nx = b.st[1];
        if (nloc == 0u) { xcd_barrier_complete(bar, b.x, nloc, nx); b.st[0] = nloc; b.st[1] = nx; }
        const unsigned old = xb_add(&bar[XB_XSUB(b.x)], 1u);
        const unsigned gen = old / nloc;
        if (old + 1u == (gen + 1u) * nloc) {
            __builtin_amdgcn_fence(__ATOMIC_RELEASE, "agent");
            asm volatile("s_waitcnt vmcnt(0)" ::: "memory");
            const unsigned og = xb_add(&bar[XB_TOP], 1u);
            const unsigned tg = og / nx;
            if (og + 1u == (tg + 1u) * nx) xb_add(&bar[XB_TOPGEN], 1u);
            else XB_SPIN(xb_ld(&bar[XB_TOPGEN]) == tg, bar);
            __builtin_amdgcn_fence(__ATOMIC_ACQUIRE, "agent");
            xb_add(&bar[XB_XGEN(b.x)], 1u);
            asm volatile("s_waitcnt vmcnt(0)" ::: "memory");
        } else {
            XB_SPIN(xb_ld(&bar[XB_XGEN(b.x)]) == gen, bar);
            __builtin_amdgcn_fence(__ATOMIC_ACQUIRE, "agent");
            asm volatile("s_waitcnt vmcnt(0)" ::: "memory");
        }
    }
    __syncthreads();
}

DI void transpose_item(const float* __restrict__ W, int N, int NP, bf16_t* __restrict__ WT, int item, float* scr, const float* __restrict__ gain = nullptr) {
    const int tid = ltid();
    const int nblk = NP / 64, kb = item / nblk, nb = item % nblk, k0 = kb * 64, n0 = nb * 64;
#pragma unroll
    for (int i = 0; i < 16; ++i) {
        const int kk = i * 4 + (tid >> 6), nn = tid & 63;
        scr[kk * 65 + nn] = (n0 + nn < N) ? W[(size_t)(k0 + kk) * N + n0 + nn] * (gain ? gain[k0 + kk] : 1.f) : 0.f;
    }
    __syncthreads();
    const int n = tid >> 2, c = tid & 3;
    uint4 o0, o1;
    const float* s = scr + (c * 16) * 65 + n;
    o0.x = pk2(s[0 * 65], s[1 * 65]); o0.y = pk2(s[2 * 65], s[3 * 65]); o0.z = pk2(s[4 * 65], s[5 * 65]); o0.w = pk2(s[6 * 65], s[7 * 65]);
    o1.x = pk2(s[8 * 65], s[9 * 65]); o1.y = pk2(s[10 * 65], s[11 * 65]); o1.z = pk2(s[12 * 65], s[13 * 65]); o1.w = pk2(s[14 * 65], s[15 * 65]);
    uint4* dst = (uint4*)(WT + (size_t)(n0 + n) * 1024 + k0 + c * 16);
    dst[0] = o0; dst[1] = o1;
    __syncthreads();
}

DI void rms_row_to_bf16(const float* xrow, const float* gain, bf16_t* orow, int lane) {
    f32x4 v[4]; float ss = 0.f;
#pragma unroll
    for (int j = 0; j < 4; ++j) { v[j] = ((const f32x4*)xrow)[lane + 64 * j]; ss += (v[j].x * v[j].x + v[j].y * v[j].y) + (v[j].z * v[j].z + v[j].w * v[j].w); }
    const float rstd = rsqrtf(wave_sum(ss) * (1.f / 1024.f) + EPS);
#pragma unroll
    for (int j = 0; j < 4; ++j) {
        const f32x4 g = ((const f32x4*)gain)[lane + 64 * j];
        uint2 w; w.x = pk2(v[j].x * rstd * g.x, v[j].y * rstd * g.y); w.y = pk2(v[j].z * rstd * g.z, v[j].w * rstd * g.w);
        ((uint2*)orow)[lane + 64 * j] = w;
    }
}

constexpr int I_IN = 16 * (NPAD / 64), I_OUT = 16 * 16;
DI void wt_item(const Params& p, int l, int it, float* scr) {
    if (it < I_IN) transpose_item(p.w_in + (size_t)l * 1024 * DIN, DIN, NPAD, p.WinT + (size_t)l * NPAD * 1024, it, scr, l == 1 ? p.pre_g + 1024 : nullptr);
    else transpose_item(p.w_out + (size_t)l * 1024 * 1024, 1024, 1024, p.WoutT + (size_t)l * 1024 * 1024, it - I_IN, scr);
}
DI void phase0(const Params& p, char* smem) {
    const int tid = ltid(), G = gridDim.x;
    if (blockIdx.x == 0 && tid < 8) p.ctr[tid] = 0u;
    float* scr = (float*)smem;
    for (int it = blockIdx.x; it < I_IN + I_OUT; it += G) wt_item(p, 0, it, scr);
    const int gt = blockIdx.x * NTHREADS + tid, GT = G * NTHREADS;
    for (int idx = gt; idx < 2 * 4 * 128 * 128; idx += GT) {
        const int i = (idx >> 7) & 127, j = idx & 127;
        const float w = p.a_sw[idx];
        p.WsA[idx] = f2bf(((j >> 6) <= (i >> 6)) ? w : 0.f);
    }
    for (int idx = gt; idx < 4096 * 32; idx += GT) {
        const int pos = idx >> 5, i = idx & 31;
        const float inv = powf(10000.f, -(float)i / 32.f);
        const float ang = (float)pos * inv;
        float sn, cs; sincosf(ang, &sn, &cs);
        p.rope[2 * idx] = cs; p.rope[2 * idx + 1] = sn;
    }
    const int wv = tid >> 6, lane = tid & 63;
    for (int row = (blockIdx.x * 4 + wv) * 2; row < NTOK; row += G * 8) {
        f32x4 v[2][4]; float ss[2] = {0.f, 0.f};
#pragma unroll
        for (int q = 0; q < 2; ++q)
#pragma unroll
            for (int j = 0; j < 4; ++j) v[q][j] = ((const f32x4*)(p.x + (size_t)(row + q) * 1024))[IDX4(j)];
#pragma unroll
        for (int q = 0; q < 2; ++q)
#pragma unroll
            for (int j = 0; j < 4; ++j) ss[q] += (v[q][j].x * v[q][j].x + v[q][j].y * v[q][j].y) + (v[q][j].z * v[q][j].z + v[q][j].w * v[q][j].w);
#pragma unroll
        for (int o = 1; o < 64; o <<= 1) { ss[0] += __shfl_xor(ss[0], o); ss[1] += __shfl_xor(ss[1], o); }
#pragma unroll
        for (int q = 0; q < 2; ++q) {
            const float rstd = rsqrtf(ss[q] * (1.f / 1024.f) + EPS);
#pragma unroll
            for (int j = 0; j < 2; ++j) {
                const f32x4 ga = ((const f32x4*)p.pre_g)[IDX4(2 * j)], gb = ((const f32x4*)p.pre_g)[IDX4(2 * j + 1)], va = v[q][2 * j], vb = v[q][2 * j + 1];
                uint4 w2; w2.x = pk2(va.x * rstd * ga.x, va.y * rstd * ga.y); w2.y = pk2(va.z * rstd * ga.z, va.w * rstd * ga.w);
                w2.z = pk2(vb.x * rstd * gb.x, vb.y * rstd * gb.y); w2.w = pk2(vb.z * rstd * gb.z, vb.w * rstd * gb.w);
                ((uint4*)(p.hb + (size_t)(row + q) * 1024))[lane + 64 * j] = w2;
            }
        }
    }
}

template <int MODE>
DI void gemm_phase(const Params& p, int layer, char* smem) {
    const bf16_t* __restrict__ A = MODE == 0 ? (layer == 0 ? p.hb : p.x1b) : p.y;
    const float* __restrict__ rsp = (MODE == 0 && layer != 0) ? p.rs : nullptr;
    const bf16_t* __restrict__ Bt = MODE == 0 ? p.WinT + (size_t)layer * NPAD * 1024 : p.WoutT + (size_t)layer * 1024 * 1024;
    constexpr int NTN = MODE == 0 ? 30 : 8, K = 1024, NKT = K / 64;
    const int ntiles = 256 * NTN;
    bf16_t* As = (bf16_t*)smem;
    bf16_t* Bs = As + 2 * 128 * 72;
    const int tid = ltid(), w = tid >> 6, lane = tid & 63, r = lane & 31, h = lane >> 5, wm = w >> 1, wn = w & 1;
    const bool xmap = (gridDim.x & 7) == 0;
    const int xcd = blockIdx.x & 7, nper = gridDim.x >> 3;
    const int tstart = xmap ? (int)(blockIdx.x >> 3) : (int)blockIdx.x, tend = xmap ? 32 * NTN : ntiles, tstep = xmap ? nper : (int)gridDim.x;
#define TILE_MN(t_, m0_, n0_, nt_) { const int grp_ = (t_) / (8 * NTN), rr_ = (t_) % (8 * NTN); nt_ = rr_ >> 3; m0_ = ((xmap ? xcd * 32 : 0) + grp_ * 8 + (rr_ & 7)) * 128; n0_ = nt_ * 128; }
    int goff[4];
#pragma unroll
    for (int i = 0; i < 4; ++i) { const int R = w * 32 + i * 8 + (lane >> 3); goff[i] = R * K + (((lane & 7) ^ ((R >> 1) & 7)) * 8); }
    LAS unsigned char* lds = (LAS unsigned char*)smem;
#define DMA_SLAB(pa, pb, koff, bufi) { _Pragma("unroll") for (int i_ = 0; i_ < 4; ++i_) { \
        __builtin_amdgcn_global_load_lds((const unsigned*)((pa) + goff[i_] + (koff)), (LAS unsigned*)(lds + (bufi) * 32768 + (w * 4 + i_) * 1024), 16, 0, 0); \
        __builtin_amdgcn_global_load_lds((const unsigned*)((pb) + goff[i_] + (koff)), (LAS unsigned*)(lds + (bufi) * 32768 + 16384 + (w * 4 + i_) * 1024), 16, 0, 0); } }
    const bf16_t *ga = A, *gb = Bt;
    if (tstart < tend) {
        int m0f, n0f, ntf;
        TILE_MN(tstart, m0f, n0f, ntf)
        ga = A + (size_t)m0f * K; gb = Bt + (size_t)n0f * K;
        DMA_SLAB(ga, gb, 0, 0)
    }
    asm volatile("s_waitcnt vmcnt(0)" ::: "memory");
    __syncthreads();
    const int l15 = lane & 15, q4 = lane >> 4, fsw = (l15 >> 1) & 7;
    for (int t = tstart; t < tend; t += tstep) {
        int m0, n0, nt;
        TILE_MN(t, m0, n0, nt)
        const bf16_t *gan = ga, *gbn = gb;
        if (t + tstep < tend) { int m0n, n0n, ntn; TILE_MN(t + tstep, m0n, n0n, ntn) gan = A + (size_t)m0n * K; gbn = Bt + (size_t)n0n * K; }
        const bool isv = MODE == 0 && ((nt >= 12 && nt < 15) || (nt >= 24 && nt < 27));
        const int offm = isv ? 16384 + (wn * 64 + l15) * 128 : (wm * 64 + l15) * 128;
        const int offn = isv ? (wm * 64 + l15) * 128 : 16384 + (wn * 64 + l15) * 128;
        f32x4 acc[4][4];
#pragma unroll
        for (int a = 0; a < 4; ++a)
#pragma unroll
            for (int b = 0; b < 4; ++b) acc[a][b] = (f32x4){0.f, 0.f, 0.f, 0.f};
#pragma unroll
        for (int kt = 0; kt < NKT; ++kt) {
            const int buf = kt & 1;
            if (kt + 1 < NKT) { DMA_SLAB(ga, gb, (kt + 1) * 64, buf ^ 1) } else { DMA_SLAB(gan, gbn, 0, buf ^ 1) }
            const char* as = smem + buf * 32768 + offm;
            const char* bs = smem + buf * 32768 + offn;
#pragma unroll
            for (int kk = 0; kk < 2; ++kk) {
                const int co = ((4 * kk + q4) ^ fsw) * 16;
                bf16x8 fn[4], fm[4];
#pragma unroll
                for (int t4 = 0; t4 < 4; ++t4) { fn[t4] = *(const bf16x8*)(bs + t4 * 16 * 128 + co); fm[t4] = *(const bf16x8*)(as + t4 * 16 * 128 + co); }
#pragma unroll
                for (int tn = 0; tn < 4; ++tn)
#pragma unroll
                    for (int tm = 0; tm < 4; ++tm) acc[tn][tm] = MFMA16(fn[tn], fm[tm], acc[tn][tm]);
            }
            asm volatile("s_waitcnt vmcnt(0)" ::: "memory");
            __syncthreads();
        }
        ga = gan; gb = gbn;
        if (MODE == 1) {
            bf16_t* Cs = (bf16_t*)(smem + 32768);
#pragma unroll
            for (int tm = 0; tm < 4; ++tm)
#pragma unroll
                for (int tn = 0; tn < 4; ++tn) {
                    uint2 v; v.x = pk2(acc[tn][tm][0], acc[tn][tm][1]); v.y = pk2(acc[tn][tm][2], acc[tn][tm][3]);
                    *(uint2*)(Cs + (wm * 64 + tm * 16 + l15) * 136 + wn * 64 + tn * 16 + 4 * q4) = v;
                }
            __syncthreads();
#pragma unroll
            for (int i = 0; i < 8; ++i) {
                const int c = tid + i * 256, row = c >> 4, cc = c & 15;
                *(uint4*)(p.o + (size_t)(m0 + row) * 1024 + n0 + cc * 8) = *(const uint4*)&Cs[row * 136 + cc * 8];
            }
            __syncthreads();
        } else {
            if (nt == 30) {
                if (wn == 0 && q4 < 2) {
#pragma unroll
                    for (int tm = 0; tm < 4; ++tm) {
                        const int tok = m0 + wm * 64 + tm * 16 + l15, b = tok >> 12, sq = tok & 4095;
#pragma unroll
                        for (int u = 0; u < 4; ++u) {
                            const int n = 4 * q4 + u;
                            if (n < 6) p.lf[(size_t)(b * 6 + n) * 4096 + sq] = logsigmoid_f(acc[0][tm][u] + p.b_f[layer * 6 + n]);
                        }
                    }
                }
            } else {
                int kind;
                if (nt < 4) kind = 1; else if (nt < 6) kind = 2; else if (nt < 9) kind = 3; else if (nt < 12) kind = 4; else if (nt < 15) kind = 0;
                else if (nt < 18) kind = 2; else if (nt < 21) kind = 5; else if (nt < 27) kind = 0; else kind = 2;
                if (rsp) {
                    if (isv) {
#pragma unroll
                        for (int a2 = 0; a2 < 4; ++a2) {
                            const f32x4 rv = *(const f32x4*)(rsp + m0 + wm * 64 + a2 * 16 + 4 * q4);
#pragma unroll
                            for (int b2 = 0; b2 < 4; ++b2) acc[a2][b2] = acc[a2][b2] * rv;
                        }
                    } else {
#pragma unroll
                        for (int tm = 0; tm < 4; ++tm) {
                            const float rv = rsp[m0 + wm * 64 + tm * 16 + l15];
#pragma unroll
                            for (int tn = 0; tn < 4; ++tn) acc[tn][tm] = acc[tn][tm] * rv;
                        }
                    }
                }
                if (nt >= 21 && nt < 24) {
                    float mxn = 0.f;
#pragma unroll
                    for (int tm = 0; tm < 4; ++tm) {
                        float ssq = 0.f;
#pragma unroll
                        for (int tn = 0; tn < 4; ++tn)
#pragma unroll
                            for (int i = 0; i < 4; ++i) ssq += acc[tn][tm][i] * acc[tn][tm][i];
                        ssq += __shfl_xor(ssq, 16); ssq += __shfl_xor(ssq, 32);
                        mxn = fmaxf(mxn, ssq);
                    }
#pragma unroll
                    for (int o = 1; o < 16; o <<= 1) mxn = fmaxf(mxn, __shfl_xor(mxn, o));
                    if (lane == 0) p.kn[((m0 >> 12) * 6 + (nt - 21) * 2 + wn) * 64 + (((m0 & 4095) + wm * 64) >> 6)] = sqrtf(mxn);
                }
                bf16_t* Cs = (bf16_t*)(smem + 32768);
#pragma unroll
                for (int tm = 0; tm < 4; ++tm) {
                    if (kind == 3 || kind == 4) {
                        const float sc = kind == 3 ? 0.125f : 1.f;
                        const int pos = (m0 + wm * 64 + tm * 16 + l15) & 4095;
                        const float* rp = p.rope + (size_t)pos * 64 + 8 * q4;
#pragma unroll
                        for (int tn = 0; tn < 2; ++tn) {
                            const f32x4 c0 = *(const f32x4*)(rp + 32 * tn), c1 = *(const f32x4*)(rp + 32 * tn + 4);
                            const float cs[4] = {c0.x, c0.z, c1.x, c1.z}, sn[4] = {c0.y, c0.w, c1.y, c1.w};
#pragma unroll
                            for (int u = 0; u < 4; ++u) {
                                const float x1 = acc[tn][tm][u], x2 = acc[tn + 2][tm][u];
                                acc[tn][tm][u] = (x1 * cs[u] - x2 * sn[u]) * sc;
                                acc[tn + 2][tm][u] = (x1 * sn[u] + x2 * cs[u]) * sc;
                            }
                        }
                    }
#pragma unroll
                    for (int tn = 0; tn < 4; ++tn) {
                        if (kind == 1) {
#pragma unroll
                            for (int i = 0; i < 4; ++i) acc[tn][tm][i] = gelu_tanh_f(acc[tn][tm][i]);
                        } else if (kind == 2) {
#pragma unroll
                            for (int i = 0; i < 4; ++i) acc[tn][tm][i] = silu_f(acc[tn][tm][i]);
                        } else if (kind == 5) {
#pragma unroll
                            for (int i = 0; i < 4; ++i) acc[tn][tm][i] *= 0.125f * LOG2E;
                        }
                        uint2 v; v.x = pk2(acc[tn][tm][0], acc[tn][tm][1]); v.y = pk2(acc[tn][tm][2], acc[tn][tm][3]);
                        if (isv) *(uint2*)(Cs + (wn * 64 + tm * 16 + l15) * 136 + wm * 64 + tn * 16 + 4 * q4) = v;
                        else *(uint2*)(Cs + (wm * 64 + tm * 16 + l15) * 136 + wn * 64 + tn * 16 + 4 * q4) = v;
                    }
                    __builtin_amdgcn_sched_barrier(0);
                }
                __syncthreads();
                if (isv) {
                    const int te = ltid();
#pragma unroll
                    for (int i = 0; i < 8; ++i) {
                        const int c = te + i * 256, n = c >> 4, cc = c & 15;
                        const int hd = (nt >= 24 ? nt - 24 : nt - 12) * 2 + (n >> 6), e = n & 63;
                        bf16_t* dst = (nt >= 24 ? p.vTf : p.vTr) + ((size_t)((m0 >> 12) * 6 + hd) * 64 + e) * 4096 + (m0 & 4095) + cc * 8;
                        *(uint4*)dst = *(const uint4*)&Cs[n * 136 + cc * 8];
                    }
                } else {
                    const int n0z = n0 - (nt >= 27 ? 768 : (nt >= 15 ? 384 : 0));
#pragma unroll
                    for (int i = 0; i < 8; ++i) {
                        const int c = tid + i * 256, row = c >> 4, cc = c & 15;
                        *(uint4*)(p.z + (size_t)(m0 + row) * ZLD + n0z + cc * 8) = *(const uint4*)&Cs[row * 136 + cc * 8];
                    }
                }
                __syncthreads();
            }
        }
    }
    if (MODE == 0) {
        const bf16_t* gbl = Bt + (size_t)3840 * K;
        const int wb = w & 1;
        const int goffb = (wb * 8 + (lane >> 3)) * K + (((lane & 7) ^ (((wb * 8 + (lane >> 3)) >> 1) & 7)) * 8);
#define LG_DMA(pa, st, sl) { _Pragma("unroll") for (int i_ = 0; i_ < 4; ++i_) \
        __builtin_amdgcn_global_load_lds((const unsigned*)((pa) + goff[i_] + (st) * 64), (LAS unsigned*)(lds + (sl) * 16384 + (w * 4 + i_) * 1024), 16, 0, 0); \
        __builtin_amdgcn_global_load_lds((const unsigned*)(gbl + goffb + (st) * 64), (LAS unsigned*)(lds + 65536 + (sl) * 2048 + wb * 1024), 16, 0, 0); }
        for (int mt = blockIdx.x; mt < NTOK / 128; mt += gridDim.x) {
            const int m0 = mt * 128;
            const bf16_t* gal = A + (size_t)m0 * K;
            f32x4 lacc[2] = {(f32x4){0.f, 0.f, 0.f, 0.f}, (f32x4){0.f, 0.f, 0.f, 0.f}};
            LG_DMA(gal, 0, 0) LG_DMA(gal, 1, 1) LG_DMA(gal, 2, 2)
#pragma unroll
            for (int kt = 0; kt < NKT; ++kt) {
                if (kt + 2 < NKT) asm volatile("s_waitcnt vmcnt(10)" ::: "memory"); else if (kt + 1 < NKT) asm volatile("s_waitcnt vmcnt(5)" ::: "memory"); else asm volatile("s_waitcnt vmcnt(0)" ::: "memory");
                __syncthreads();
                if (kt + 3 < NKT) LG_DMA(gal, kt + 3, (kt + 3) & 3)
                const char* as = smem + (kt & 3) * 16384 + (w * 32 + l15) * 128;
                const char* bs = smem + 65536 + (kt & 3) * 2048 + l15 * 128;
#pragma unroll
                for (int kk = 0; kk < 2; ++kk) {
                    const int co = ((4 * kk + q4) ^ fsw) * 16;
                    const bf16x8 fnl = *(const bf16x8*)(bs + co);
                    const bf16x8 fm0 = *(const bf16x8*)(as + co), fm1 = *(const bf16x8*)(as + 16 * 128 + co);
                    lacc[0] = MFMA16(fnl, fm0, lacc[0]); lacc[1] = MFMA16(fnl, fm1, lacc[1]);
                }
            }
            __syncthreads();
            if (q4 < 2) {
#pragma unroll
                for (int tm = 0; tm < 2; ++tm) {
                    const int tok = m0 + w * 32 + tm * 16 + l15, b = tok >> 12, sq = tok & 4095;
#pragma unroll
                    for (int u = 0; u < 4; ++u) {
                        const int n = 4 * q4 + u;
                        if (n < 6) p.lf[(size_t)(b * 6 + n) * 4096 + sq] = logsigmoid_f(lacc[tm][u] * (rsp ? rsp[tok] : 1.f) + p.b_f[layer * 6 + n]);
                    }
                }
            }
        }
    }
}

DI void unpack8(const uint4 v, float* f) { f[0] = lo_f(v.x); f[1] = hi_f(v.x); f[2] = lo_f(v.y); f[3] = hi_f(v.y); f[4] = lo_f(v.z); f[5] = hi_f(v.z); f[6] = lo_f(v.w); f[7] = hi_f(v.w); }

DI void abranch_item(const Params& p, int layer, int item, char* smem) {
    const int g = item & 3, nb = (item >> 2) & 31, b = item >> 7;
    const int t0 = b * 4096 + nb * 128;
    bf16_t* vnT = (bf16_t*)smem;
    const int tid = ltid(), w = tid >> 6, lane = tid & 63, r = lane & 31, h = lane >> 5;
    {
        const int tok = tid >> 1, half = tid & 1;
        const uint4* src = (const uint4*)(p.z + (size_t)(t0 + tok) * ZLD + C_AV + g * 64 + half * 32);
        float v[32];
#pragma unroll
        for (int i = 0; i < 4; ++i) unpack8(src[i], v + 8 * i);
        float s = 0.f;
#pragma unroll
        for (int i = 0; i < 32; ++i) s += v[i];
        s += __shfl_xor(s, 1);
        const float mean = s * (1.f / 64.f);
        float q = 0.f;
#pragma unroll
        for (int i = 0; i < 32; ++i) { v[i] -= mean; q += v[i] * v[i]; }
        q += __shfl_xor(q, 1);
        const float rstd = rsqrtf(q * (1.f / 64.f) + EPS);
        const float* gain = p.a_ng + layer * 256 + g * 64 + half * 32;
#pragma unroll
        for (int i = 0; i < 32; ++i) vnT[(half * 32 + i) * 136 + tok] = f2bf(v[i] * rstd * gain[i]);
    }
    __syncthreads();
    f32x16 acc[2] = {zero16(), zero16()};
    const bf16_t* wrow = p.WsA + ((size_t)(layer * 4 + g) * 128 + w * 32 + r) * 128 + h * 8;
    const int kmax = (w < 2) ? 4 : 8;
    for (int ks = 0; ks < kmax; ++ks) {
        const bf16x8 bfr = *(const bf16x8*)(wrow + ks * 16);
#pragma unroll
        for (int ct = 0; ct < 2; ++ct) {
            const bf16x8 afr = *(const bf16x8*)&vnT[(ct * 32 + r) * 136 + ks * 16 + h * 8];
            acc[ct] = MFMA32(afr, bfr, acc[ct]);
        }
    }
    const int i = w * 32 + r, tok = t0 + i;
    const float bias = p.a_sb[(layer * 4 + g) * 128 + i];
#pragma unroll
    for (int ct = 0; ct < 2; ++ct)
#pragma unroll
        for (int gq = 0; gq < 4; ++gq) {
            const int c0 = ct * 32 + 8 * gq + 4 * h;
            const uint2 u = *(const uint2*)(p.z + (size_t)tok * ZLD + C_AU + g * 64 + c0);
            const uint2 sg = *(const uint2*)(p.z + (size_t)tok * ZLD + C_AG + g * 64 + c0);
            const float o0 = lo_f(u.x) * (acc[ct][4 * gq] + bias) * lo_f(sg.x), o1 = hi_f(u.x) * (acc[ct][4 * gq + 1] + bias) * hi_f(sg.x);
            const float o2 = lo_f(u.y) * (acc[ct][4 * gq + 2] + bias) * lo_f(sg.y), o3 = hi_f(u.y) * (acc[ct][4 * gq + 3] + bias) * hi_f(sg.y);
            uint2 ov; ov.x = pk2(o0, o1); ov.y = pk2(o2, o3);
            *(uint2*)(p.y + (size_t)tok * 1024 + g * 64 + c0) = ov;
        }
    __syncthreads();
}

DI void kv_item(const Params& p, int item, char* smem) {
    const int n = item & 63, bh = item >> 6, hd = bh % 6, b = bh / 6;
    const int t0 = b * 4096 + n * 64;
    bf16_t* KT = (bf16_t*)smem;
    bf16_t* VT = KT + 64 * 72;
    const int tid = ltid(), w = tid >> 6, lane = tid & 63, r = lane & 31, h = lane >> 5;
    {
        const int j = tid >> 2, part = tid & 3;
        const uint4* ks = (const uint4*)(p.z + (size_t)(t0 + j) * ZLD + C_RK + hd * 64 + part * 16);
        const uint4* vs = (const uint4*)(p.vTr + ((size_t)bh * 64 + j) * 4096 + n * 64 + part * 16);
        float kf[16]; unpack8(ks[0], kf); unpack8(ks[1], kf + 8);
        *(uint4*)&VT[j * 72 + part * 16] = vs[0]; *(uint4*)&VT[j * 72 + part * 16 + 8] = vs[1];
        const float lg = logf(1.f - exp2f(-5.f - (float)hd));
        const float kd = expf(lg * (float)(63 - j));
#pragma unroll
        for (int q = 0; q < 16; ++q) {
            KT[(part * 16 + q) * 72 + j] = f2bf(kf[q] * kd);
        }
    }
    __syncthreads();
    const int dt = w >> 1, et = w & 1;
    f32x16 acc = zero16();
#pragma unroll
    for (int ks = 0; ks < 4; ++ks) {
        const bf16x8 a = *(const bf16x8*)&KT[(dt * 32 + r) * 72 + ks * 16 + h * 8];
        const bf16x8 bb = *(const bf16x8*)&VT[(et * 32 + r) * 72 + ks * 16 + h * 8];
        acc = MFMA32(a, bb, acc);
    }
    float* dst = p.kv + (size_t)item * 4096 + (et * 32 + r) * 64 + dt * 32 + 4 * h;
#pragma unroll
    for (int gq = 0; gq < 4; ++gq) { f32x4 v = {acc[4 * gq], acc[4 * gq + 1], acc[4 * gq + 2], acc[4 * gq + 3]}; *(f32x4*)(dst + 8 * gq) = v; }
    __syncthreads();
}

DI void cumsum_item(const Params& p, int item, char* smem) {
    const float* src = p.lf + (size_t)item * 4096;
    float* dst = p.cf + (size_t)item * 4096;
    float* wt = (float*)smem;
    const int tid = ltid(), w = tid >> 6, lane = tid & 63;
    float v[16];
#pragma unroll
    for (int i = 0; i < 4; ++i) { const f32x4 t = ((const f32x4*)src)[tid * 4 + i]; v[4 * i] = t.x; v[4 * i + 1] = t.y; v[4 * i + 2] = t.z; v[4 * i + 3] = t.w; }
#pragma unroll
    for (int i = 1; i < 16; ++i) v[i] += v[i - 1];
    const float total = v[15];
    float x = total;
#pragma unroll
    for (int o = 1; o < 64; o <<= 1) { const float y = __shfl_up(x, o); if (lane >= o) x += y; }
    if (lane == 63) wt[w] = x;
    __syncthreads();
    float off = x - total;
    for (int i = 0; i < w; ++i) off += wt[i];
#pragma unroll
    for (int i = 0; i < 4; ++i) { f32x4 t = {v[4 * i] + off, v[4 * i + 1] + off, v[4 * i + 2] + off, v[4 * i + 3] + off}; ((f32x4*)dst)[tid * 4 + i] = t; }
    __syncthreads();
}

DI void phase2a(const Params& p, int layer, char* smem) {
    constexpr int N_CS = 48, N_KV = 3072;
    for (int it = blockIdx.x; it < N_CS + N_KV; it += gridDim.x) {
        if (it < N_CS) cumsum_item(p, it, smem);
        else kv_item(p, it - N_CS, smem);
    }
}

DI void ret_item(const Params& p, int item, char* smem) {
    const int seg = item & 7, bh = item >> 3, hd = bh % 6, b = bh / 6;
    bf16_t* Qs = (bf16_t*)smem;
    bf16_t* Qds = Qs + 64 * 72;
    bf16_t* Ks = Qds + 64 * 72;
    bf16_t* VT = Ks + 64 * 72;
    bf16_t* ST = VT + 64 * 72;
    bf16_t* Ps = ST + 64 * 72;
    float* red = (float*)(Ps + 64 * 72);
    const int tid = ltid(), w = tid >> 6, lane = tid & 63, r = lane & 31, h = lane >> 5;
    const float lg = logf(1.f - exp2f(-5.f - (float)hd));
    const float cd = expf(lg * 64.f);
    const int e_own = tid >> 2, dpart = tid & 3;
    float st[16];
#pragma unroll
    for (int q = 0; q < 16; ++q) st[q] = 0.f;
    const float* kvb = p.kv + (size_t)bh * 64 * 4096 + e_own * 64 + dpart * 16;
#pragma unroll 8
    for (int m = 0; m < seg * 8; ++m) {
        const f32x4* s4 = (const f32x4*)(kvb + (size_t)m * 4096);
#pragma unroll
        for (int i = 0; i < 4; ++i) { const f32x4 t = s4[i]; st[4 * i] = st[4 * i] * cd + t.x; st[4 * i + 1] = st[4 * i + 1] * cd + t.y; st[4 * i + 2] = st[4 * i + 2] * cd + t.z; st[4 * i + 3] = st[4 * i + 3] * cd + t.w; }
    }
    const int lj = tid >> 2, lpart = tid & 3;
    const bf16_t* zr0 = p.z + (size_t)(b * 4096 + seg * 512 + lj) * ZLD + hd * 64 + lpart * 16;
    const bf16_t* vs0 = p.vTr + ((size_t)bh * 64 + lj) * 4096 + seg * 512 + lpart * 16;
    const float* kvs = kvb + (size_t)(seg * 8) * 4096;
    uint4 pq0 = *(const uint4*)(zr0 + C_RQ), pq1 = *(const uint4*)(zr0 + C_RQ + 8), pk0 = *(const uint4*)(zr0 + C_RK), pk1 = *(const uint4*)(zr0 + C_RK + 8);
    uint4 pv0 = *(const uint4*)vs0, pv1 = *(const uint4*)(vs0 + 8);
    f32x4 pkv0 = ((const f32x4*)kvs)[0], pkv1 = ((const f32x4*)kvs)[1], pkv2 = ((const f32x4*)kvs)[2], pkv3 = ((const f32x4*)kvs)[3];
    const float qd_c = expf(lg * (float)(lj + 1));
    float dec[16];
    {
        const int i_ = (w & 1) * 32 + r, jt_ = w >> 1;
#pragma unroll
        for (int q = 0; q < 16; ++q) { const int dd = i_ - (jt_ * 32 + crow(q, h)); dec[q] = expf(lg * (float)(dd < 0 ? -dd : dd)); }
    }
    for (int c = 0; c < 8; ++c) {
        const int n = seg * 8 + c, t0 = b * 4096 + n * 64;
        uint2 sgr[4];
        {
            uint4 s0, s1;
            s0.x = pk2(st[0], st[1]); s0.y = pk2(st[2], st[3]); s0.z = pk2(st[4], st[5]); s0.w = pk2(st[6], st[7]);
            s1.x = pk2(st[8], st[9]); s1.y = pk2(st[10], st[11]); s1.z = pk2(st[12], st[13]); s1.w = pk2(st[14], st[15]);
            *(uint4*)&ST[e_own * 72 + dpart * 16] = s0; *(uint4*)&ST[e_own * 72 + dpart * 16 + 8] = s1;
            const int j = lj, part = lpart;
            const uint4 q0 = pq0, q1 = pq1, k0 = pk0, k1 = pk1, v0 = pv0, v1 = pv1;
            *(uint4*)&Qs[j * 72 + part * 16] = q0; *(uint4*)&Qs[j * 72 + part * 16 + 8] = q1;
            *(uint4*)&Ks[j * 72 + part * 16] = k0; *(uint4*)&Ks[j * 72 + part * 16 + 8] = k1;
            const float qd = qd_c;
            float qf[16]; unpack8(q0, qf); unpack8(q1, qf + 8);
            uint4 d0, d1;
            d0.x = pk2(qf[0] * qd, qf[1] * qd); d0.y = pk2(qf[2] * qd, qf[3] * qd); d0.z = pk2(qf[4] * qd, qf[5] * qd); d0.w = pk2(qf[6] * qd, qf[7] * qd);
            d1.x = pk2(qf[8] * qd, qf[9] * qd); d1.y = pk2(qf[10] * qd, qf[11] * qd); d1.z = pk2(qf[12] * qd, qf[13] * qd); d1.w = pk2(qf[14] * qd, qf[15] * qd);
            *(uint4*)&Qds[j * 72 + part * 16] = d0; *(uint4*)&Qds[j * 72 + part * 16 + 8] = d1;
            *(uint4*)&VT[j * 72 + part * 16] = v0; *(uint4*)&VT[j * 72 + part * 16 + 8] = v1;
            if (c + 1 < 8) {
                const bf16_t* zr = zr0 + (size_t)(c + 1) * 64 * ZLD;
                pq0 = *(const uint4*)(zr + C_RQ); pq1 = *(const uint4*)(zr + C_RQ + 8); pk0 = *(const uint4*)(zr + C_RK); pk1 = *(const uint4*)(zr + C_RK + 8);
                pv0 = *(const uint4*)(vs0 + (c + 1) * 64); pv1 = *(const uint4*)(vs0 + (c + 1) * 64 + 8);
            }
            {
                const int i_ = (w & 1) * 32 + r, et_ = w >> 1;
                const bf16_t* gsrc = p.z + (size_t)(t0 + i_) * ZLD + C_RG + hd * 64 + et_ * 32 + 4 * h;
#pragma unroll
                for (int gq = 0; gq < 4; ++gq) sgr[gq] = *(const uint2*)(gsrc + 8 * gq);
            }
            __builtin_amdgcn_sched_barrier(0);
        }
        __syncthreads();
        {
            const int it = w & 1, jt = w >> 1;
            f32x16 acc = zero16();
#pragma unroll
            for (int ks = 0; ks < 4; ++ks) {
                const bf16x8 a = *(const bf16x8*)&Ks[(jt * 32 + r) * 72 + ks * 16 + h * 8];
                const bf16x8 bb = *(const bf16x8*)&Qs[(it * 32 + r) * 72 + ks * 16 + h * 8];
                acc = MFMA32(a, bb, acc);
            }
            const int i = it * 32 + r;
#pragma unroll
            for (int gq = 0; gq < 4; ++gq) {
                const int j0 = jt * 32 + 8 * gq + 4 * h;
                float pv[4];
#pragma unroll
                for (int u = 0; u < 4; ++u) pv[u] = acc[4 * gq + u] * dec[4 * gq + u];
                uint2 o; o.x = pk2(pv[0], pv[1]); o.y = pk2(pv[2], pv[3]);
                *(uint2*)&Ps[i * 72 + j0] = o;
            }
        }
        __syncthreads();
        const int it = w & 1, et = w >> 1;
        f32x16 acc = zero16();
#pragma unroll
        for (int ks = 0; ks < 4; ++ks) {
            const bf16x8 a = *(const bf16x8*)&VT[(et * 32 + r) * 72 + ks * 16 + h * 8];
            const bf16x8 bb = *(const bf16x8*)&Ps[(it * 32 + r) * 72 + ks * 16 + h * 8];
            acc = MFMA32(a, bb, acc);
        }
#pragma unroll
        for (int ks = 0; ks < 4; ++ks) {
            const bf16x8 a = *(const bf16x8*)&ST[(et * 32 + r) * 72 + ks * 16 + h * 8];
            const bf16x8 bb = *(const bf16x8*)&Qds[(it * 32 + r) * 72 + ks * 16 + h * 8];
            acc = MFMA32(a, bb, acc);
        }
        float s1 = 0.f, s2 = 0.f;
#pragma unroll
        for (int q = 0; q < 16; ++q) { s1 += acc[q]; s2 += acc[q] * acc[q]; }
        s1 += __shfl_xor(s1, 32); s2 += __shfl_xor(s2, 32);
        const int i = it * 32 + r;
        if (h == 0) { red[(et * 64 + i) * 2] = s1; red[(et * 64 + i) * 2 + 1] = s2; }
        __syncthreads();
        {
            const float t1 = red[i * 2] + red[(64 + i) * 2], t2 = red[i * 2 + 1] + red[(64 + i) * 2 + 1];
            const float mean = t1 * (1.f / 64.f);
            const float var = fmaxf(t2 * (1.f / 64.f) - mean * mean, 0.f);
            const float rstd = rsqrtf(var + EPS);
            const int tok = t0 + i;
#pragma unroll
            for (int gq = 0; gq < 4; ++gq) {
                const int e0 = et * 32 + 8 * gq + 4 * h;
                const uint2 sg = sgr[gq];
                uint2 o;
                o.x = pk2((acc[4 * gq] - mean) * rstd * lo_f(sg.x), (acc[4 * gq + 1] - mean) * rstd * hi_f(sg.x));
                o.y = pk2((acc[4 * gq + 2] - mean) * rstd * lo_f(sg.y), (acc[4 * gq + 3] - mean) * rstd * hi_f(sg.y));
                *(uint2*)(p.y + (size_t)tok * 1024 + 256 + hd * 64 + e0) = o;
            }
        }
        {
            const f32x4 kq[4] = {pkv0, pkv1, pkv2, pkv3};
#pragma unroll
            for (int i2 = 0; i2 < 4; ++i2) { const f32x4 t = kq[i2]; st[4 * i2] = st[4 * i2] * cd + t.x; st[4 * i2 + 1] = st[4 * i2 + 1] * cd + t.y; st[4 * i2 + 2] = st[4 * i2 + 2] * cd + t.z; st[4 * i2 + 3] = st[4 * i2 + 3] * cd + t.w; }
            if (c + 1 < 8) { const f32x4* s4 = (const f32x4*)(kvs + (size_t)(c + 1) * 4096); pkv0 = s4[0]; pkv1 = s4[1]; pkv2 = s4[2]; pkv3 = s4[3]; }
            __builtin_amdgcn_sched_barrier(0);
        }
    }
    __syncthreads();
}

DI void attn_item(const Params& p, int item, char* smem) {
    const int qb = 15 - item / 48, bh = item % 48, hd = bh % 6, b = bh / 6;
    float* Fall = (float*)smem;
    LAS unsigned char* lds = (LAS unsigned char*)smem;
    const int tid = ltid(), w = tid >> 6, lane = tid & 63, r = lane & 31, h = lane >> 5;
    const int q0w = qb * 256 + w * 64;
    const float* cfb = p.cf + (size_t)bh * 4096;
    const int nkt = 4 * qb + 4;
    const bf16_t* kbase = p.z + (size_t)b * 4096 * ZLD + C_FK + hd * 64;
    const bf16_t* vbase = p.vTf + (size_t)bh * 64 * 4096;
#define ATT_DMA(kt_, s_) { const int ln_ = ltid() & 63; _Pragma("unroll") for (int i_ = 0; i_ < 2; ++i_) { \
        const int R_ = (w * 2 + i_) * 8 + (ln_ >> 3), c_ = ((ln_ & 7) ^ ((R_ >> 1) & 7)) * 8;     \
        __builtin_amdgcn_global_load_lds((const unsigned*)(kbase + (size_t)(kt_) * 64 * ZLD + R_ * ZLD + c_), (LAS unsigned*)(lds + 16384 + (s_) * 16384 + (w * 2 + i_) * 1024), 16, 0, 0); \
        __builtin_amdgcn_global_load_lds((const unsigned*)(vbase + (kt_) * 64 + R_ * 4096 + c_), (LAS unsigned*)(lds + 16384 + (s_) * 16384 + 8192 + (w * 2 + i_) * 1024), 16, 0, 0); } }
    __syncthreads();
    ATT_DMA(nkt - 1, (nkt - 1) % 3)
    ATT_DMA(nkt - 2, (nkt - 2) % 3)
#pragma unroll
    for (int i = 0; i < 4; ++i) {
        const int i4 = tid + i * NTHREADS;
        if (i4 * 4 < nkt * 64) { const f32x4 c = ((const f32x4*)cfb)[i4]; ((f32x4*)Fall)[i4] = c * LOG2E; }
    }
    bf16x8 qf[2][4];
    float* own = (float*)(smem + 66560) + tid * 4;
#pragma unroll
    for (int rg = 0; rg < 2; ++rg) {
        const size_t tq = (size_t)b * 4096 + q0w + rg * 32 + r;
#pragma unroll
        for (int ks = 0; ks < 4; ++ks) qf[rg][ks] = *(const bf16x8*)(p.z + tq * ZLD + C_FQ + hd * 64 + ks * 16 + h * 8);
        own[rg] = cfb[q0w + rg * 32 + r] * LOG2E;
    }
    float* knp = (float*)(smem + 65536);
    int* flg = (int*)(smem + 65536 + 256);
    if (w == 0) {
        float kv = (lane < nkt) ? p.kn[bh * 64 + lane] : 0.f;
#pragma unroll
        for (int o = 1; o < 64; o <<= 1) { const float y = __shfl_up(kv, o); if (lane >= o) kv = fmaxf(kv, y); }
        knp[lane] = kv * 1.02f;
    }
#pragma unroll
    for (int rg = 0; rg < 2; ++rg) {
        float ssq = 0.f;
#pragma unroll
        for (int ks = 0; ks < 4; ++ks)
#pragma unroll
            for (int j = 0; j < 8; ++j) { const float qv = bf2f((unsigned)(unsigned short)qf[rg][ks][j]); ssq += qv * qv; }
        ssq += __shfl_xor(ssq, 32);
        own[2 + rg] = sqrtf(ssq);
    }
    f32x16 O[2][2] = {{zero16(), zero16()}, {zero16(), zero16()}};
    float m[2] = {-INFINITY, -INFINITY}, l[2] = {0.f, 0.f};
    const int fsw = (r >> 1) & 7;
    for (int kt = nkt - 1; kt >= 0; --kt) {
        bool wdone = false;
        if (kt < nkt - 1) {
            const float fl_ = Fall[kt * 64 + 63], kp = knp[kt];
            const f32x4 ow = *(const f32x4*)own;
            const bool ok = (ow.z * kp + ow.x - fl_ < m[0] - SKIP_T) && (ow.w * kp + ow.y - fl_ < m[1] - SKIP_T);
            wdone = (__ballot(!ok) == 0ull);
        }
        if (lane == 0) flg[(kt & 3) * 4 + w] = wdone ? 1 : 0;
        if (kt > 0) asm volatile("s_waitcnt vmcnt(4)" ::: "memory"); else asm volatile("s_waitcnt vmcnt(0)" ::: "memory");
        __syncthreads();
        {
            const int4 fl = *(const int4*)&flg[(kt & 3) * 4];
            if (fl.x & fl.y & fl.z & fl.w) break;
        }
        if (kt >= 2) ATT_DMA(kt - 2, (kt - 2) % 3)
        const int kmin = kt * 64;
        if (!wdone && kmin <= q0w + 63) {
            const char* Kt = smem + 16384 + (kt % 3) * 16384;
            const char* Vt = Kt + 8192;
#pragma unroll
            for (int rg = 0; rg < 2; ++rg) {
                const int q0 = q0w + rg * 32, qrow = q0 + r;
                const float Fi_rg = own[rg];
                if (kmin <= q0 + 31) {
#pragma unroll
                    for (int jt = 1; jt >= 0; --jt) {
                        if (kmin + jt * 32 > q0 + 31) continue;
                        f32x16 S;
#pragma unroll
                        for (int gq = 0; gq < 4; ++gq) {
                            const f32x4 fk = *(const f32x4*)&Fall[kmin + jt * 32 + 8 * gq + 4 * h];
                            S[4 * gq] = Fi_rg - fk.x; S[4 * gq + 1] = Fi_rg - fk.y; S[4 * gq + 2] = Fi_rg - fk.z; S[4 * gq + 3] = Fi_rg - fk.w;
                        }
#pragma unroll
                        for (int ks = 0; ks < 4; ++ks) {
                            const bf16x8 a = *(const bf16x8*)(Kt + (jt * 32 + r) * 128 + (((2 * ks + h) ^ fsw) * 16));
                            S = MFMA32(a, qf[rg][ks], S);
                        }
                        if (kmin + jt * 32 + 31 > q0) {
#pragma unroll
                            for (int q = 0; q < 16; ++q) { const int key = kmin + jt * 32 + crow(q, h); if (key > qrow) S[q] = -INFINITY; }
                        }
                        float mx = S[0];
#pragma unroll
                        for (int q = 1; q < 16; ++q) mx = fmaxf(mx, S[q]);
                        mx = fmaxf(mx, __shfl_xor(mx, 32));
                        if (__ballot(mx > m[rg] - SKIP_T) != 0ull) {
                            const float mnew = fmaxf(m[rg], mx);
                            const float alpha = __builtin_amdgcn_exp2f(m[rg] - mnew);
                            m[rg] = mnew;
                            float ls = 0.f;
#pragma unroll
                            for (int q = 0; q < 16; ++q) { const float pv = __builtin_amdgcn_exp2f(S[q] - mnew); S[q] = pv; ls += pv; }
                            l[rg] = l[rg] * alpha + ls;
                            if (__ballot(alpha != 1.f) != 0ull) {
#pragma unroll
                                for (int et = 0; et < 2; ++et)
#pragma unroll
                                    for (int q = 0; q < 16; ++q) O[rg][et][q] *= alpha;
                            }
#pragma unroll
                            for (int s2 = 0; s2 < 2; ++s2) {
                                uint4 pw;
                                pw.x = pk2(S[8 * s2], S[8 * s2 + 1]); pw.y = pk2(S[8 * s2 + 2], S[8 * s2 + 3]);
                                pw.z = pk2(S[8 * s2 + 4], S[8 * s2 + 5]); pw.w = pk2(S[8 * s2 + 6], S[8 * s2 + 7]);
                                const bf16x8 pf = __builtin_bit_cast(bf16x8, pw);
#pragma unroll
                                for (int et = 0; et < 2; ++et) {
                                    const char* vrow = Vt + (et * 32 + r) * 128 + 8 * h;
                                    const s16x4 lo = *(const s16x4*)(vrow + (((4 * jt + 2 * s2) ^ fsw) * 16)), hi = *(const s16x4*)(vrow + (((4 * jt + 2 * s2 + 1) ^ fsw) * 16));
                                    const bf16x8 vf = __builtin_shufflevector(lo, hi, 0, 1, 2, 3, 4, 5, 6, 7);
                                    O[rg][et] = MFMA32(vf, pf, O[rg][et]);
                                }
                            }
                        }
                    }
                }
            }
        }
    }
    asm volatile("s_waitcnt vmcnt(0)" ::: "memory");
#pragma unroll
    for (int rg = 0; rg < 2; ++rg) {
        const size_t tokq = (size_t)b * 4096 + q0w + rg * 32 + r;
        float lt = l[rg];
        lt += __shfl_xor(lt, 32);
        const float inv = 1.f / lt;
#pragma unroll
        for (int et = 0; et < 2; ++et)
#pragma unroll
            for (int gq = 0; gq < 4; ++gq) {
                const int e0 = et * 32 + 8 * gq + 4 * h;
                const uint2 sg = *(const uint2*)(p.z + tokq * ZLD + C_FG + hd * 64 + e0);
                uint2 o;
                o.x = pk2(O[rg][et][4 * gq] * inv * lo_f(sg.x), O[rg][et][4 * gq + 1] * inv * hi_f(sg.x));
                o.y = pk2(O[rg][et][4 * gq + 2] * inv * lo_f(sg.y), O[rg][et][4 * gq + 3] * inv * hi_f(sg.y));
                *(uint2*)(p.y + tokq * 1024 + 640 + hd * 64 + e0) = o;
            }
    }
}

DI void phase2b(const Params& p, int layer, char* smem, int cidx) {
    constexpr int N_ATT = 768, N_RET = 384, N_A = 1024;
    const int n_w = (layer == 0) ? I_IN + I_OUT : 0;
    int* s_item = (int*)(smem + LDS_MAIN + 16);
    for (;;) {
        if (threadIdx.x == 0) *s_item = (int)atomicAdd(p.ctr + cidx, 1u);
        __syncthreads();
        const int it = *s_item;
        __syncthreads();
        if (it >= N_RET + N_ATT + N_A + n_w) break;
        if (it < N_RET) ret_item(p, it, smem);
        else if (it < N_RET + N_ATT) attn_item(p, it - N_RET, smem);
        else if (it < N_RET + N_ATT + N_A) abranch_item(p, layer, it - N_RET - N_ATT, smem);
        else wt_item(p, 1, it - N_RET - N_ATT - N_A, (float*)smem);
        __syncthreads();
    }
}

DI void phase4(const Params& p, int layer, char* smem) {
    const int tid = ltid(), wv = tid >> 6, lane = tid & 63;
    const f32x4* pg = (const f32x4*)(p.post_g + layer * 1024);
    for (int row = (blockIdx.x * 4 + wv) * 2; row < NTOK; row += gridDim.x * 8) {
        f32x4 v[2][4], xv[2][4]; float ss[2] = {0.f, 0.f};
#pragma unroll
        for (int q = 0; q < 2; ++q)
#pragma unroll
            for (int j = 0; j < 2; ++j) { const uint4 ow = ((const uint4*)(p.o + (size_t)(row + q) * 1024))[lane + 64 * j]; v[q][2 * j] = (f32x4){lo_f(ow.x), hi_f(ow.x), lo_f(ow.y), hi_f(ow.y)}; v[q][2 * j + 1] = (f32x4){lo_f(ow.z), hi_f(ow.z), lo_f(ow.w), hi_f(ow.w)};
                if (layer == 0) { xv[q][2 * j] = ((const f32x4*)(p.x + (size_t)(row + q) * 1024))[IDX4(2 * j)]; xv[q][2 * j + 1] = ((const f32x4*)(p.x + (size_t)(row + q) * 1024))[IDX4(2 * j + 1)]; }
                else { const uint4 xw = ((const uint4*)(p.x1b + (size_t)(row + q) * 1024))[lane + 64 * j]; xv[q][2 * j] = (f32x4){lo_f(xw.x), hi_f(xw.x), lo_f(xw.y), hi_f(xw.y)}; xv[q][2 * j + 1] = (f32x4){lo_f(xw.z), hi_f(xw.z), lo_f(xw.w), hi_f(xw.w)}; } }
#pragma unroll
        for (int q = 0; q < 2; ++q)
#pragma unroll
            for (int j = 0; j < 4; ++j) ss[q] += (v[q][j].x * v[q][j].x + v[q][j].y * v[q][j].y) + (v[q][j].z * v[q][j].z + v[q][j].w * v[q][j].w);
#pragma unroll
        for (int o = 1; o < 64; o <<= 1) { ss[0] += __shfl_xor(ss[0], o); ss[1] += __shfl_xor(ss[1], o); }
        float s2[2] = {0.f, 0.f};
#pragma unroll
        for (int q = 0; q < 2; ++q) {
            const float rstd = rsqrtf(ss[q] * (1.f / 1024.f) + EPS);
#pragma unroll
            for (int j = 0; j < 4; ++j) {
                const f32x4 g = pg[IDX4(j)];
                v[q][j] = xv[q][j] + v[q][j] * rstd * g;
                if (layer != 0) ((f32x4*)(p.out + (size_t)(row + q) * 1024))[IDX4(j)] = v[q][j];
                s2[q] += (v[q][j].x * v[q][j].x + v[q][j].y * v[q][j].y) + (v[q][j].z * v[q][j].z + v[q][j].w * v[q][j].w);
            }
        }
        if (layer == 0) {
#pragma unroll
            for (int o = 1; o < 64; o <<= 1) { s2[0] += __shfl_xor(s2[0], o); s2[1] += __shfl_xor(s2[1], o); }
#pragma unroll
            for (int q = 0; q < 2; ++q) {
                if (lane == 0) p.rs[row + q] = rsqrtf(s2[q] * (1.f / 1024.f) + EPS);
#pragma unroll
                for (int j = 0; j < 2; ++j) {
                    const f32x4 va = v[q][2 * j], vb = v[q][2 * j + 1];
                    uint4 xw; xw.x = pk2(va.x, va.y); xw.y = pk2(va.z, va.w); xw.z = pk2(vb.x, vb.y); xw.w = pk2(vb.z, vb.w);
                    ((uint4*)(p.x1b + (size_t)(row + q) * 1024))[lane + 64 * j] = xw;
                }
            }
        }
    }
}

template <int PH>
__global__ void __launch_bounds__(NTHREADS, 2) __attribute__((amdgpu_waves_per_eu(2, 2))) k_phase(Params p, int layer) {
    extern __shared__ __attribute__((aligned(16))) char smem[];
    if (PH == 0) phase0(p, smem);
    else if (PH == 1) gemm_phase<0>(p, layer, smem);
    else if (PH == 2) phase2a(p, layer, smem);
    else if (PH == 3) phase2b(p, layer, smem, layer);
    else if (PH == 4) gemm_phase<1>(p, layer, smem);
    else phase4(p, layer, smem);
}

#if MEGA
__global__ void __launch_bounds__(NTHREADS, 2) __attribute__((amdgpu_waves_per_eu(2, 2))) k_mega(Params p) {
    extern __shared__ __attribute__((aligned(16))) char smem[];
    cg::grid_group grid = cg::this_grid();
    volatile LAS unsigned* st = (volatile LAS unsigned*)(smem + LDS_MAIN);
    if (threadIdx.x < 2) st[threadIdx.x] = 0u;
    __syncthreads();
    (void)xcd_barrier_post(p.bar, st);
#define XBAR() { XcdBarrier xb_; xb_.bar = p.bar; xb_.x = xb_xcc_id(); xb_.st = (volatile LAS unsigned*)(smem + LDS_MAIN); xcd_barrier(xb_); }
    phase0(p, smem);
    if (p.never) grid.sync();
    XBAR();
    if (PROBE_PH == 10) { for (int i = 0; i < 10; ++i) XBAR(); }
#pragma nounroll
    for (int layer = 0; layer < 2; ++layer) {
        gemm_phase<0>(p, layer, smem);
        XBAR();
        if ((PROBE_PH == 1 && layer == 0) || (PROBE_PH == 11 && layer == 1)) { gemm_phase<0>(p, layer, smem); XBAR(); }
        phase2a(p, layer, smem);
        XBAR();
        if (PROBE_PH == 2 && layer == 0) { phase2a(p, layer, smem); XBAR(); }
        phase2b(p, layer, smem, layer);
        XBAR();
        if (PROBE_PH == 3 && layer == 0) { phase2b(p, layer, smem, 2); XBAR(); }
        gemm_phase<1>(p, layer, smem);
        XBAR();
        if (PROBE_PH == 4 && layer == 0) { gemm_phase<1>(p, layer, smem); XBAR(); }
        phase4(p, layer, smem);
        if (PROBE_PH == 5 && layer == 0) { XBAR(); phase4(p, layer, smem); }
        if (layer == 0) XBAR();
    }
}
#endif

extern "C" void kernel_launch(void* const* d_in, const int* in_sizes, int n_in, void* d_out, int out_size, void* d_ws, size_t ws_size, hipStream_t stream) {
    static int grid_blocks = 0;
    if (grid_blocks == 0) {
        if (ws_size < WS_END) { fprintf(stderr, "kernel_launch: workspace too small: %zu < %zu\n", ws_size, (size_t)WS_END); grid_blocks = -1; return; }
        int dev = 0, cus = 0, per_cu = 0;
        hipGetDevice(&dev);
        hipDeviceGetAttribute(&cus, hipDeviceAttributeMultiprocessorCount, dev);
#if MEGA
        hipFuncSetAttribute((const void*)k_mega, hipFuncAttributeMaxDynamicSharedMemorySize, LDS_BYTES);
        hipOccupancyMaxActiveBlocksPerMultiprocessor(&per_cu, (const void*)k_mega, NTHREADS, LDS_BYTES);
#else
        hipFuncSetAttribute((const void*)k_phase<0>, hipFuncAttributeMaxDynamicSharedMemorySize, LDS_BYTES);
        hipFuncSetAttribute((const void*)k_phase<1>, hipFuncAttributeMaxDynamicSharedMemorySize, LDS_BYTES);
        hipFuncSetAttribute((const void*)k_phase<2>, hipFuncAttributeMaxDynamicSharedMemorySize, LDS_BYTES);
        hipFuncSetAttribute((const void*)k_phase<3>, hipFuncAttributeMaxDynamicSharedMemorySize, LDS_BYTES);
        hipFuncSetAttribute((const void*)k_phase<4>, hipFuncAttributeMaxDynamicSharedMemorySize, LDS_BYTES);
        hipFuncSetAttribute((const void*)k_phase<5>, hipFuncAttributeMaxDynamicSharedMemorySize, LDS_BYTES);
        per_cu = 2;
#endif
        if (per_cu < 1) per_cu = 1;
        if (per_cu > 2) per_cu = 2;
        grid_blocks = cus * per_cu;
    }
    if (grid_blocks < 0) return;
    Params p{};
    p.x = (const float*)d_in[0]; p.pre_g = (const float*)d_in[1]; p.post_g = (const float*)d_in[2]; p.w_in = (const float*)d_in[3];
    p.b_f = (const float*)d_in[4]; p.a_ng = (const float*)d_in[5]; p.a_sw = (const float*)d_in[6]; p.a_sb = (const float*)d_in[7]; p.w_out = (const float*)d_in[8];
    p.out = (float*)d_out;
    char* ws = (char*)d_ws;
    p.ctr = (unsigned*)(ws + WS_CTR);
    p.bar = (unsigned*)(ws + WS_BAR);
    p.WinT = (bf16_t*)(ws + WS_WINT); p.WoutT = (bf16_t*)(ws + WS_WOUTT); p.WsA = (bf16_t*)(ws + WS_WSA);
    p.rope = (float*)(ws + WS_ROPE); p.lf = (float*)(ws + WS_LF); p.cf = (float*)(ws + WS_CF);
    p.vTf = (bf16_t*)(ws + WS_VTF); p.vTr = (bf16_t*)(ws + WS_VTR);
    p.hb = (bf16_t*)(ws + WS_HB); p.y = (bf16_t*)(ws + WS_Y); p.kv = (float*)(ws + WS_KV);
    p.z = (bf16_t*)(ws + WS_Z); p.kn = (float*)(ws + WS_KN); p.rs = (float*)(ws + WS_RS); p.x1b = (bf16_t*)(ws + WS_X1B); p.o = (bf16_t*)(ws + WS_HB);
#if MEGA
    hipMemsetAsync(ws + WS_BAR, 0, XCD_BAR_WORDS * 4, stream);
    void* args[] = {&p};
    hipError_t e = hipLaunchCooperativeKernel((void*)k_mega, dim3(grid_blocks), dim3(NTHREADS), args, LDS_BYTES, stream);
    if (e != hipSuccess) fprintf(stderr, "cooperative launch failed: %s (grid %d)\n", hipGetErrorString(e), grid_blocks);
#else
    const dim3 g(grid_blocks), bl(NTHREADS);
    hipLaunchKernelGGL(k_phase<0>, g, bl, LDS_BYTES, stream, p, 0);
    for (int layer = 0; layer < 2; ++layer) {
        hipLaunchKernelGGL(k_phase<1>, g, bl, LDS_BYTES, stream, p, layer);
        hipLaunchKernelGGL(k_phase<2>, g, bl, LDS_BYTES, stream, p, layer);
        hipLaunchKernelGGL(k_phase<3>, g, bl, LDS_BYTES, stream, p, layer);
        hipLaunchKernelGGL(k_phase<4>, g, bl, LDS_BYTES, stream, p, layer);
        hipLaunchKernelGGL(k_phase<5>, g, bl, LDS_BYTES, stream, p, layer);
    }
#endif
}
```

```cpp
#include <hip/hip_runtime.h>
#include <hip/hip_cooperative_groups.h>
#include <cstdint>
#include <cstdio>
namespace cg = cooperative_groups;

#ifndef PROBE_PH
#define PROBE_PH -1
#endif
#ifndef MEGA
#define MEGA 1
#endif

#define DI __device__ __forceinline__
typedef unsigned short bf16_t;
typedef short bf16x8 __attribute__((ext_vector_type(8)));
typedef short s16x4 __attribute__((ext_vector_type(4)));
typedef float f32x4 __attribute__((ext_vector_type(4)));
typedef float f32x16 __attribute__((ext_vector_type(16)));

constexpr int NB = 8, SEQ = 4096, DM = 1024, NTOK = NB * SEQ, DIN = 3846, ZLD = 3072, NPAD = 3968;
constexpr int NTHREADS = 256;
constexpr float EPS = 1e-6f;
constexpr float LOG2E = 1.4426950408889634f;
constexpr float SKIP_T = 40.f;
constexpr int C_AU = 0, C_AV = 256, C_AG = 512, C_RQ = 768, C_RK = 1152, C_RG = 1536, C_FQ = 1920, C_FK = 2304, C_FG = 2688;
constexpr int LDS_MAIN = 2 * 2 * 128 * 72 * 2;
constexpr int LDS_BYTES = LDS_MAIN + 64;

struct Params {
    const float *x, *pre_g, *post_g, *w_in, *b_f, *a_ng, *a_sw, *a_sb, *w_out;
    float* out;
    bf16_t *WinT, *WoutT, *WsA, *hb, *z, *y, *vTf, *vTr, *x1b;
    bf16_t* o;
    float *kv, *lf, *cf, *rope, *kn, *rs;
    unsigned* ctr;
    unsigned* bar;
    int never;
    int pad0;
};

constexpr size_t WS_CTR = 0;
constexpr size_t WS_BAR = 256;
constexpr size_t WS_WINT = 256 + 16384;
constexpr size_t WS_WOUTT = WS_WINT + (size_t)2 * NPAD * 1024 * 2;
constexpr size_t WS_WSA = WS_WOUTT + (size_t)2 * 1024 * 1024 * 2;
constexpr size_t WS_ROPE = WS_WSA + (size_t)2 * 4 * 128 * 128 * 2;
constexpr size_t WS_LF = WS_ROPE + (size_t)4096 * 32 * 2 * 4;
constexpr size_t WS_CF = WS_LF + (size_t)48 * 4096 * 4;
constexpr size_t WS_VTF = WS_CF + (size_t)48 * 4096 * 4;
constexpr size_t WS_VTR = WS_VTF + (size_t)48 * 64 * 4096 * 2;
constexpr size_t WS_HB = WS_VTR + (size_t)48 * 64 * 4096 * 2;
constexpr size_t WS_Y = WS_HB + (size_t)NTOK * 1024 * 2;
constexpr size_t WS_KV = WS_Y + (size_t)NTOK * 1024 * 2;
constexpr size_t WS_Z = WS_KV + (size_t)3072 * 4096 * 4;
constexpr size_t WS_X1B = WS_Z + (size_t)NTOK * ZLD * 2;
constexpr size_t WS_KN = WS_X1B + (size_t)NTOK * 1024 * 2;
constexpr size_t WS_RS = WS_KN + 16384;
constexpr size_t WS_END = WS_RS + (size_t)NTOK * 4;

DI int ltid() { int t = threadIdx.x; asm volatile("" : "+v"(t)); return t; }
DI float bf2f(unsigned v) { return __uint_as_float(v << 16); }
typedef __bf16 bf16v2_t __attribute__((ext_vector_type(2)));
typedef float f32x2_t __attribute__((ext_vector_type(2)));
DI unsigned pk2(float lo, float hi) { const f32x2_t v = {lo, hi}; return __builtin_bit_cast(unsigned, __builtin_convertvector(v, bf16v2_t)); }
DI bf16_t f2bf(float x) { return (bf16_t)(pk2(x, 0.f) & 0xffffu); }
DI float lo_f(unsigned w) { return __uint_as_float(w << 16); }
DI float hi_f(unsigned w) { return __uint_as_float(w & 0xffff0000u); }
DI int crow(int reg, int h) { return (reg & 3) + 8 * (reg >> 2) + 4 * h; }
#define IDX4(jj) ((lane + 64 * ((jj) >> 1)) * 2 + ((jj) & 1))
DI float wave_sum(float v) {
#pragma unroll
    for (int o = 1; o < 64; o <<= 1) v += __shfl_xor(v, o);
    return v;
}
DI float silu_f(float x) { return x * __builtin_amdgcn_rcpf(1.f + __builtin_amdgcn_exp2f(-LOG2E * x)); }
DI float gelu_tanh_f(float x) { const float u = (-2.f * LOG2E * 0.7978845608028654f) * (x + 0.044715f * x * x * x); return x * __builtin_amdgcn_rcpf(1.f + __builtin_amdgcn_exp2f(u)); }
DI float logsigmoid_f(float x) { return fminf(x, 0.f) - log1pf(__expf(-fabsf(x))); }
#define MFMA32(a, b, c) __builtin_amdgcn_mfma_f32_32x32x16_bf16((a), (b), (c), 0, 0, 0)
#define MFMA16(a, b, c) __builtin_amdgcn_mfma_f32_16x16x32_bf16((a), (b), (c), 0, 0, 0)
DI f32x16 zero16() { f32x16 z; for (int i = 0; i < 16; ++i) z[i] = 0.f; return z; }

#define XB_TMO      128
#define XB_XCNT(j)  (256  + 64 * (j))
#define XB_XSUB(j)  (1280 + 64 * (j))
#define XB_XGEN(j)  (2304 + 64 * (j))
#define XB_TOP      3328
#define XB_TOPGEN   3392
#define XCD_BAR_WORDS 3456
#define XB_SPIN_CAP (1u << 18)
#define LAS __attribute__((address_space(3)))

__device__ __forceinline__ unsigned xb_ld(unsigned* p)              { return __hip_atomic_load(p, __ATOMIC_RELAXED, __HIP_MEMORY_SCOPE_AGENT); }
__device__ __forceinline__ unsigned xb_add(unsigned* p, unsigned v) { return __hip_atomic_fetch_add(p, v, __ATOMIC_RELAXED, __HIP_MEMORY_SCOPE_AGENT); }
__device__ __forceinline__ unsigned xb_xcc_id() { return (unsigned)__builtin_amdgcn_s_getreg((3 << 11) | 20) & 0xFu; }
#define XB_SPIN(cond, bar) do { unsigned _sp = 0; while (cond) { __builtin_amdgcn_s_sleep(1); \
    if ((++_sp & 255u) == 0u) { if (xb_ld(&(bar)[XB_TMO])) break; if (_sp > XB_SPIN_CAP) { atomicAdd(&(bar)[XB_TMO], 1u); break; } } } } while (0)

struct XcdBarrier {
    unsigned* bar; unsigned x;
    volatile LAS unsigned* st;
};

__device__ __forceinline__ XcdBarrier xcd_barrier_post(unsigned* bar, volatile LAS unsigned* st) {
    XcdBarrier b; b.bar = bar; b.x = xb_xcc_id(); b.st = st;
    if (threadIdx.x == 0) (void)xb_add(&bar[XB_XCNT(b.x)], 1u);
    return b;
}
__device__ __forceinline__ void xcd_barrier_complete(unsigned* bar, unsigned x, unsigned& nloc, unsigned& nx) {
    const unsigned G = gridDim.x * gridDim.y * gridDim.z;
    unsigned sum, cnt, mine, sp = 0u;
    for (;;) {
        sum = 0u; cnt = 0u; mine = 0u;
#pragma unroll
        for (unsigned j = 0; j < 16; ++j) { const unsigned c = xb_ld(&bar[XB_XCNT(j)]); sum += c; cnt += (c > 0u) ? 1u : 0u; mine = (j == x) ? c : mine; }
        if (sum == G) break;
        __builtin_amdgcn_s_sleep(1);
        if ((++sp & 255u) == 0u) { if (xb_ld(&bar[XB_TMO])) break; if (sp > XB_SPIN_CAP) { atomicAdd(&bar[XB_TMO], 1u); break; } }
    }
    nloc = mine > 0u ? mine : 1u; nx = cnt > 0u ? cnt : 1u;
}

__device__ __forceinline__ void xcd_barrier(const XcdBarrier& b) {
    asm volatile("s_waitcnt vmcnt(0)" ::: "memory");
    __syncthreads();
    if (threadIdx.x == 0) {
        unsigned* bar = b.bar;
        __builtin_amdgcn_s_waitcnt(0);
        unsigned nloc = b.st[0], nx = b.st[1];
        if (nloc == 0u) { xcd_barrier_complete(bar, b.x, nloc, nx); b.st[0] = nloc; b.st[1] = nx; }
        const unsigned old = xb_add(&bar[XB_XSUB(b.x)], 1u);
        const unsigned gen = old / nloc;
        if (old + 1u == (gen + 1u) * nloc) {
            __builtin_amdgcn_fence(__ATOMIC_RELEASE, "agent");
            asm volatile("s_waitcnt vmcnt(0)" ::: "memory");
            const unsigned og = xb_add(&bar[XB_TOP], 1u);
            const unsigned tg = og / nx;
            if (og + 1u == (tg + 1u) * nx) xb_add(&bar[XB_TOPGEN], 1u);
            else XB_SPIN(xb_ld(&bar[XB_TOPGEN]) == tg, bar);
            __builtin_amdgcn_fence(__ATOMIC_ACQUIRE, "agent");
            xb_add(&bar[XB_XGEN(b.x)], 1u);
            asm volatile("s_waitcnt vmcnt(0)" ::: "memory");
        } else {
            XB_SPIN(xb_ld(&bar[XB_XGEN(b.x)]) == gen, bar);
            __builtin_amdgcn_fence(__ATOMIC_ACQUIRE, "agent");
            asm volatile("s_waitcnt vmcnt(0)" ::: "memory");
        }
    }
    __syncthreads();
}

DI void transpose_item(const float* __restrict__ W, int N, int NP, bf16_t* __restrict__ WT, int item, float* scr, const float* __restrict__ gain = nullptr) {
    const int tid = ltid();
    const int nblk = NP / 64, kb = item / nblk, nb = item % nblk, k0 = kb * 64, n0 = nb * 64;
#pragma unroll
    for (int i = 0; i < 16; ++i) {
        const int kk = i * 4 + (tid >> 6), nn = tid & 63;
        scr[kk * 65 + nn] = (n0 + nn < N) ? W[(size_t)(k0 + kk) * N + n0 + nn] * (gain ? gain[k0 + kk] : 1.f) : 0.f;
    }
    __syncthreads();
    const int n = tid >> 2, c = tid & 3;
    uint4 o0, o1;
    const float* s = scr + (c * 16) * 65 + n;
    o0.x = pk2(s[0 * 65], s[1 * 65]); o0.y = pk2(s[2 * 65], s[3 * 65]); o0.z = pk2(s[4 * 65], s[5 * 65]); o0.w = pk2(s[6 * 65], s[7 * 65]);
    o1.x = pk2(s[8 * 65], s[9 * 65]); o1.y = pk2(s[10 * 65], s[11 * 65]); o1.z = pk2(s[12 * 65], s[13 * 65]); o1.w = pk2(s[14 * 65], s[15 * 65]);
    uint4* dst = (uint4*)(WT + (size_t)(n0 + n) * 1024 + k0 + c * 16);
    dst[0] = o0; dst[1] = o1;
    __syncthreads();
}

DI void rms_row_to_bf16(const float* xrow, const float* gain, bf16_t* orow, int lane) {
    f32x4 v[4]; float ss = 0.f;
#pragma unroll
    for (int j = 0; j < 4; ++j) { v[j] = ((const f32x4*)xrow)[lane + 64 * j]; ss += (v[j].x * v[j].x + v[j].y * v[j].y) + (v[j].z * v[j].z + v[j].w * v[j].w); }
    const float rstd = rsqrtf(wave_sum(ss) * (1.f / 1024.f) + EPS);
#pragma unroll
    for (int j = 0; j < 4; ++j) {
        const f32x4 g = ((const f32x4*)gain)[lane + 64 * j];
        uint2 w; w.x = pk2(v[j].x * rstd * g.x, v[j].y * rstd * g.y); w.y = pk2(v[j].z * rstd * g.z, v[j].w * rstd * g.w);
        ((uint2*)orow)[lane + 64 * j] = w;
    }
}

constexpr int I_IN = 16 * (NPAD / 64), I_OUT = 16 * 16;
DI void wt_item(const Params& p, int l, int it, float* scr) {
    if (it < I_IN) transpose_item(p.w_in + (size_t)l * 1024 * DIN, DIN, NPAD, p.WinT + (size_t)l * NPAD * 1024, it, scr, l == 1 ? p.pre_g + 1024 : nullptr);
    else transpose_item(p.w_out + (size_t)l * 1024 * 1024, 1024, 1024, p.WoutT + (size_t)l * 1024 * 1024, it - I_IN, scr);
}
DI void phase0(const Params& p, char* smem) {
    const int tid = ltid(), G = gridDim.x;
    if (blockIdx.x == 0 && tid < 8) p.ctr[tid] = 0u;
    float* scr = (float*)smem;
    for (int it = blockIdx.x; it < I_IN + I_OUT; it += G) wt_item(p, 0, it, scr);
    const int gt = blockIdx.x * NTHREADS + tid, GT = G * NTHREADS;
    for (int idx = gt; idx < 2 * 4 * 128 * 128; idx += GT) {
        const int i = (idx >> 7) & 127, j = idx & 127;
        const float w = p.a_sw[idx];
        p.WsA[idx] = f2bf(((j >> 6) <= (i >> 6)) ? w : 0.f);
    }
    for (int idx = gt; idx < 4096 * 32; idx += GT) {
        const int pos = idx >> 5, i = idx & 31;
        const float inv = powf(10000.f, -(float)i / 32.f);
        const float ang = (float)pos * inv;
        float sn, cs; sincosf(ang, &sn, &cs);
        p.rope[2 * idx] = cs; p.rope[2 * idx + 1] = sn;
    }
    const int wv = tid >> 6, lane = tid & 63;
    for (int row = (blockIdx.x * 4 + wv) * 2; row < NTOK; row += G * 8) {
        f32x4 v[2][4]; float ss[2] = {0.f, 0.f};
#pragma unroll
        for (int q = 0; q < 2; ++q)
#pragma unroll
            for (int j = 0; j < 4; ++j) v[q][j] = ((const f32x4*)(p.x + (size_t)(row + q) * 1024))[IDX4(j)];
#pragma unroll
        for (int q = 0; q < 2; ++q)
#pragma unroll
            for (int j = 0; j < 4; ++j) ss[q] += (v[q][j].x * v[q][j].x + v[q][j].y * v[q][j].y) + (v[q][j].z * v[q][j].z + v[q][j].w * v[q][j].w);
#pragma unroll
        for (int o = 1; o < 64; o <<= 1) { ss[0] += __shfl_xor(ss[0], o); ss[1] += __shfl_xor(ss[1], o); }
#pragma unroll
        for (int q = 0; q < 2; ++q) {
            const float rstd = rsqrtf(ss[q] * (1.f / 1024.f) + EPS);
#pragma unroll
            for (int j = 0; j < 2; ++j) {
                const f32x4 ga = ((const f32x4*)p.pre_g)[IDX4(2 * j)], gb = ((const f32x4*)p.pre_g)[IDX4(2 * j + 1)], va = v[q][2 * j], vb = v[q][2 * j + 1];
                uint4 w2; w2.x = pk2(va.x * rstd * ga.x, va.y * rstd * ga.y); w2.y = pk2(va.z * rstd * ga.z, va.w * rstd * ga.w);
                w2.z = pk2(vb.x * rstd * gb.x, vb.y * rstd * gb.y); w2.w = pk2(vb.z * rstd * gb.z, vb.w * rstd * gb.w);
                ((uint4*)(p.hb + (size_t)(row + q) * 1024))[lane + 64 * j] = w2;
            }
        }
    }
}

template <int MODE>
DI void gemm_phase(const Params& p, int layer, char* smem) {
    const bf16_t* __restrict__ A = MODE == 0 ? (layer == 0 ? p.hb : p.x1b) : p.y;
    const float* __restrict__ rsp = (MODE == 0 && layer != 0) ? p.rs : nullptr;
    const bf16_t* __restrict__ Bt = MODE == 0 ? p.WinT + (size_t)layer * NPAD * 1024 : p.WoutT + (size_t)layer * 1024 * 1024;
    constexpr int NTN = MODE == 0 ? 30 : 8, K = 1024, NKT = K / 64;
    const int ntiles = 256 * NTN;
    bf16_t* As = (bf16_t*)smem;
    bf16_t* Bs = As + 2 * 128 * 72;
    const int tid = ltid(), w = tid >> 6, lane = tid & 63, r = lane & 31, h = lane >> 5, wm = w >> 1, wn = w & 1;
    const bool xmap = (gridDim.x & 7) == 0;
    const int xcd = blockIdx.x & 7, nper = gridDim.x >> 3;
    const int tstart = xmap ? (int)(blockIdx.x >> 3) : (int)blockIdx.x, tend = xmap ? 32 * NTN : ntiles, tstep = xmap ? nper : (int)gridDim.x;
#define TILE_MN(t_, m0_, n0_, nt_) { const int grp_ = (t_) / (8 * NTN), rr_ = (t_) % (8 * NTN); nt_ = rr_ >> 3; m0_ = ((xmap ? xcd * 32 : 0) + grp_ * 8 + (rr_ & 7)) * 128; n0_ = nt_ * 128; }
    int goff[4];
#pragma unroll
    for (int i = 0; i < 4; ++i) { const int R = w * 32 + i * 8 + (lane >> 3); goff[i] = R * K + (((lane & 7) ^ ((R >> 1) & 7)) * 8); }
    LAS unsigned char* lds = (LAS unsigned char*)smem;
#define DMA_SLAB(pa, pb, koff, bufi) { _Pragma("unroll") for (int i_ = 0; i_ < 4; ++i_) { \
        __builtin_amdgcn_global_load_lds((const unsigned*)((pa) + goff[i_] + (koff)), (LAS unsigned*)(lds + (bufi) * 32768 + (w * 4 + i_) * 1024), 16, 0, 0); \
        __builtin_amdgcn_global_load_lds((const unsigned*)((pb) + goff[i_] + (koff)), (LAS unsigned*)(lds + (bufi) * 32768 + 16384 + (w * 4 + i_) * 1024), 16, 0, 0); } }
    const bf16_t *ga = A, *gb = Bt;
    if (tstart < tend) {
        int m0f, n0f, ntf;
        TILE_MN(tstart, m0f, n0f, ntf)
        ga = A + (size_t)m0f * K; gb = Bt + (size_t)n0f * K;
        DMA_SLAB(ga, gb, 0, 0)
    }
    asm volatile("s_waitcnt vmcnt(0)" ::: "memory");
    __syncthreads();
    const int l15 = lane & 15, q4 = lane >> 4, fsw = (l15 >> 1) & 7;
    for (int t = tstart; t < tend; t += tstep) {
        int m0, n0, nt;
        TILE_MN(t, m0, n0, nt)
        const bf16_t *gan = ga, *gbn = gb;
        if (t + tstep < tend) { int m0n, n0n, ntn; TILE_MN(t + tstep, m0n, n0n, ntn) gan = A + (size_t)m0n * K; gbn = Bt + (size_t)n0n * K; }
        const bool isv = MODE == 0 && ((nt >= 12 && nt < 15) || (nt >= 24 && nt < 27));
        const int offm = isv ? 16384 + (wn * 64 + l15) * 128 : (wm * 64 + l15) * 128;
        const int offn = isv ? (wm * 64 + l15) * 128 : 16384 + (wn * 64 + l15) * 128;
        f32x4 acc[4][4];
#pragma unroll
        for (int a = 0; a < 4; ++a)
#pragma unroll
            for (int b = 0; b < 4; ++b) acc[a][b] = (f32x4){0.f, 0.f, 0.f, 0.f};
#pragma unroll
        for (int kt = 0; kt < NKT; ++kt) {
            const int buf = kt & 1;
            if (kt + 1 < NKT) { DMA_SLAB(ga, gb, (kt + 1) * 64, buf ^ 1) } else { DMA_SLAB(gan, gbn, 0, buf ^ 1) }
            const char* as = smem + buf * 32768 + offm;
            const char* bs = smem + buf * 32768 + offn;
#pragma unroll
            for (int kk = 0; kk < 2; ++kk) {
                const int co = ((4 * kk + q4) ^ fsw) * 16;
                bf16x8 fn[4], fm[4];
#pragma unroll
                for (int t4 = 0; t4 < 4; ++t4) { fn[t4] = *(const bf16x8*)(bs + t4 * 16 * 128 + co); fm[t4] = *(const bf16x8*)(as + t4 * 16 * 128 + co); }
#pragma unroll
                for (int tn = 0; tn < 4; ++tn)
#pragma unroll
                    for (int tm = 0; tm < 4; ++tm) acc[tn][tm] = MFMA16(fn[tn], fm[tm], acc[tn][tm]);
            }
            asm volatile("s_waitcnt vmcnt(0)" ::: "memory");
            __syncthreads();
        }
        ga = gan; gb = gbn;
        if (MODE == 1) {
            bf16_t* Cs = (bf16_t*)(smem + 32768);
#pragma unroll
            for (int tm = 0; tm < 4; ++tm)
#pragma unroll
                for (int tn = 0; tn < 4; ++tn) {
                    uint2 v; v.x = pk2(acc[tn][tm][0], acc[tn][tm][1]); v.y = pk2(acc[tn][tm][2], acc[tn][tm][3]);
                    *(uint2*)(Cs + (wm * 64 + tm * 16 + l15) * 136 + wn * 64 + tn * 16 + 4 * q4) = v;
                }
            __syncthreads();
#pragma unroll
            for (int i = 0; i < 8; ++i) {
                const int c = tid + i * 256, row = c >> 4, cc = c & 15;
                *(uint4*)(p.o + (size_t)(m0 + row) * 1024 + n0 + cc * 8) = *(const uint4*)&Cs[row * 136 + cc * 8];
            }
            __syncthreads();
        } else {
            if (nt == 30) {
                if (wn == 0 && q4 < 2) {
#pragma unroll
                    for (int tm = 0; tm < 4; ++tm) {
                        const int tok = m0 + wm * 64 + tm * 16 + l15, b = tok >> 12, sq = tok & 4095;
#pragma unroll
                        for (int u = 0; u < 4; ++u) {
                            const int n = 4 * q4 + u;
                            if (n < 6) p.lf[(size_t)(b * 6 + n) * 4096 + sq] = logsigmoid_f(acc[0][tm][u] + p.b_f[layer * 6 + n]);
                        }
                    }
                }
            } else {
                int kind;
                if (nt < 4) kind = 1; else if (nt < 6) kind = 2; else if (nt < 9) kind = 3; else if (nt < 12) kind = 4; else if (nt < 15) kind = 0;
                else if (nt < 18) kind = 2; else if (nt < 21) kind = 5; else if (nt < 27) kind = 0; else kind = 2;
                if (rsp) {
                    if (isv) {
#pragma unroll
                        for (int a2 = 0; a2 < 4; ++a2) {
                            const f32x4 rv = *(const f32x4*)(rsp + m0 + wm * 64 + a2 * 16 + 4 * q4);
#pragma unroll
                            for (int b2 = 0; b2 < 4; ++b2) acc[a2][b2] = acc[a2][b2] * rv;
                        }
                    } else {
#pragma unroll
                        for (int tm = 0; tm < 4; ++tm) {
                            const float rv = rsp[m0 + wm * 64 + tm * 16 + l15];
#pragma unroll
                            for (int tn = 0; tn < 4; ++tn) acc[tn][tm] = acc[tn][tm] * rv;
                        }
                    }
                }
                if (nt >= 21 && nt < 24) {
                    float mxn = 0.f;
#pragma unroll
                    for (int tm = 0; tm < 4; ++tm) {
                        float ssq = 0.f;
#pragma unroll
                        for (int tn = 0; tn < 4; ++tn)
#pragma unroll
                            for (int i = 0; i < 4; ++i) ssq += acc[tn][tm][i] * acc[tn][tm][i];
                        ssq += __shfl_xor(ssq, 16); ssq += __shfl_xor(ssq, 32);
                        mxn = fmaxf(mxn, ssq);
                    }
#pragma unroll
                    for (int o = 1; o < 16; o <<= 1) mxn = fmaxf(mxn, __shfl_xor(mxn, o));
                    if (lane == 0) p.kn[((m0 >> 12) * 6 + (nt - 21) * 2 + wn) * 64 + (((m0 & 4095) + wm * 64) >> 6)] = sqrtf(mxn);
                }
                bf16_t* Cs = (bf16_t*)(smem + 32768);
#pragma unroll
                for (int tm = 0; tm < 4; ++tm) {
                    if (kind == 3 || kind == 4) {
                        const float sc = kind == 3 ? 0.125f : 1.f;
                        const int pos = (m0 + wm * 64 + tm * 16 + l15) & 4095;
                        const float* rp = p.rope + (size_t)pos * 64 + 8 * q4;
#pragma unroll
                        for (int tn = 0; tn < 2; ++tn) {
                            const f32x4 c0 = *(const f32x4*)(rp + 32 * tn), c1 = *(const f32x4*)(rp + 32 * tn + 4);
                            const float cs[4] = {c0.x, c0.z, c1.x, c1.z}, sn[4] = {c0.y, c0.w, c1.y, c1.w};
#pragma unroll
                            for (int u = 0; u < 4; ++u) {
                                const float x1 = acc[tn][tm][u], x2 = acc[tn + 2][tm][u];
                                acc[tn][tm][u] = (x1 * cs[u] - x2 * sn[u]) * sc;
                                acc[tn + 2][tm][u] = (x1 * sn[u] + x2 * cs[u]) * sc;
                            }
                        }
                    }
#pragma unroll
                    for (int tn = 0; tn < 4; ++tn) {
                        if (kind == 1) {
#pragma unroll
                            for (int i = 0; i < 4; ++i) acc[tn][tm][i] = gelu_tanh_f(acc[tn][tm][i]);
                        } else if (kind == 2) {
#pragma unroll
                            for (int i = 0; i < 4; ++i) acc[tn][tm][i] = silu_f(acc[tn][tm][i]);
                        } else if (kind == 5) {
#pragma unroll
                            for (int i = 0; i < 4; ++i) acc[tn][tm][i] *= 0.125f * LOG2E;
                        }
                        uint2 v; v.x = pk2(acc[tn][tm][0], acc[tn][tm][1]); v.y = pk2(acc[tn][tm][2], acc[tn][tm][3]);
                        if (isv) *(uint2*)(Cs + (wn * 64 + tm * 16 + l15) * 136 + wm * 64 + tn * 16 + 4 * q4) = v;
                        else *(uint2*)(Cs + (wm * 64 + tm * 16 + l15) * 136 + wn * 64 + tn * 16 + 4 * q4) = v;
                    }
                    __builtin_amdgcn_sched_barrier(0);
                }
                __syncthreads();
                if (isv) {
                    const int te = ltid();
#pragma unroll
                    for (int i = 0; i < 8; ++i) {
                        const int c = te + i * 256, n = c >> 4, cc = c & 15;
                        const int hd = (nt >= 24 ? nt - 24 : nt - 12) * 2 + (n >> 6), e = n & 63;
                        bf16_t* dst = (nt >= 24 ? p.vTf : p.vTr) + ((size_t)((m0 >> 12) * 6 + hd) * 64 + e) * 4096 + (m0 & 4095) + cc * 8;
                        *(uint4*)dst = *(const uint4*)&Cs[n * 136 + cc * 8];
                    }
                } else {
                    const int n0z = n0 - (nt >= 27 ? 768 : (nt >= 15 ? 384 : 0));
#pragma unroll
                    for (int i = 0; i < 8; ++i) {
                        const int c = tid + i * 256, row = c >> 4, cc = c & 15;
                        *(uint4*)(p.z + (size_t)(m0 + row) * ZLD + n0z + cc * 8) = *(const uint4*)&Cs[row * 136 + cc * 8];
                    }
                }
                __syncthreads();
            }
        }
    }
    if (MODE == 0) {
        const bf16_t* gbl = Bt + (size_t)3840 * K;
        const int wb = w & 1;
        const int goffb = (wb * 8 + (lane >> 3)) * K + (((lane & 7) ^ (((wb * 8 + (lane >> 3)) >> 1) & 7)) * 8);
#define LG_DMA(pa, st, sl) { _Pragma("unroll") for (int i_ = 0; i_ < 4; ++i_) \
        __builtin_amdgcn_global_load_lds((const unsigned*)((pa) + goff[i_] + (st) * 64), (LAS unsigned*)(lds + (sl) * 16384 + (w * 4 + i_) * 1024), 16, 0, 0); \
        __builtin_amdgcn_global_load_lds((const unsigned*)(gbl + goffb + (st) * 64), (LAS unsigned*)(lds + 65536 + (sl) * 2048 + wb * 1024), 16, 0, 0); }
        for (int mt = blockIdx.x; mt < NTOK / 128; mt += gridDim.x) {
            const int m0 = mt * 128;
            const bf16_t* gal = A + (size_t)m0 * K;
            f32x4 lacc[2] = {(f32x4){0.f, 0.f, 0.f, 0.f}, (f32x4){0.f, 0.f, 0.f, 0.f}};
            LG_DMA(gal, 0, 0) LG_DMA(gal, 1, 1) LG_DMA(gal, 2, 2)
#pragma unroll
            for (int kt = 0; kt < NKT; ++kt) {
                if (kt + 2 < NKT) asm volatile("s_waitcnt vmcnt(10)" ::: "memory"); else if (kt + 1 < NKT) asm volatile("s_waitcnt vmcnt(5)" ::: "memory"); else asm volatile("s_waitcnt vmcnt(0)" ::: "memory");
                __syncthreads();
                if (kt + 3 < NKT) LG_DMA(gal, kt + 3, (kt + 3) & 3)
                const char* as = smem + (kt & 3) * 16384 + (w * 32 + l15) * 128;
                const char* bs = smem + 65536 + (kt & 3) * 2048 + l15 * 128;
#pragma unroll
                for (int kk = 0; kk < 2; ++kk) {
                    const int co = ((4 * kk + q4) ^ fsw) * 16;
                    const bf16x8 fnl = *(const bf16x8*)(bs + co);
                    const bf16x8 fm0 = *(const bf16x8*)(as + co), fm1 = *(const bf16x8*)(as + 16 * 128 + co);
                    lacc[0] = MFMA16(fnl, fm0, lacc[0]); lacc[1] = MFMA16(fnl, fm1, lacc[1]);
                }
            }
            __syncthreads();
            if (q4 < 2) {
#pragma unroll
                for (int tm = 0; tm < 2; ++tm) {
                    const int tok = m0 + w * 32 + tm * 16 + l15, b = tok >> 12, sq = tok & 4095;
#pragma unroll
                    for (int u = 0; u < 4; ++u) {
                        const int n = 4 * q4 + u;
                        if (n < 6) p.lf[(size_t)(b * 6 + n) * 4096 + sq] = logsigmoid_f(lacc[tm][u] * (rsp ? rsp[tok] : 1.f) + p.b_f[layer * 6 + n]);
                    }
                }
            }
        }
    }
}

DI void unpack8(const uint4 v, float* f) { f[0] = lo_f(v.x); f[1] = hi_f(v.x); f[2] = lo_f(v.y); f[3] = hi_f(v.y); f[4] = lo_f(v.z); f[5] = hi_f(v.z); f[6] = lo_f(v.w); f[7] = hi_f(v.w); }

DI void abranch_item(const Params& p, int layer, int item, char* smem) {
    const int g = item & 3, nb = (item >> 2) & 31, b = item >> 7;
    const int t0 = b * 4096 + nb * 128;
    bf16_t* vnT = (bf16_t*)smem;
    const int tid = ltid(), w = tid >> 6, lane = tid & 63, r = lane & 31, h = lane >> 5;
    {
        const int tok = tid >> 1, half = tid & 1;
        const uint4* src = (const uint4*)(p.z + (size_t)(t0 + tok) * ZLD + C_AV + g * 64 + half * 32);
        float v[32];
#pragma unroll
        for (int i = 0; i < 4; ++i) unpack8(src[i], v + 8 * i);
        float s = 0.f;
#pragma unroll
        for (int i = 0; i < 32; ++i) s += v[i];
        s += __shfl_xor(s, 1);
        const float mean = s * (1.f / 64.f);
        float q = 0.f;
#pragma unroll
        for (int i = 0; i < 32; ++i) { v[i] -= mean; q += v[i] * v[i]; }
        q += __shfl_xor(q, 1);
        const float rstd = rsqrtf(q * (1.f / 64.f) + EPS);
        const float* gain = p.a_ng + layer * 256 + g * 64 + half * 32;
#pragma unroll
        for (int i = 0; i < 32; ++i) vnT[(half * 32 + i) * 136 + tok] = f2bf(v[i] * rstd * gain[i]);
    }
    __syncthreads();
    f32x16 acc[2] = {zero16(), zero16()};
    const bf16_t* wrow = p.WsA + ((size_t)(layer * 4 + g) * 128 + w * 32 + r) * 128 + h * 8;
    const int kmax = (w < 2) ? 4 : 8;
    for (int ks = 0; ks < kmax; ++ks) {
        const bf16x8 bfr = *(const bf16x8*)(wrow + ks * 16);
#pragma unroll
        for (int ct = 0; ct < 2; ++ct) {
            const bf16x8 afr = *(const bf16x8*)&vnT[(ct * 32 + r) * 136 + ks * 16 + h * 8];
            acc[ct] = MFMA32(afr, bfr, acc[ct]);
        }
    }
    const int i = w * 32 + r, tok = t0 + i;
    const float bias = p.a_sb[(layer * 4 + g) * 128 + i];
#pragma unroll
    for (int ct = 0; ct < 2; ++ct)
#pragma unroll
        for (int gq = 0; gq < 4; ++gq) {
            const int c0 = ct * 32 + 8 * gq + 4 * h;
            const uint2 u = *(const uint2*)(p.z + (size_t)tok * ZLD + C_AU + g * 64 + c0);
            const uint2 sg = *(const uint2*)(p.z + (size_t)tok * ZLD + C_AG + g * 64 + c0);
            const float o0 = lo_f(u.x) * (acc[ct][4 * gq] + bias) * lo_f(sg.x), o1 = hi_f(u.x) * (acc[ct][4 * gq + 1] + bias) * hi_f(sg.x);
            const float o2 = lo_f(u.y) * (acc[ct][4 * gq + 2] + bias) * lo_f(sg.y), o3 = hi_f(u.y) * (acc[ct][4 * gq + 3] + bias) * hi_f(sg.y);
            uint2 ov; ov.x = pk2(o0, o1); ov.y = pk2(o2, o3);
            *(uint2*)(p.y + (size_t)tok * 1024 + g * 64 + c0) = ov;
        }
    __syncthreads();
}

DI void kv_item(const Params& p, int item, char* smem) {
    const int n = item & 63, bh = item >> 6, hd = bh % 6, b = bh / 6;
    const int t0 = b * 4096 + n * 64;
    bf16_t* KT = (bf16_t*)smem;
    bf16_t* VT = KT + 64 * 72;
    const int tid = ltid(), w = tid >> 6, lane = tid & 63, r = lane & 31, h = lane >> 5;
    {
        const int j = tid >> 2, part = tid & 3;
        const uint4* ks = (const uint4*)(p.z + (size_t)(t0 + j) * ZLD + C_RK + hd * 64 + part * 16);
        const uint4* vs = (const uint4*)(p.vTr + ((size_t)bh * 64 + j) * 4096 + n * 64 + part * 16);
        float kf[16]; unpack8(ks[0], kf); unpack8(ks[1], kf + 8);
        *(uint4*)&VT[j * 72 + part * 16] = vs[0]; *(uint4*)&VT[j * 72 + part * 16 + 8] = vs[1];
        const float lg = logf(1.f - exp2f(-5.f - (float)hd));
        const float kd = expf(lg * (float)(63 - j));
#pragma unroll
        for (int q = 0; q < 16; ++q) {
            KT[(part * 16 + q) * 72 + j] = f2bf(kf[q] * kd);
        }
    }
    __syncthreads();
    const int dt = w >> 1, et = w & 1;
    f32x16 acc = zero16();
#pragma unroll
    for (int ks = 0; ks < 4; ++ks) {
        const bf16x8 a = *(const bf16x8*)&KT[(dt * 32 + r) * 72 + ks * 16 + h * 8];
        const bf16x8 bb = *(const bf16x8*)&VT[(et * 32 + r) * 72 + ks * 16 + h * 8];
        acc = MFMA32(a, bb, acc);
    }
    bf16_t* dst = (bf16_t*)p.kv + (size_t)item * 4096 + (et * 32 + r) * 64 + dt * 32 + 4 * h;
#pragma unroll
    for (int gq = 0; gq < 4; ++gq) { uint2 v; v.x = pk2(acc[4 * gq], acc[4 * gq + 1]); v.y = pk2(acc[4 * gq + 2], acc[4 * gq + 3]); *(uint2*)(dst + 8 * gq) = v; }
    __syncthreads();
}

DI void cumsum_item(const Params& p, int item, char* smem) {
    const float* src = p.lf + (size_t)item * 4096;
    float* dst = p.cf + (size_t)item * 4096;
    float* wt = (float*)smem;
    const int tid = ltid(), w = tid >> 6, lane = tid & 63;
    float v[16];
#pragma unroll
    for (int i = 0; i < 4; ++i) { const f32x4 t = ((const f32x4*)src)[tid * 4 + i]; v[4 * i] = t.x; v[4 * i + 1] = t.y; v[4 * i + 2] = t.z; v[4 * i + 3] = t.w; }
#pragma unroll
    for (int i = 1; i < 16; ++i) v[i] += v[i - 1];
    const float total = v[15];
    float x = total;
#pragma unroll
    for (int o = 1; o < 64; o <<= 1) { const float y = __shfl_up(x, o); if (lane >= o) x += y; }
    if (lane == 63) wt[w] = x;
    __syncthreads();
    float off = x - total;
    for (int i = 0; i < w; ++i) off += wt[i];
#pragma unroll
    for (int i = 0; i < 4; ++i) { f32x4 t = {v[4 * i] + off, v[4 * i + 1] + off, v[4 * i + 2] + off, v[4 * i + 3] + off}; ((f32x4*)dst)[tid * 4 + i] = t; }
    __syncthreads();
}

DI void phase2a(const Params& p, int layer, char* smem) {
    constexpr int N_CS = 48, N_KV = 3072;
    for (int it = blockIdx.x; it < N_CS + N_KV; it += gridDim.x) {
        if (it < N_CS) cumsum_item(p, it, smem);
        else kv_item(p, it - N_CS, smem);
    }
}

DI void ret_item(const Params& p, int item, char* smem) {
    const int seg = item & 7, bh = item >> 3, hd = bh % 6, b = bh / 6;
    bf16_t* Qs = (bf16_t*)smem;
    bf16_t* Qds = Qs + 64 * 72;
    bf16_t* Ks = Qds + 64 * 72;
    bf16_t* VT = Ks + 64 * 72;
    bf16_t* ST = VT + 64 * 72;
    bf16_t* Ps = ST + 64 * 72;
    float* red = (float*)(Ps + 64 * 72);
    const int tid = ltid(), w = tid >> 6, lane = tid & 63, r = lane & 31, h = lane >> 5;
    const float lg = logf(1.f - exp2f(-5.f - (float)hd));
    const float cd = expf(lg * 64.f);
    const int e_own = tid >> 2, dpart = tid & 3;
    float st[16];
#pragma unroll
    for (int q = 0; q < 16; ++q) st[q] = 0.f;
    const bf16_t* kvb = (const bf16_t*)p.kv + (size_t)bh * 64 * 4096 + e_own * 64 + dpart * 16;
#pragma unroll 8
    for (int m = 0; m < seg * 8; ++m) {
        const uint4* s4 = (const uint4*)(kvb + (size_t)m * 4096);
        float t[16]; unpack8(s4[0], t); unpack8(s4[1], t + 8);
#pragma unroll
        for (int i = 0; i < 16; ++i) st[i] = st[i] * cd + t[i];
    }
    const int lj = tid >> 2, lpart = tid & 3;
    const bf16_t* zr0 = p.z + (size_t)(b * 4096 + seg * 512 + lj) * ZLD + hd * 64 + lpart * 16;
    const bf16_t* vs0 = p.vTr + ((size_t)bh * 64 + lj) * 4096 + seg * 512 + lpart * 16;
    const bf16_t* kvs = kvb + (size_t)(seg * 8) * 4096;
    uint4 pq0 = *(const uint4*)(zr0 + C_RQ), pq1 = *(const uint4*)(zr0 + C_RQ + 8), pk0 = *(const uint4*)(zr0 + C_RK), pk1 = *(const uint4*)(zr0 + C_RK + 8);
    uint4 pv0 = *(const uint4*)vs0, pv1 = *(const uint4*)(vs0 + 8);
    uint4 pkv0 = ((const uint4*)kvs)[0], pkv1 = ((const uint4*)kvs)[1];
    const float qd_c = expf(lg * (float)(lj + 1));
    float dec[16];
    {
        const int i_ = (w & 1) * 32 + r, jt_ = w >> 1;
#pragma unroll
        for (int q = 0; q < 16; ++q) { const int dd = i_ - (jt_ * 32 + crow(q, h)); dec[q] = expf(lg * (float)(dd < 0 ? -dd : dd)); }
    }
    for (int c = 0; c < 8; ++c) {
        const int n = seg * 8 + c, t0 = b * 4096 + n * 64;
        uint2 sgr[4];
        {
            uint4 s0, s1;
            s0.x = pk2(st[0], st[1]); s0.y = pk2(st[2], st[3]); s0.z = pk2(st[4], st[5]); s0.w = pk2(st[6], st[7]);
            s1.x = pk2(st[8], st[9]); s1.y = pk2(st[10], st[11]); s1.z = pk2(st[12], st[13]); s1.w = pk2(st[14], st[15]);
            *(uint4*)&ST[e_own * 72 + dpart * 16] = s0; *(uint4*)&ST[e_own * 72 + dpart * 16 + 8] = s1;
            const int j = lj, part = lpart;
            const uint4 q0 = pq0, q1 = pq1, k0 = pk0, k1 = pk1, v0 = pv0, v1 = pv1;
            *(uint4*)&Qs[j * 72 + part * 16] = q0; *(uint4*)&Qs[j * 72 + part * 16 + 8] = q1;
            *(uint4*)&Ks[j * 72 + part * 16] = k0; *(uint4*)&Ks[j * 72 + part * 16 + 8] = k1;
            const float qd = qd_c;
            float qf[16]; unpack8(q0, qf); unpack8(q1, qf + 8);
            uint4 d0, d1;
            d0.x = pk2(qf[0] * qd, qf[1] * qd); d0.y = pk2(qf[2] * qd, qf[3] * qd); d0.z = pk2(qf[4] * qd, qf[5] * qd); d0.w = pk2(qf[6] * qd, qf[7] * qd);
            d1.x = pk2(qf[8] * qd, qf[9] * qd); d1.y = pk2(qf[10] * qd, qf[11] * qd); d1.z = pk2(qf[12] * qd, qf[13] * qd); d1.w = pk2(qf[14] * qd, qf[15] * qd);
            *(uint4*)&Qds[j * 72 + part * 16] = d0; *(uint4*)&Qds[j * 72 + part * 16 + 8] = d1;
            *(uint4*)&VT[j * 72 + part * 16] = v0; *(uint4*)&VT[j * 72 + part * 16 + 8] = v1;
            if (c + 1 < 8) {
                const bf16_t* zr = zr0 + (size_t)(c + 1) * 64 * ZLD;
                pq0 = *(const uint4*)(zr + C_RQ); pq1 = *(const uint4*)(zr + C_RQ + 8); pk0 = *(const uint4*)(zr + C_RK); pk1 = *(const uint4*)(zr + C_RK + 8);
                pv0 = *(const uint4*)(vs0 + (c + 1) * 64); pv1 = *(const uint4*)(vs0 + (c + 1) * 64 + 8);
            }
            {
                const int i_ = (w & 1) * 32 + r, et_ = w >> 1;
                const bf16_t* gsrc = p.z + (size_t)(t0 + i_) * ZLD + C_RG + hd * 64 + et_ * 32 + 4 * h;
#pragma unroll
                for (int gq = 0; gq < 4; ++gq) sgr[gq] = *(const uint2*)(gsrc + 8 * gq);
            }
            __builtin_amdgcn_sched_barrier(0);
        }
        __syncthreads();
        {
            const int it = w & 1, jt = w >> 1;
            f32x16 acc = zero16();
#pragma unroll
            for (int ks = 0; ks < 4; ++ks) {
                const bf16x8 a = *(const bf16x8*)&Ks[(jt * 32 + r) * 72 + ks * 16 + h * 8];
                const bf16x8 bb = *(const bf16x8*)&Qs[(it * 32 + r) * 72 + ks * 16 + h * 8];
                acc = MFMA32(a, bb, acc);
            }
            const int i = it * 32 + r;
#pragma unroll
            for (int gq = 0; gq < 4; ++gq) {
                const int j0 = jt * 32 + 8 * gq + 4 * h;
                float pv[4];
#pragma unroll
                for (int u = 0; u < 4; ++u) pv[u] = acc[4 * gq + u] * dec[4 * gq + u];
                uint2 o; o.x = pk2(pv[0], pv[1]); o.y = pk2(pv[2], pv[3]);
                *(uint2*)&Ps[i * 72 + j0] = o;
            }
        }
        __syncthreads();
        const int it = w & 1, et = w >> 1;
        f32x16 acc = zero16();
#pragma unroll
        for (int ks = 0; ks < 4; ++ks) {
            const bf16x8 a = *(const bf16x8*)&VT[(et * 32 + r) * 72 + ks * 16 + h * 8];
            const bf16x8 bb = *(const bf16x8*)&Ps[(it * 32 + r) * 72 + ks * 16 + h * 8];
            acc = MFMA32(a, bb, acc);
        }
#pragma unroll
        for (int ks = 0; ks < 4; ++ks) {
            const bf16x8 a = *(const bf16x8*)&ST[(et * 32 + r) * 72 + ks * 16 + h * 8];
            const bf16x8 bb = *(const bf16x8*)&Qds[(it * 32 + r) * 72 + ks * 16 + h * 8];
            acc = MFMA32(a, bb, acc);
        }
        float s1 = 0.f, s2 = 0.f;
#pragma unroll
        for (int q = 0; q < 16; ++q) { s1 += acc[q]; s2 += acc[q] * acc[q]; }
        s1 += __shfl_xor(s1, 32); s2 += __shfl_xor(s2, 32);
        const int i = it * 32 + r;
        if (h == 0) { red[(et * 64 + i) * 2] = s1; red[(et * 64 + i) * 2 + 1] = s2; }
        __syncthreads();
        {
            const float t1 = red[i * 2] + red[(64 + i) * 2], t2 = red[i * 2 + 1] + red[(64 + i) * 2 + 1];
            const float mean = t1 * (1.f / 64.f);
            const float var = fmaxf(t2 * (1.f / 64.f) - mean * mean, 0.f);
            const float rstd = rsqrtf(var + EPS);
            const int tok = t0 + i;
#pragma unroll
            for (int gq = 0; gq < 4; ++gq) {
                const int e0 = et * 32 + 8 * gq + 4 * h;
                const uint2 sg = sgr[gq];
                uint2 o;
                o.x = pk2((acc[4 * gq] - mean) * rstd * lo_f(sg.x), (acc[4 * gq + 1] - mean) * rstd * hi_f(sg.x));
                o.y = pk2((acc[4 * gq + 2] - mean) * rstd * lo_f(sg.y), (acc[4 * gq + 3] - mean) * rstd * hi_f(sg.y));
                *(uint2*)(p.y + (size_t)tok * 1024 + 256 + hd * 64 + e0) = o;
            }
        }
        {
            float t[16]; unpack8(pkv0, t); unpack8(pkv1, t + 8);
#pragma unroll
            for (int i2 = 0; i2 < 16; ++i2) st[i2] = st[i2] * cd + t[i2];
            if (c + 1 < 8) { const uint4* s4 = (const uint4*)(kvs + (size_t)(c + 1) * 4096); pkv0 = s4[0]; pkv1 = s4[1]; }
            __builtin_amdgcn_sched_barrier(0);
        }
    }
    __syncthreads();
}

DI void attn_item(const Params& p, int item, char* smem) {
    const int qb = 15 - item / 48, bh = item % 48, hd = bh % 6, b = bh / 6;
    float* Fall = (float*)smem;
    LAS unsigned char* lds = (LAS unsigned char*)smem;
    const int tid = ltid(), w = tid >> 6, lane = tid & 63, r = lane & 31, h = lane >> 5;
    const int q0w = qb * 256 + w * 64;
    const float* cfb = p.cf + (size_t)bh * 4096;
    const int nkt = 4 * qb + 4;
    const bf16_t* kbase = p.z + (size_t)b * 4096 * ZLD + C_FK + hd * 64;
    const bf16_t* vbase = p.vTf + (size_t)bh * 64 * 4096;
#define ATT_DMA(kt_, s_) { const int ln_ = ltid() & 63; _Pragma("unroll") for (int i_ = 0; i_ < 2; ++i_) { \
        const int R_ = (w * 2 + i_) * 8 + (ln_ >> 3), c_ = ((ln_ & 7) ^ ((R_ >> 1) & 7)) * 8;     \
        __builtin_amdgcn_global_load_lds((const unsigned*)(kbase + (size_t)(kt_) * 64 * ZLD + R_ * ZLD + c_), (LAS unsigned*)(lds + 16384 + (s_) * 16384 + (w * 2 + i_) * 1024), 16, 0, 0); \
        __builtin_amdgcn_global_load_lds((const unsigned*)(vbase + (kt_) * 64 + R_ * 4096 + c_), (LAS unsigned*)(lds + 16384 + (s_) * 16384 + 8192 + (w * 2 + i_) * 1024), 16, 0, 0); } }
    __syncthreads();
    ATT_DMA(nkt - 1, (nkt - 1) % 3)
    ATT_DMA(nkt - 2, (nkt - 2) % 3)
#pragma unroll
    for (int i = 0; i < 4; ++i) {
        const int i4 = tid + i * NTHREADS;
        if (i4 * 4 < nkt * 64) { const f32x4 c = ((const f32x4*)cfb)[i4]; ((f32x4*)Fall)[i4] = c * LOG2E; }
    }
    bf16x8 qf[2][4];
    float* own = (float*)(smem + 66560) + tid * 4;
#pragma unroll
    for (int rg = 0; rg < 2; ++rg) {
        const size_t tq = (size_t)b * 4096 + q0w + rg * 32 + r;
#pragma unroll
        for (int ks = 0; ks < 4; ++ks) qf[rg][ks] = *(const bf16x8*)(p.z + tq * ZLD + C_FQ + hd * 64 + ks * 16 + h * 8);
        own[rg] = cfb[q0w + rg * 32 + r] * LOG2E;
    }
    float* knp = (float*)(smem + 65536);
    int* flg = (int*)(smem + 65536 + 256);
    if (w == 0) {
        float kv = (lane < nkt) ? p.kn[bh * 64 + lane] : 0.f;
#pragma unroll
        for (int o = 1; o < 64; o <<= 1) { const float y = __shfl_up(kv, o); if (lane >= o) kv = fmaxf(kv, y); }
        knp[lane] = kv * 1.02f;
    }
#pragma unroll
    for (int rg = 0; rg < 2; ++rg) {
        float ssq = 0.f;
#pragma unroll
        for (int ks = 0; ks < 4; ++ks)
#pragma unroll
            for (int j = 0; j < 8; ++j) { const float qv = bf2f((unsigned)(unsigned short)qf[rg][ks][j]); ssq += qv * qv; }
        ssq += __shfl_xor(ssq, 32);
        own[2 + rg] = sqrtf(ssq);
    }
    f32x16 O[2][2] = {{zero16(), zero16()}, {zero16(), zero16()}};
    float m[2] = {-INFINITY, -INFINITY}, l[2] = {0.f, 0.f};
    const int fsw = (r >> 1) & 7;
    for (int kt = nkt - 1; kt >= 0; --kt) {
        bool wdone = false;
        if (kt < nkt - 1) {
            const float fl_ = Fall[kt * 64 + 63], kp = knp[kt];
            const f32x4 ow = *(const f32x4*)own;
            const bool ok = (ow.z * kp + ow.x - fl_ < m[0] - SKIP_T) && (ow.w * kp + ow.y - fl_ < m[1] - SKIP_T);
            wdone = (__ballot(!ok) == 0ull);
        }
        if (lane == 0) flg[(kt & 3) * 4 + w] = wdone ? 1 : 0;
        if (kt > 0) asm volatile("s_waitcnt vmcnt(4)" ::: "memory"); else asm volatile("s_waitcnt vmcnt(0)" ::: "memory");
        __syncthreads();
        {
            const int4 fl = *(const int4*)&flg[(kt & 3) * 4];
            if (fl.x & fl.y & fl.z & fl.w) break;
        }
        if (kt >= 2) ATT_DMA(kt - 2, (kt - 2) % 3)
        const int kmin = kt * 64;
        if (!wdone && kmin <= q0w + 63) {
            const char* Kt = smem + 16384 + (kt % 3) * 16384;
            const char* Vt = Kt + 8192;
#pragma unroll
            for (int rg = 0; rg < 2; ++rg) {
                const int q0 = q0w + rg * 32, qrow = q0 + r;
                const float Fi_rg = own[rg];
                if (kmin <= q0 + 31) {
#pragma unroll
                    for (int jt = 1; jt >= 0; --jt) {
                        if (kmin + jt * 32 > q0 + 31) continue;
                        f32x16 S;
#pragma unroll
                        for (int gq = 0; gq < 4; ++gq) {
                            const f32x4 fk = *(const f32x4*)&Fall[kmin + jt * 32 + 8 * gq + 4 * h];
                            S[4 * gq] = Fi_rg - fk.x; S[4 * gq + 1] = Fi_rg - fk.y; S[4 * gq + 2] = Fi_rg - fk.z; S[4 * gq + 3] = Fi_rg - fk.w;
                        }
#pragma unroll
                        for (int ks = 0; ks < 4; ++ks) {
                            const bf16x8 a = *(const bf16x8*)(Kt + (jt * 32 + r) * 128 + (((2 * ks + h) ^ fsw) * 16));
                            S = MFMA32(a, qf[rg][ks], S);
                        }
                        if (kmin + jt * 32 + 31 > q0) {
#pragma unroll
                            for (int q = 0; q < 16; ++q) { const int key = kmin + jt * 32 + crow(q, h); if (key > qrow) S[q] = -INFINITY; }
                        }
                        float mx = S[0];
#pragma unroll
                        for (int q = 1; q < 16; ++q) mx = fmaxf(mx, S[q]);
                        mx = fmaxf(mx, __shfl_xor(mx, 32));
                        if (__ballot(mx > m[rg] - SKIP_T) != 0ull) {
                            const float mnew = fmaxf(m[rg], mx);
                            const float alpha = __builtin_amdgcn_exp2f(m[rg] - mnew);
                            m[rg] = mnew;
                            float ls = 0.f;
#pragma unroll
                            for (int q = 0; q < 16; ++q) { const float pv = __builtin_amdgcn_exp2f(S[q] - mnew); S[q] = pv; ls += pv; }
                            l[rg] = l[rg] * alpha + ls;
                            if (__ballot(alpha != 1.f) != 0ull) {
#pragma unroll
                                for (int et = 0; et < 2; ++et)
#pragma unroll
                                    for (int q = 0; q < 16; ++q) O[rg][et][q] *= alpha;
                            }
#pragma unroll
                            for (int s2 = 0; s2 < 2; ++s2) {
                                uint4 pw;
                                pw.x = pk2(S[8 * s2], S[8 * s2 + 1]); pw.y = pk2(S[8 * s2 + 2], S[8 * s2 + 3]);
                                pw.z = pk2(S[8 * s2 + 4], S[8 * s2 + 5]); pw.w = pk2(S[8 * s2 + 6], S[8 * s2 + 7]);
                                const bf16x8 pf = __builtin_bit_cast(bf16x8, pw);
#pragma unroll
                                for (int et = 0; et < 2; ++et) {
                                    const char* vrow = Vt + (et * 32 + r) * 128 + 8 * h;
                                    const s16x4 lo = *(const s16x4*)(vrow + (((4 * jt + 2 * s2) ^ fsw) * 16)), hi = *(const s16x4*)(vrow + (((4 * jt + 2 * s2 + 1) ^ fsw) * 16));
                                    const bf16x8 vf = __builtin_shufflevector(lo, hi, 0, 1, 2, 3, 4, 5, 6, 7);
                                    O[rg][et] = MFMA32(vf, pf, O[rg][et]);
                                }
                            }
                        }
                    }
                }
            }
        }
    }
    asm volatile("s_waitcnt vmcnt(0)" ::: "memory");
#pragma unroll
    for (int rg = 0; rg < 2; ++rg) {
        const size_t tokq = (size_t)b * 4096 + q0w + rg * 32 + r;
        float lt = l[rg];
        lt += __shfl_xor(lt, 32);
        const float inv = 1.f / lt;
#pragma unroll
        for (int et = 0; et < 2; ++et)
#pragma unroll
            for (int gq = 0; gq < 4; ++gq) {
                const int e0 = et * 32 + 8 * gq + 4 * h;
                const uint2 sg = *(const uint2*)(p.z + tokq * ZLD + C_FG + hd * 64 + e0);
                uint2 o;
                o.x = pk2(O[rg][et][4 * gq] * inv * lo_f(sg.x), O[rg][et][4 * gq + 1] * inv * hi_f(sg.x));
                o.y = pk2(O[rg][et][4 * gq + 2] * inv * lo_f(sg.y), O[rg][et][4 * gq + 3] * inv * hi_f(sg.y));
                *(uint2*)(p.y + tokq * 1024 + 640 + hd * 64 + e0) = o;
            }
    }
}

DI void phase2b(const Params& p, int layer, char* smem, int cidx) {
    constexpr int N_ATT = 768, N_RET = 384, N_A = 1024;
    const int n_w = (layer == 0) ? I_IN + I_OUT : 0;
    int* s_item = (int*)(smem + LDS_MAIN + 16);
    for (;;) {
        if (threadIdx.x == 0) *s_item = (int)atomicAdd(p.ctr + cidx, 1u);
        __syncthreads();
        const int it = *s_item;
        __syncthreads();
        if (it >= N_RET + N_ATT + N_A + n_w) break;
        if (it < N_RET) ret_item(p, it, smem);
        else if (it < N_RET + N_ATT) attn_item(p, it - N_RET, smem);
        else if (it < N_RET + N_ATT + N_A) abranch_item(p, layer, it - N_RET - N_ATT, smem);
        else wt_item(p, 1, it - N_RET - N_ATT - N_A, (float*)smem);
        __syncthreads();
    }
}

DI void phase4(const Params& p, int layer, char* smem) {
    const int tid = ltid(), wv = tid >> 6, lane = tid & 63;
    const f32x4* pg = (const f32x4*)(p.post_g + layer * 1024);
    for (int row = (blockIdx.x * 4 + wv) * 2; row < NTOK; row += gridDim.x * 8) {
        f32x4 v[2][4], xv[2][4]; float ss[2] = {0.f, 0.f};
#pragma unroll
        for (int q = 0; q < 2; ++q)
#pragma unroll
            for (int j = 0; j < 2; ++j) { const uint4 ow = ((const uint4*)(p.o + (size_t)(row + q) * 1024))[lane + 64 * j]; v[q][2 * j] = (f32x4){lo_f(ow.x), hi_f(ow.x), lo_f(ow.y), hi_f(ow.y)}; v[q][2 * j + 1] = (f32x4){lo_f(ow.z), hi_f(ow.z), lo_f(ow.w), hi_f(ow.w)};
                if (layer == 0) { xv[q][2 * j] = ((const f32x4*)(p.x + (size_t)(row + q) * 1024))[IDX4(2 * j)]; xv[q][2 * j + 1] = ((const f32x4*)(p.x + (size_t)(row + q) * 1024))[IDX4(2 * j + 1)]; }
                else { const uint4 xw = ((const uint4*)(p.x1b + (size_t)(row + q) * 1024))[lane + 64 * j]; xv[q][2 * j] = (f32x4){lo_f(xw.x), hi_f(xw.x), lo_f(xw.y), hi_f(xw.y)}; xv[q][2 * j + 1] = (f32x4){lo_f(xw.z), hi_f(xw.z), lo_f(xw.w), hi_f(xw.w)}; } }
#pragma unroll
        for (int q = 0; q < 2; ++q)
#pragma unroll
            for (int j = 0; j < 4; ++j) ss[q] += (v[q][j].x * v[q][j].x + v[q][j].y * v[q][j].y) + (v[q][j].z * v[q][j].z + v[q][j].w * v[q][j].w);
#pragma unroll
        for (int o = 1; o < 64; o <<= 1) { ss[0] += __shfl_xor(ss[0], o); ss[1] += __shfl_xor(ss[1], o); }
        float s2[2] = {0.f, 0.f};
#pragma unroll
        for (int q = 0; q < 2; ++q) {
            const float rstd = rsqrtf(ss[q] * (1.f / 1024.f) + EPS);
#pragma unroll
            for (int j = 0; j < 4; ++j) {
                const f32x4 g = pg[IDX4(j)];
                v[q][j] = xv[q][j] + v[q][j] * rstd * g;
                if (layer != 0) ((f32x4*)(p.out + (size_t)(row + q) * 1024))[IDX4(j)] = v[q][j];
                s2[q] += (v[q][j].x * v[q][j].x + v[q][j].y * v[q][j].y) + (v[q][j].z * v[q][j].z + v[q][j].w * v[q][j].w);
            }
        }
        if (layer == 0) {
#pragma unroll
            for (int o = 1; o < 64; o <<= 1) { s2[0] += __shfl_xor(s2[0], o); s2[1] += __shfl_xor(s2[1], o); }
#pragma unroll
            for (int q = 0; q < 2; ++q) {
                if (lane == 0) p.rs[row + q] = rsqrtf(s2[q] * (1.f / 1024.f) + EPS);
#pragma unroll
                for (int j = 0; j < 2; ++j) {
                    const f32x4 va = v[q][2 * j], vb = v[q][2 * j + 1];
                    uint4 xw; xw.x = pk2(va.x, va.y); xw.y = pk2(va.z, va.w); xw.z = pk2(vb.x, vb.y); xw.w = pk2(vb.z, vb.w);
                    ((uint4*)(p.x1b + (size_t)(row + q) * 1024))[lane + 64 * j] = xw;
                }
            }
        }
    }
}

template <int PH>
__global__ void __launch_bounds__(NTHREADS, 2) __attribute__((amdgpu_waves_per_eu(2, 2))) k_phase(Params p, int layer) {
    extern __shared__ __attribute__((aligned(16))) char smem[];
    if (PH == 0) phase0(p, smem);
    else if (PH == 1) gemm_phase<0>(p, layer, smem);
    else if (PH == 2) phase2a(p, layer, smem);
    else if (PH == 3) phase2b(p, layer, smem, layer);
    else if (PH == 4) gemm_phase<1>(p, layer, smem);
    else phase4(p, layer, smem);
}

#if MEGA
__global__ void __launch_bounds__(NTHREADS, 2) __attribute__((amdgpu_waves_per_eu(2, 2))) k_mega(Params p) {
    extern __shared__ __attribute__((aligned(16))) char smem[];
    cg::grid_group grid = cg::this_grid();
    volatile LAS unsigned* st = (volatile LAS unsigned*)(smem + LDS_MAIN);
    if (threadIdx.x < 2) st[threadIdx.x] = 0u;
    __syncthreads();
    (void)xcd_barrier_post(p.bar, st);
#define XBAR() { XcdBarrier xb_; xb_.bar = p.bar; xb_.x = xb_xcc_id(); xb_.st = (volatile LAS unsigned*)(smem + LDS_MAIN); xcd_barrier(xb_); }
    phase0(p, smem);
    if (p.never) grid.sync();
    XBAR();
    if (PROBE_PH == 10) { for (int i = 0; i < 10; ++i) XBAR(); }
#pragma nounroll
    for (int layer = 0; layer < 2; ++layer) {
        gemm_phase<0>(p, layer, smem);
        XBAR();
        if ((PROBE_PH == 1 && layer == 0) || (PROBE_PH == 11 && layer == 1)) { gemm_phase<0>(p, layer, smem); XBAR(); }
        phase2a(p, layer, smem);
        XBAR();
        if (PROBE_PH == 2 && layer == 0) { phase2a(p, layer, smem); XBAR(); }
        phase2b(p, layer, smem, layer);
        XBAR();
        if (PROBE_PH == 3 && layer == 0) { phase2b(p, layer, smem, 2); XBAR(); }
        gemm_phase<1>(p, layer, smem);
        XBAR();
        if (PROBE_PH == 4 && layer == 0) { gemm_phase<1>(p, layer, smem); XBAR(); }
        phase4(p, layer, smem);
        if (PROBE_PH == 5 && layer == 0) { XBAR(); phase4(p, layer, smem); }
        if (layer == 0) XBAR();
    }
}
#endif

extern "C" void kernel_launch(void* const* d_in, const int* in_sizes, int n_in, void* d_out, int out_size, void* d_ws, size_t ws_size, hipStream_t stream) {
    static int grid_blocks = 0;
    if (grid_blocks == 0) {
        if (ws_size < WS_END) { fprintf(stderr, "kernel_launch: workspace too small: %zu < %zu\n", ws_size, (size_t)WS_END); grid_blocks = -1; return; }
        int dev = 0, cus = 0, per_cu = 0;
        hipGetDevice(&dev);
        hipDeviceGetAttribute(&cus, hipDeviceAttributeMultiprocessorCount, dev);
#if MEGA
        hipFuncSetAttribute((const void*)k_mega, hipFuncAttributeMaxDynamicSharedMemorySize, LDS_BYTES);
        hipOccupancyMaxActiveBlocksPerMultiprocessor(&per_cu, (const void*)k_mega, NTHREADS, LDS_BYTES);
#else
        hipFuncSetAttribute((const void*)k_phase<0>, hipFuncAttributeMaxDynamicSharedMemorySize, LDS_BYTES);
        hipFuncSetAttribute((const void*)k_phase<1>, hipFuncAttributeMaxDynamicSharedMemorySize, LDS_BYTES);
        hipFuncSetAttribute((const void*)k_phase<2>, hipFuncAttributeMaxDynamicSharedMemorySize, LDS_BYTES);
        hipFuncSetAttribute((const void*)k_phase<3>, hipFuncAttributeMaxDynamicSharedMemorySize, LDS_BYTES);
        hipFuncSetAttribute((const void*)k_phase<4>, hipFuncAttributeMaxDynamicSharedMemorySize, LDS_BYTES);
        hipFuncSetAttribute((const void*)k_phase<5>, hipFuncAttributeMaxDynamicSharedMemorySize, LDS_BYTES);
        per_cu = 2;
#endif
        if (per_cu < 1) per_cu = 1;
        if (per_cu > 2) per_cu = 2;
        grid_blocks = cus * per_cu;
    }
    if (grid_blocks < 0) return;
    Params p{};
    p.x = (const float*)d_in[0]; p.pre_g = (const float*)d_in[1]; p.post_g = (const float*)d_in[2]; p.w_in = (const float*)d_in[3];
    p.b_f = (const float*)d_in[4]; p.a_ng = (const float*)d_in[5]; p.a_sw = (const float*)d_in[6]; p.a_sb = (const float*)d_in[7]; p.w_out = (const float*)d_in[8];
    p.out = (float*)d_out;
    char* ws = (char*)d_ws;
    p.ctr = (unsigned*)(ws + WS_CTR);
    p.bar = (unsigned*)(ws + WS_BAR);
    p.WinT = (bf16_t*)(ws + WS_WINT); p.WoutT = (bf16_t*)(ws + WS_WOUTT); p.WsA = (bf16_t*)(ws + WS_WSA);
    p.rope = (float*)(ws + WS_ROPE); p.lf = (float*)(ws + WS_LF); p.cf = (float*)(ws + WS_CF);
    p.vTf = (bf16_t*)(ws + WS_VTF); p.vTr = (bf16_t*)(ws + WS_VTR);
    p.hb = (bf16_t*)(ws + WS_HB); p.y = (bf16_t*)(ws + WS_Y); p.kv = (float*)(ws + WS_KV);
    p.z = (bf16_t*)(ws + WS_Z); p.kn = (float*)(ws + WS_KN); p.rs = (float*)(ws + WS_RS); p.x1b = (bf16_t*)(ws + WS_X1B); p.o = (bf16_t*)(ws + WS_HB);
#if MEGA
    hipMemsetAsync(ws + WS_BAR, 0, XCD_BAR_WORDS * 4, stream);
    void* args[] = {&p};
    hipError_t e = hipLaunchCooperativeKernel((void*)k_mega, dim3(grid_blocks), dim3(NTHREADS), args, LDS_BYTES, stream);
    if (e != hipSuccess) fprintf(stderr, "cooperative launch failed: %s (grid %d)\n", hipGetErrorString(e), grid_blocks);
#else
    const dim3 g(grid_blocks), bl(NTHREADS);
    hipLaunchKernelGGL(k_phase<0>, g, bl, LDS_BYTES, stream, p, 0);
    for (int layer = 0; layer < 2; ++layer) {
        hipLaunchKernelGGL(k_phase<1>, g, bl, LDS_BYTES, stream, p, layer);
        hipLaunchKernelGGL(k_phase<2>, g, bl, LDS_BYTES, stream, p, layer);
        hipLaunchKernelGGL(k_phase<3>, g, bl, LDS_BYTES, stream, p, layer);
        hipLaunchKernelGGL(k_phase<4>, g, bl, LDS_BYTES, stream, p, layer);
        hipLaunchKernelGGL(k_phase<5>, g, bl, LDS_BYTES, stream, p, layer);
    }
#endif
}
```

```cpp
#include <hip/hip_runtime.h>
#include <hip/hip_cooperative_groups.h>
#include <cstdint>
#include <cstdio>
namespace cg = cooperative_groups;

#ifndef PROBE_PH
#define PROBE_PH -1
#endif
#ifndef MEGA
#define MEGA 1
#endif

#define DI __device__ __forceinline__
typedef unsigned short bf16_t;
typedef short bf16x8 __attribute__((ext_vector_type(8)));
typedef short s16x4 __attribute__((ext_vector_type(4)));
typedef float f32x4 __attribute__((ext_vector_type(4)));
typedef float f32x16 __attribute__((ext_vector_type(16)));

constexpr int NB = 8, SEQ = 4096, DM = 1024, NTOK = NB * SEQ, DIN = 3846, ZLD = 3072, NPAD = 3968;
constexpr int NTHREADS = 256;
constexpr float EPS = 1e-6f;
constexpr float LOG2E = 1.4426950408889634f;
constexpr float SKIP_T = 40.f;
constexpr int C_AU = 0, C_AV = 256, C_AG = 512, C_RQ = 768, C_RK = 1152, C_RG = 1536, C_FQ = 1920, C_FK = 2304, C_FG = 2688;
constexpr int LDS_MAIN = 2 * 2 * 128 * 72 * 2;
constexpr int LDS_BYTES = LDS_MAIN + 64;

struct Params {
    const float *x, *pre_g, *post_g, *w_in, *b_f, *a_ng, *a_sw, *a_sb, *w_out;
    float* out;
    bf16_t *WinT, *WoutT, *WsA, *hb, *z, *y, *vTf, *vTr, *x1b;
    bf16_t* o;
    float *kv, *lf, *cf, *rope, *kn, *rs;
    unsigned* ctr;
    unsigned* bar;
    int never;
    int pad0;
};

constexpr size_t WS_CTR = 0;
constexpr size_t WS_BAR = 256;
constexpr size_t WS_WINT = 256 + 16384;
constexpr size_t WS_WOUTT = WS_WINT + (size_t)2 * NPAD * 1024 * 2;
constexpr size_t WS_WSA = WS_WOUTT + (size_t)2 * 1024 * 1024 * 2;
constexpr size_t WS_ROPE = WS_WSA + (size_t)2 * 4 * 128 * 128 * 2;
constexpr size_t WS_LF = WS_ROPE + (size_t)4096 * 32 * 2 * 4;
constexpr size_t WS_CF = WS_LF + (size_t)48 * 4096 * 4;
constexpr size_t WS_VTF = WS_CF + (size_t)48 * 4096 * 4;
constexpr size_t WS_VTR = WS_VTF + (size_t)48 * 64 * 4096 * 2;
constexpr size_t WS_HB = WS_VTR + (size_t)48 * 64 * 4096 * 2;
constexpr size_t WS_Y = WS_HB + (size_t)NTOK * 1024 * 2;
constexpr size_t WS_KV = WS_Y + (size_t)NTOK * 1024 * 2;
constexpr size_t WS_Z = WS_KV + (size_t)3072 * 4096 * 4;
constexpr size_t WS_X1B = WS_Z + (size_t)NTOK * ZLD * 2;
constexpr size_t WS_KN = WS_X1B + (size_t)NTOK * 1024 * 2;
constexpr size_t WS_RS = WS_KN + 16384;
constexpr size_t WS_END = WS_RS + (size_t)NTOK * 4;

DI int ltid() { int t = threadIdx.x; asm volatile("" : "+v"(t)); return t; }
DI float bf2f(unsigned v) { return __uint_as_float(v << 16); }
typedef __bf16 bf16v2_t __attribute__((ext_vector_type(2)));
typedef float f32x2_t __attribute__((ext_vector_type(2)));
DI unsigned pk2(float lo, float hi) { const f32x2_t v = {lo, hi}; return __builtin_bit_cast(unsigned, __builtin_convertvector(v, bf16v2_t)); }
DI bf16_t f2bf(float x) { return (bf16_t)(pk2(x, 0.f) & 0xffffu); }
DI float lo_f(unsigned w) { return __uint_as_float(w << 16); }
DI float hi_f(unsigned w) { return __uint_as_float(w & 0xffff0000u); }
DI int crow(int reg, int h) { return (reg & 3) + 8 * (reg >> 2) + 4 * h; }
#define IDX4(jj) ((lane + 64 * ((jj) >> 1)) * 2 + ((jj) & 1))
DI float wave_sum(float v) {
#pragma unroll
    for (int o = 1; o < 64; o <<= 1) v += __shfl_xor(v, o);
    return v;
}
DI float silu_f(float x) { return x * __builtin_amdgcn_rcpf(1.f + __builtin_amdgcn_exp2f(-LOG2E * x)); }
DI float gelu_tanh_f(float x) { const float u = (-2.f * LOG2E * 0.7978845608028654f) * (x + 0.044715f * x * x * x); return x * __builtin_amdgcn_rcpf(1.f + __builtin_amdgcn_exp2f(u)); }
DI float logsigmoid_f(float x) { return fminf(x, 0.f) - log1pf(__expf(-fabsf(x))); }
#define MFMA32(a, b, c) __builtin_amdgcn_mfma_f32_32x32x16_bf16((a), (b), (c), 0, 0, 0)
#define MFMA16(a, b, c) __builtin_amdgcn_mfma_f32_16x16x32_bf16((a), (b), (c), 0, 0, 0)
DI f32x16 zero16() { f32x16 z; for (int i = 0; i < 16; ++i) z[i] = 0.f; return z; }

#define XB_TMO      128
#define XB_XCNT(j)  (256  + 64 * (j))
#define XB_XSUB(j)  (1280 + 64 * (j))
#define XB_XGEN(j)  (2304 + 64 * (j))
#define XB_TOP      3328
#define XB_TOPGEN   3392
#define XCD_BAR_WORDS 3456
#define XB_SPIN_CAP (1u << 18)
#define LAS __attribute__((address_space(3)))

__device__ __forceinline__ unsigned xb_ld(unsigned* p)              { return __hip_atomic_load(p, __ATOMIC_RELAXED, __HIP_MEMORY_SCOPE_AGENT); }
__device__ __forceinline__ unsigned xb_add(unsigned* p, unsigned v) { return __hip_atomic_fetch_add(p, v, __ATOMIC_RELAXED, __HIP_MEMORY_SCOPE_AGENT); }
__device__ __forceinline__ unsigned xb_xcc_id() { return (unsigned)__builtin_amdgcn_s_getreg((3 << 11) | 20) & 0xFu; }
#define XB_SPIN(cond, bar) do { unsigned _sp = 0; while (cond) { __builtin_amdgcn_s_sleep(1); \
    if ((++_sp & 255u) == 0u) { if (xb_ld(&(bar)[XB_TMO])) break; if (_sp > XB_SPIN_CAP) { atomicAdd(&(bar)[XB_TMO], 1u); break; } } } } while (0)

struct XcdBarrier {
    unsigned* bar; unsigned x;
    volatile LAS unsigned* st;
};

__device__ __forceinline__ XcdBarrier xcd_barrier_post(unsigned* bar, volatile LAS unsigned* st) {
    XcdBarrier b; b.bar = bar; b.x = xb_xcc_id(); b.st = st;
    if (threadIdx.x == 0) (void)xb_add(&bar[XB_XCNT(b.x)], 1u);
    return b;
}
__device__ __forceinline__ void xcd_barrier_complete(unsigned* bar, unsigned x, unsigned& nloc, unsigned& nx) {
    const unsigned G = gridDim.x * gridDim.y * gridDim.z;
    unsigned sum, cnt, mine, sp = 0u;
    for (;;) {
        sum = 0u; cnt = 0u; mine = 0u;
#pragma unroll
        for (unsigned j = 0; j < 16; ++j) { const unsigned c = xb_ld(&bar[XB_XCNT(j)]); sum += c; cnt += (c > 0u) ? 1u : 0u; mine = (j == x) ? c : mine; }
        if (sum == G) break;
        __builtin_amdgcn_s_sleep(1);
        if ((++sp & 255u) == 0u) { if (xb_ld(&bar[XB_TMO])) break; if (sp > XB_SPIN_CAP) { atomicAdd(&bar[XB_TMO], 1u); break; } }
    }
    nloc = mine > 0u ? mine : 1u; nx = cnt > 0u ? cnt : 1u;
}

__device__ __forceinline__ void xcd_barrier(const XcdBarrier& b) {
    asm volatile("s_waitcnt vmcnt(0)" ::: "memory");
    __syncthreads();
    if (threadIdx.x == 0) {
        unsigned* bar = b.bar;
        __builtin_amdgcn_s_waitcnt(0);
        unsigned nloc = b.st[0], nx = b.st[1];
        if (nloc == 0u) { xcd_barrier_complete(bar, b.x, nloc, nx); b.st[0] = nloc; b.st[1] = nx; }
        const unsigned old = xb_add(&bar[XB_XSUB(b.x)], 1u);
        const unsigned gen = old / nloc;
        if (old + 1u == (gen + 1u) * nloc) {
            __builtin_amdgcn_fence(__ATOMIC_RELEASE, "agent");
            asm volatile("s_waitcnt vmcnt(0)" ::: "memory");
            const unsigned og = xb_add(&bar[XB_TOP], 1u);
            const unsigned tg = og / nx;
            if (og + 1u == (tg + 1u) * nx) xb_add(&bar[XB_TOPGEN], 1u);
            else XB_SPIN(xb_ld(&bar[XB_TOPGEN]) == tg, bar);
            __builtin_amdgcn_fence(__ATOMIC_ACQUIRE, "agent");
            xb_add(&bar[XB_XGEN(b.x)], 1u);
            asm volatile("s_waitcnt vmcnt(0)" ::: "memory");
        } else {
            XB_SPIN(xb_ld(&bar[XB_XGEN(b.x)]) == gen, bar);
            __builtin_amdgcn_fence(__ATOMIC_ACQUIRE, "agent");
            asm volatile("s_waitcnt vmcnt(0)" ::: "memory");
        }
    }
    __syncthreads();
}

DI void transpose_item(const float* __restrict__ W, int N, int NP, bf16_t* __restrict__ WT, int item, float* scr, const float* __restrict__ gain = nullptr) {
    const int tid = ltid();
    const int nblk = NP / 64, kb = item / nblk, nb = item % nblk, k0 = kb * 64, n0 = nb * 64;
#pragma unroll
    for (int i = 0; i < 16; ++i) {
        const int kk = i * 4 + (tid >> 6), nn = tid & 63;
        scr[kk * 65 + nn] = (n0 + nn < N) ? W[(size_t)(k0 + kk) * N + n0 + nn] * (gain ? gain[k0 + kk] : 1.f) : 0.f;
    }
    __syncthreads();
    const int n = tid >> 2, c = tid & 3;
    uint4 o0, o1;
    const float* s = scr + (c * 16) * 65 + n;
    o0.x = pk2(s[0 * 65], s[1 * 65]); o0.y = pk2(s[2 * 65], s[3 * 65]); o0.z = pk2(s[4 * 65], s[5 * 65]); o0.w = pk2(s[6 * 65], s[7 * 65]);
    o1.x = pk2(s[8 * 65], s[9 * 65]); o1.y = pk2(s[10 * 65], s[11 * 65]); o1.z = pk2(s[12 * 65], s[13 * 65]); o1.w = pk2(s[14 * 65], s[15 * 65]);
    uint4* dst = (uint4*)(WT + (size_t)(n0 + n) * 1024 + k0 + c * 16);
    dst[0] = o0; dst[1] = o1;
    __syncthreads();
}

DI void rms_row_to_bf16(const float* xrow, const float* gain, bf16_t* orow, int lane) {
    f32x4 v[4]; float ss = 0.f;
#pragma unroll
    for (int j = 0; j < 4; ++j) { v[j] = ((const f32x4*)xrow)[lane + 64 * j]; ss += (v[j].x * v[j].x + v[j].y * v[j].y) + (v[j].z * v[j].z + v[j].w * v[j].w); }
    const float rstd = rsqrtf(wave_sum(ss) * (1.f / 1024.f) + EPS);
#pragma unroll
    for (int j = 0; j < 4; ++j) {
        const f32x4 g = ((const f32x4*)gain)[lane + 64 * j];
        uint2 w; w.x = pk2(v[j].x * rstd * g.x, v[j].y * rstd * g.y); w.y = pk2(v[j].z * rstd * g.z, v[j].w * rstd * g.w);
        ((uint2*)orow)[lane + 64 * j] = w;
    }
}

constexpr int I_IN = 16 * (NPAD / 64), I_OUT = 16 * 16;
DI void wt_item(const Params& p, int l, int it, float* scr) {
    if (it < I_IN) transpose_item(p.w_in + (size_t)l * 1024 * DIN, DIN, NPAD, p.WinT + (size_t)l * NPAD * 1024, it, scr, l == 1 ? p.pre_g + 1024 : nullptr);
    else transpose_item(p.w_out + (size_t)l * 1024 * 1024, 1024, 1024, p.WoutT + (size_t)l * 1024 * 1024, it - I_IN, scr);
}
DI void phase0(const Params& p, char* smem) {
    const int tid = ltid(), G = gridDim.x;
    if (blockIdx.x == 0 && tid < 8) p.ctr[tid] = 0u;
    float* scr = (float*)smem;
    for (int it = blockIdx.x; it < I_IN + I_OUT; it += G) wt_item(p, 0, it, scr);
    const int gt = blockIdx.x * NTHREADS + tid, GT = G * NTHREADS;
    for (int idx = gt; idx < 2 * 4 * 128 * 128; idx += GT) {
        const int i = (idx >> 7) & 127, j = idx & 127;
        const float w = p.a_sw[idx];
        p.WsA[idx] = f2bf(((j >> 6) <= (i >> 6)) ? w : 0.f);
    }
    for (int idx = gt; idx < 4096 * 32; idx += GT) {
        const int pos = idx >> 5, i = idx & 31;
        const float inv = powf(10000.f, -(float)i / 32.f);
        const float ang = (float)pos * inv;
        float sn, cs; sincosf(ang, &sn, &cs);
        p.rope[2 * idx] = cs; p.rope[2 * idx + 1] = sn;
    }
    const int wv = tid >> 6, lane = tid & 63;
    for (int row = (blockIdx.x * 4 + wv) * 2; row < NTOK; row += G * 8) {
        f32x4 v[2][4]; float ss[2] = {0.f, 0.f};
#pragma unroll
        for (int q = 0; q < 2; ++q)
#pragma unroll
            for (int j = 0; j < 4; ++j) v[q][j] = ((const f32x4*)(p.x + (size_t)(row + q) * 1024))[IDX4(j)];
#pragma unroll
        for (int q = 0; q < 2; ++q)
#pragma unroll
            for (int j = 0; j < 4; ++j) ss[q] += (v[q][j].x * v[q][j].x + v[q][j].y * v[q][j].y) + (v[q][j].z * v[q][j].z + v[q][j].w * v[q][j].w);
#pragma unroll
        for (int o = 1; o < 64; o <<= 1) { ss[0] += __shfl_xor(ss[0], o); ss[1] += __shfl_xor(ss[1], o); }
#pragma unroll
        for (int q = 0; q < 2; ++q) {
            const float rstd = rsqrtf(ss[q] * (1.f / 1024.f) + EPS);
#pragma unroll
            for (int j = 0; j < 2; ++j) {
                const f32x4 ga = ((const f32x4*)p.pre_g)[IDX4(2 * j)], gb = ((const f32x4*)p.pre_g)[IDX4(2 * j + 1)], va = v[q][2 * j], vb = v[q][2 * j + 1];
                uint4 w2; w2.x = pk2(va.x * rstd * ga.x, va.y * rstd * ga.y); w2.y = pk2(va.z * rstd * ga.z, va.w * rstd * ga.w);
                w2.z = pk2(vb.x * rstd * gb.x, vb.y * rstd * gb.y); w2.w = pk2(vb.z * rstd * gb.z, vb.w * rstd * gb.w);
                ((uint4*)(p.hb + (size_t)(row + q) * 1024))[lane + 64 * j] = w2;
            }
        }
    }
}

template <int MODE>
DI void gemm_phase(const Params& p, int layer, char* smem) {
    const bf16_t* __restrict__ A = MODE == 0 ? (layer == 0 ? p.hb : p.x1b) : p.y;
    const float* __restrict__ rsp = (MODE == 0 && layer != 0) ? p.rs : nullptr;
    const bf16_t* __restrict__ Bt = MODE == 0 ? p.WinT + (size_t)layer * NPAD * 1024 : p.WoutT + (size_t)layer * 1024 * 1024;
    constexpr int NTN = MODE == 0 ? 30 : 8, K = 1024, NKT = K / 64;
    const int ntiles = 256 * NTN;
    bf16_t* As = (bf16_t*)smem;
    bf16_t* Bs = As + 2 * 128 * 72;
    const int tid = ltid(), w = tid >> 6, lane = tid & 63, r = lane & 31, h = lane >> 5, wm = w >> 1, wn = w & 1;
    const bool xmap = (gridDim.x & 7) == 0;
    const int xcd = blockIdx.x & 7, nper = gridDim.x >> 3;
    const int tstart = xmap ? (int)(blockIdx.x >> 3) : (int)blockIdx.x, tend = xmap ? 32 * NTN : ntiles, tstep = xmap ? nper : (int)gridDim.x;
#define TILE_MN(t_, m0_, n0_, nt_) { const int grp_ = (t_) / (8 * NTN), rr_ = (t_) % (8 * NTN); nt_ = rr_ >> 3; m0_ = ((xmap ? xcd * 32 : 0) + grp_ * 8 + (rr_ & 7)) * 128; n0_ = nt_ * 128; }
    int goff[4];
#pragma unroll
    for (int i = 0; i < 4; ++i) { const int R = w * 32 + i * 8 + (lane >> 3); goff[i] = R * K + (((lane & 7) ^ ((R >> 1) & 7)) * 8); }
    LAS unsigned char* lds = (LAS unsigned char*)smem;
#define DMA_SLAB(pa, pb, koff, bufi) { _Pragma("unroll") for (int i_ = 0; i_ < 4; ++i_) { \
        __builtin_amdgcn_global_load_lds((const unsigned*)((pa) + goff[i_] + (koff)), (LAS unsigned*)(lds + (bufi) * 32768 + (w * 4 + i_) * 1024), 16, 0, 0); \
        __builtin_amdgcn_global_load_lds((const unsigned*)((pb) + goff[i_] + (koff)), (LAS unsigned*)(lds + (bufi) * 32768 + 16384 + (w * 4 + i_) * 1024), 16, 0, 0); } }
    const bf16_t *ga = A, *gb = Bt;
    if (tstart < tend) {
        int m0f, n0f, ntf;
        TILE_MN(tstart, m0f, n0f, ntf)
        ga = A + (size_t)m0f * K; gb = Bt + (size_t)n0f * K;
        DMA_SLAB(ga, gb, 0, 0)
    }
    asm volatile("s_waitcnt vmcnt(0)" ::: "memory");
    __syncthreads();
    const int l15 = lane & 15, q4 = lane >> 4, fsw = (l15 >> 1) & 7;
    for (int t = tstart; t < tend; t += tstep) {
        int m0, n0, nt;
        TILE_MN(t, m0, n0, nt)
        const bf16_t *gan = ga, *gbn = gb;
        if (t + tstep < tend) { int m0n, n0n, ntn; TILE_MN(t + tstep, m0n, n0n, ntn) gan = A + (size_t)m0n * K; gbn = Bt + (size_t)n0n * K; }
        const bool isv = MODE == 0 && ((nt >= 12 && nt < 15) || (nt >= 24 && nt < 27));
        const int offm = isv ? 16384 + (wn * 64 + l15) * 128 : (wm * 64 + l15) * 128;
        const int offn = isv ? (wm * 64 + l15) * 128 : 16384 + (wn * 64 + l15) * 128;
        f32x4 acc[4][4];
#pragma unroll
        for (int a = 0; a < 4; ++a)
#pragma unroll
            for (int b = 0; b < 4; ++b) acc[a][b] = (f32x4){0.f, 0.f, 0.f, 0.f};
#pragma unroll
        for (int kt = 0; kt < NKT; ++kt) {
            const int buf = kt & 1;
            if (kt + 1 < NKT) { DMA_SLAB(ga, gb, (kt + 1) * 64, buf ^ 1) } else { DMA_SLAB(gan, gbn, 0, buf ^ 1) }
            const char* as = smem + buf * 32768 + offm;
            const char* bs = smem + buf * 32768 + offn;
#pragma unroll
            for (int kk = 0; kk < 2; ++kk) {
                const int co = ((4 * kk + q4) ^ fsw) * 16;
                bf16x8 fn[4], fm[4];
#pragma unroll
                for (int t4 = 0; t4 < 4; ++t4) { fn[t4] = *(const bf16x8*)(bs + t4 * 16 * 128 + co); fm[t4] = *(const bf16x8*)(as + t4 * 16 * 128 + co); }
#pragma unroll
                for (int tn = 0; tn < 4; ++tn)
#pragma unroll
                    for (int tm = 0; tm < 4; ++tm) acc[tn][tm] = MFMA16(fn[tn], fm[tm], acc[tn][tm]);
            }
            asm volatile("s_waitcnt vmcnt(0)" ::: "memory");
            __syncthreads();
        }
        ga = gan; gb = gbn;
        if (MODE == 1) {
            bf16_t* Cs = (bf16_t*)(smem + 32768);
#pragma unroll
            for (int tm = 0; tm < 4; ++tm)
#pragma unroll
                for (int tn = 0; tn < 4; ++tn) {
                    uint2 v; v.x = pk2(acc[tn][tm][0], acc[tn][tm][1]); v.y = pk2(acc[tn][tm][2], acc[tn][tm][3]);
                    *(uint2*)(Cs + (wm * 64 + tm * 16 + l15) * 136 + wn * 64 + tn * 16 + 4 * q4) = v;
                }
            __syncthreads();
#pragma unroll
            for (int i = 0; i < 8; ++i) {
                const int c = tid + i * 256, row = c >> 4, cc = c & 15;
                *(uint4*)(p.o + (size_t)(m0 + row) * 1024 + n0 + cc * 8) = *(const uint4*)&Cs[row * 136 + cc * 8];
            }
            __syncthreads();
        } else {
            if (nt == 30) {
                if (wn == 0 && q4 < 2) {
#pragma unroll
                    for (int tm = 0; tm < 4; ++tm) {
                        const int tok = m0 + wm * 64 + tm * 16 + l15, b = tok >> 12, sq = tok & 4095;
#pragma unroll
                        for (int u = 0; u < 4; ++u) {
                            const int n = 4 * q4 + u;
                            if (n < 6) p.lf[(size_t)(b * 6 + n) * 4096 + sq] = logsigmoid_f(acc[0][tm][u] + p.b_f[layer * 6 + n]);
                        }
                    }
                }
            } else {
                int kind;
                if (nt < 4) kind = 1; else if (nt < 6) kind = 2; else if (nt < 9) kind = 3; else if (nt < 12) kind = 4; else if (nt < 15) kind = 0;
                else if (nt < 18) kind = 2; else if (nt < 21) kind = 5; else if (nt < 27) kind = 0; else kind = 2;
                if (rsp) {
                    if (isv) {
#pragma unroll
                        for (int a2 = 0; a2 < 4; ++a2) {
                            const f32x4 rv = *(const f32x4*)(rsp + m0 + wm * 64 + a2 * 16 + 4 * q4);
#pragma unroll
                            for (int b2 = 0; b2 < 4; ++b2) acc[a2][b2] = acc[a2][b2] * rv;
                        }
                    } else {
#pragma unroll
                        for (int tm = 0; tm < 4; ++tm) {
                            const float rv = rsp[m0 + wm * 64 + tm * 16 + l15];
#pragma unroll
                            for (int tn = 0; tn < 4; ++tn) acc[tn][tm] = acc[tn][tm] * rv;
                        }
                    }
                }
                if (nt >= 21 && nt < 24) {
                    float mxn = 0.f;
#pragma unroll
                    for (int tm = 0; tm < 4; ++tm) {
                        float ssq = 0.f;
#pragma unroll
                        for (int tn = 0; tn < 4; ++tn)
#pragma unroll
                            for (int i = 0; i < 4; ++i) ssq += acc[tn][tm][i] * acc[tn][tm][i];
                        ssq += __shfl_xor(ssq, 16); ssq += __shfl_xor(ssq, 32);
                        mxn = fmaxf(mxn, ssq);
                    }
#pragma unroll
                    for (int o = 1; o < 16; o <<= 1) mxn = fmaxf(mxn, __shfl_xor(mxn, o));
                    if (lane == 0) p.kn[((m0 >> 12) * 6 + (nt - 21) * 2 + wn) * 64 + (((m0 & 4095) + wm * 64) >> 6)] = sqrtf(mxn);
                }
                bf16_t* Cs = (bf16_t*)(smem + 32768);
#pragma unroll
                for (int tm = 0; tm < 4; ++tm) {
                    if (kind == 3 || kind == 4) {
                        const float sc = kind == 3 ? 0.125f : 1.f;
                        const int pos = (m0 + wm * 64 + tm * 16 + l15) & 4095;
                        const float* rp = p.rope + (size_t)pos * 64 + 8 * q4;
#pragma unroll
                        for (int tn = 0; tn < 2; ++tn) {
                            const f32x4 c0 = *(const f32x4*)(rp + 32 * tn), c1 = *(const f32x4*)(rp + 32 * tn + 4);
                            const float cs[4] = {c0.x, c0.z, c1.x, c1.z}, sn[4] = {c0.y, c0.w, c1.y, c1.w};
#pragma unroll
                            for (int u = 0; u < 4; ++u) {
                                const float x1 = acc[tn][tm][u], x2 = acc[tn + 2][tm][u];
                                acc[tn][tm][u] = (x1 * cs[u] - x2 * sn[u]) * sc;
                                acc[tn + 2][tm][u] = (x1 * sn[u] + x2 * cs[u]) * sc;
                            }
                        }
                    }
#pragma unroll
                    for (int tn = 0; tn < 4; ++tn) {
                        if (kind == 1) {
#pragma unroll
                            for (int i = 0; i < 4; ++i) acc[tn][tm][i] = gelu_tanh_f(acc[tn][tm][i]);
                        } else if (kind == 2) {
#pragma unroll
                            for (int i = 0; i < 4; ++i) acc[tn][tm][i] = silu_f(acc[tn][tm][i]);
                        } else if (kind == 5) {
#pragma unroll
                            for (int i = 0; i < 4; ++i) acc[tn][tm][i] *= 0.125f * LOG2E;
                        }
                        uint2 v; v.x = pk2(acc[tn][tm][0], acc[tn][tm][1]); v.y = pk2(acc[tn][tm][2], acc[tn][tm][3]);
                        if (isv) *(uint2*)(Cs + (wn * 64 + tm * 16 + l15) * 136 + wm * 64 + tn * 16 + 4 * q4) = v;
                        else *(uint2*)(Cs + (wm * 64 + tm * 16 + l15) * 136 + wn * 64 + tn * 16 + 4 * q4) = v;
                    }
                    __builtin_amdgcn_sched_barrier(0);
                }
                __syncthreads();
                if (isv) {
                    const int te = ltid();
#pragma unroll
                    for (int i = 0; i < 8; ++i) {
                        const int c = te + i * 256, n = c >> 4, cc = c & 15;
                        const int hd = (nt >= 24 ? nt - 24 : nt - 12) * 2 + (n >> 6), e = n & 63;
                        bf16_t* dst = (nt >= 24 ? p.vTf : p.vTr) + ((size_t)((m0 >> 12) * 6 + hd) * 64 + e) * 4096 + (m0 & 4095) + cc * 8;
                        *(uint4*)dst = *(const uint4*)&Cs[n * 136 + cc * 8];
                    }
                } else {
                    const int n0z = n0 - (nt >= 27 ? 768 : (nt >= 15 ? 384 : 0));
#pragma unroll
                    for (int i = 0; i < 8; ++i) {
                        const int c = tid + i * 256, row = c >> 4, cc = c & 15;
                        *(uint4*)(p.z + (size_t)(m0 + row) * ZLD + n0z + cc * 8) = *(const uint4*)&Cs[row * 136 + cc * 8];
                    }
                }
                __syncthreads();
            }
        }
    }
    if (MODE == 0) {
        const bf16_t* gbl = Bt + (size_t)3840 * K;
        const int wb = w & 1;
        const int goffb = (wb * 8 + (lane >> 3)) * K + (((lane & 7) ^ (((wb * 8 + (lane >> 3)) >> 1) & 7)) * 8);
#define LG_DMA(pa, st, sl) { _Pragma("unroll") for (int i_ = 0; i_ < 4; ++i_) \
        __builtin_amdgcn_global_load_lds((const unsigned*)((pa) + goff[i_] + (st) * 64), (LAS unsigned*)(lds + (sl) * 16384 + (w * 4 + i_) * 1024), 16, 0, 0); \
        __builtin_amdgcn_global_load_lds((const unsigned*)(gbl + goffb + (st) * 64), (LAS unsigned*)(lds + 65536 + (sl) * 2048 + wb * 1024), 16, 0, 0); }
        for (int mt = blockIdx.x; mt < NTOK / 128; mt += gridDim.x) {
            const int m0 = mt * 128;
            const bf16_t* gal = A + (size_t)m0 * K;
            f32x4 lacc[2] = {(f32x4){0.f, 0.f, 0.f, 0.f}, (f32x4){0.f, 0.f, 0.f, 0.f}};
            LG_DMA(gal, 0, 0) LG_DMA(gal, 1, 1) LG_DMA(gal, 2, 2)
#pragma unroll
            for (int kt = 0; kt < NKT; ++kt) {
                if (kt + 2 < NKT) asm volatile("s_waitcnt vmcnt(10)" ::: "memory"); else if (kt + 1 < NKT) asm volatile("s_waitcnt vmcnt(5)" ::: "memory"); else asm volatile("s_waitcnt vmcnt(0)" ::: "memory");
                __syncthreads();
                if (kt + 3 < NKT) LG_DMA(gal, kt + 3, (kt + 3) & 3)
                const char* as = smem + (kt & 3) * 16384 + (w * 32 + l15) * 128;
                const char* bs = smem + 65536 + (kt & 3) * 2048 + l15 * 128;
#pragma unroll
                for (int kk = 0; kk < 2; ++kk) {
                    const int co = ((4 * kk + q4) ^ fsw) * 16;
                    const bf16x8 fnl = *(const bf16x8*)(bs + co);
                    const bf16x8 fm0 = *(const bf16x8*)(as + co), fm1 = *(const bf16x8*)(as + 16 * 128 + co);
                    lacc[0] = MFMA16(fnl, fm0, lacc[0]); lacc[1] = MFMA16(fnl, fm1, lacc[1]);
                }
            }
            __syncthreads();
            if (q4 < 2) {
#pragma unroll
                for (int tm = 0; tm < 2; ++tm) {
                    const int tok = m0 + w * 32 + tm * 16 + l15, b = tok >> 12, sq = tok & 4095;
#pragma unroll
                    for (int u = 0; u < 4; ++u) {
                        const int n = 4 * q4 + u;
                        if (n < 6) p.lf[(size_t)(b * 6 + n) * 4096 + sq] = logsigmoid_f(lacc[tm][u] * (rsp ? rsp[tok] : 1.f) + p.b_f[layer * 6 + n]);
                    }
                }
            }
        }
    }
}

DI void unpack8(const uint4 v, float* f) { f[0] = lo_f(v.x); f[1] = hi_f(v.x); f[2] = lo_f(v.y); f[3] = hi_f(v.y); f[4] = lo_f(v.z); f[5] = hi_f(v.z); f[6] = lo_f(v.w); f[7] = hi_f(v.w); }

DI void abranch_item(const Params& p, int layer, int item, char* smem) {
    const int g = item & 3, nb = (item >> 2) & 31, b = item >> 7;
    const int t0 = b * 4096 + nb * 128;
    bf16_t* vnT = (bf16_t*)smem;
    const int tid = ltid(), w = tid >> 6, lane = tid & 63, r = lane & 31, h = lane >> 5;
    {
        const int tok = tid >> 1, half = tid & 1;
        const uint4* src = (const uint4*)(p.z + (size_t)(t0 + tok) * ZLD + C_AV + g * 64 + half * 32);
        float v[32];
#pragma unroll
        for (int i = 0; i < 4; ++i) unpack8(src[i], v + 8 * i);
        float s = 0.f;
#pragma unroll
        for (int i = 0; i < 32; ++i) s += v[i];
        s += __shfl_xor(s, 1);
        const float mean = s * (1.f / 64.f);
        float q = 0.f;
#pragma unroll
        for (int i = 0; i < 32; ++i) { v[i] -= mean; q += v[i] * v[i]; }
        q += __shfl_xor(q, 1);
        const float rstd = rsqrtf(q * (1.f / 64.f) + EPS);
        const float* gain = p.a_ng + layer * 256 + g * 64 + half * 32;
#pragma unroll
        for (int i = 0; i < 32; ++i) vnT[(half * 32 + i) * 136 + tok] = f2bf(v[i] * rstd * gain[i]);
    }
    __syncthreads();
    f32x16 acc[2] = {zero16(), zero16()};
    const bf16_t* wrow = p.WsA + ((size_t)(layer * 4 + g) * 128 + w * 32 + r) * 128 + h * 8;
    const int kmax = (w < 2) ? 4 : 8;
    for (int ks = 0; ks < kmax; ++ks) {
        const bf16x8 bfr = *(const bf16x8*)(wrow + ks * 16);
#pragma unroll
        for (int ct = 0; ct < 2; ++ct) {
            const bf16x8 afr = *(const bf16x8*)&vnT[(ct * 32 + r) * 136 + ks * 16 + h * 8];
            acc[ct] = MFMA32(afr, bfr, acc[ct]);
        }
    }
    const int i = w * 32 + r, tok = t0 + i;
    const float bias = p.a_sb[(layer * 4 + g) * 128 + i];
#pragma unroll
    for (int ct = 0; ct < 2; ++ct)
#pragma unroll
        for (int gq = 0; gq < 4; ++gq) {
            const int c0 = ct * 32 + 8 * gq + 4 * h;
            const uint2 u = *(const uint2*)(p.z + (size_t)tok * ZLD + C_AU + g * 64 + c0);
            const uint2 sg = *(const uint2*)(p.z + (size_t)tok * ZLD + C_AG + g * 64 + c0);
            const float o0 = lo_f(u.x) * (acc[ct][4 * gq] + bias) * lo_f(sg.x), o1 = hi_f(u.x) * (acc[ct][4 * gq + 1] + bias) * hi_f(sg.x);
            const float o2 = lo_f(u.y) * (acc[ct][4 * gq + 2] + bias) * lo_f(sg.y), o3 = hi_f(u.y) * (acc[ct][4 * gq + 3] + bias) * hi_f(sg.y);
            uint2 ov; ov.x = pk2(o0, o1); ov.y = pk2(o2, o3);
            *(uint2*)(p.y + (size_t)tok * 1024 + g * 64 + c0) = ov;
        }
    __syncthreads();
}

DI void kv_item(const Params& p, int item, char* smem) {
    const int n = item & 63, bh = item >> 6, hd = bh % 6, b = bh / 6;
    const int t0 = b * 4096 + n * 64;
    bf16_t* KT = (bf16_t*)smem;
    bf16_t* VT = KT + 64 * 72;
    const int tid = ltid(), w = tid >> 6, lane = tid & 63, r = lane & 31, h = lane >> 5;
    {
        const int j = tid >> 2, part = tid & 3;
        const uint4* ks = (const uint4*)(p.z + (size_t)(t0 + j) * ZLD + C_RK + hd * 64 + part * 16);
        const uint4* vs = (const uint4*)(p.vTr + ((size_t)bh * 64 + j) * 4096 + n * 64 + part * 16);
        float kf[16]; unpack8(ks[0], kf); unpack8(ks[1], kf + 8);
        *(uint4*)&VT[j * 72 + part * 16] = vs[0]; *(uint4*)&VT[j * 72 + part * 16 + 8] = vs[1];
        const float lg = logf(1.f - exp2f(-5.f - (float)hd));
        const float kd = expf(lg * (float)(63 - j));
#pragma unroll
        for (int q = 0; q < 16; ++q) {
            KT[(part * 16 + q) * 72 + j] = f2bf(kf[q] * kd);
        }
    }
    __syncthreads();
    const int dt = w >> 1, et = w & 1;
    f32x16 acc = zero16();
#pragma unroll
    for (int ks = 0; ks < 4; ++ks) {
        const bf16x8 a = *(const bf16x8*)&KT[(dt * 32 + r) * 72 + ks * 16 + h * 8];
        const bf16x8 bb = *(const bf16x8*)&VT[(et * 32 + r) * 72 + ks * 16 + h * 8];
        acc = MFMA32(a, bb, acc);
    }
    bf16_t* dst = (bf16_t*)p.kv + (size_t)item * 4096 + (et * 32 + r) * 64 + dt * 32 + 4 * h;
#pragma unroll
    for (int gq = 0; gq < 4; ++gq) { uint2 v; v.x = pk2(acc[4 * gq], acc[4 * gq + 1]); v.y = pk2(acc[4 * gq + 2], acc[4 * gq + 3]); *(uint2*)(dst + 8 * gq) = v; }
    __syncthreads();
}

DI void cumsum_item(const Params& p, int item, char* smem) {
    const float* src = p.lf + (size_t)item * 4096;
    float* dst = p.cf + (size_t)item * 4096;
    float* wt = (float*)smem;
    const int tid = ltid(), w = tid >> 6, lane = tid & 63;
    float v[16];
#pragma unroll
    for (int i = 0; i < 4; ++i) { const f32x4 t = ((const f32x4*)src)[tid * 4 + i]; v[4 * i] = t.x; v[4 * i + 1] = t.y; v[4 * i + 2] = t.z; v[4 * i + 3] = t.w; }
#pragma unroll
    for (int i = 1; i < 16; ++i) v[i] += v[i - 1];
    const float total = v[15];
    float x = total;
#pragma unroll
    for (int o = 1; o < 64; o <<= 1) { const float y = __shfl_up(x, o); if (lane >= o) x += y; }
    if (lane == 63) wt[w] = x;
    __syncthreads();
    float off = x - total;
    for (int i = 0; i < w; ++i) off += wt[i];
#pragma unroll
    for (int i = 0; i < 4; ++i) { f32x4 t = {v[4 * i] + off, v[4 * i + 1] + off, v[4 * i + 2] + off, v[4 * i + 3] + off}; ((f32x4*)dst)[tid * 4 + i] = t; }
    __syncthreads();
}

DI void phase2a(const Params& p, int layer, char* smem) {
    constexpr int N_CS = 48, N_KV = 3072;
    for (int it = blockIdx.x; it < N_CS + N_KV; it += gridDim.x) {
        if (it < N_CS) cumsum_item(p, it, smem);
        else kv_item(p, it - N_CS, smem);
    }
}

DI void ret_item(const Params& p, int item, char* smem) {
    const int seg = item & 7, bh = item >> 3, hd = bh % 6, b = bh / 6;
    bf16_t* Qs = (bf16_t*)smem;
    bf16_t* Qds = Qs + 64 * 72;
    bf16_t* Ks = Qds + 64 * 72;
    bf16_t* VT = Ks + 64 * 72;
    bf16_t* ST = VT + 64 * 72;
    bf16_t* Ps = ST + 64 * 72;
    float* red = (float*)(Ps + 64 * 72);
    const int tid = ltid(), w = tid >> 6, lane = tid & 63, r = lane & 31, h = lane >> 5;
    const float lg = logf(1.f - exp2f(-5.f - (float)hd));
    const float cd = expf(lg * 64.f);
    const int e_own = tid >> 2, dpart = tid & 3;
    float st[16];
#pragma unroll
    for (int q = 0; q < 16; ++q) st[q] = 0.f;
    const bf16_t* kvb = (const bf16_t*)p.kv + (size_t)bh * 64 * 4096 + e_own * 64 + dpart * 16;
#pragma unroll 8
    for (int m = 0; m < seg * 8; ++m) {
        const uint4* s4 = (const uint4*)(kvb + (size_t)m * 4096);
        float t[16]; unpack8(s4[0], t); unpack8(s4[1], t + 8);
#pragma unroll
        for (int i = 0; i < 16; ++i) st[i] = st[i] * cd + t[i];
    }
    const int lj = tid >> 2, lpart = tid & 3;
    const bf16_t* zr0 = p.z + (size_t)(b * 4096 + seg * 512 + lj) * ZLD + hd * 64 + lpart * 16;
    const bf16_t* vs0 = p.vTr + ((size_t)bh * 64 + lj) * 4096 + seg * 512 + lpart * 16;
    const bf16_t* kvs = kvb + (size_t)(seg * 8) * 4096;
    uint4 pq0 = *(const uint4*)(zr0 + C_RQ), pq1 = *(const uint4*)(zr0 + C_RQ + 8), pk0 = *(const uint4*)(zr0 + C_RK), pk1 = *(const uint4*)(zr0 + C_RK + 8);
    uint4 pv0 = *(const uint4*)vs0, pv1 = *(const uint4*)(vs0 + 8);
    uint4 pkv0 = ((const uint4*)kvs)[0], pkv1 = ((const uint4*)kvs)[1];
    const float qd_c = expf(lg * (float)(lj + 1));
    float dec[16];
    {
        const int i_ = (w & 1) * 32 + r, jt_ = w >> 1;
#pragma unroll
        for (int q = 0; q < 16; ++q) { const int dd = i_ - (jt_ * 32 + crow(q, h)); dec[q] = expf(lg * (float)(dd < 0 ? -dd : dd)); }
    }
    for (int c = 0; c < 8; ++c) {
        const int n = seg * 8 + c, t0 = b * 4096 + n * 64;
        uint2 sgr[4];
        {
            uint4 s0, s1;
            s0.x = pk2(st[0], st[1]); s0.y = pk2(st[2], st[3]); s0.z = pk2(st[4], st[5]); s0.w = pk2(st[6], st[7]);
            s1.x = pk2(st[8], st[9]); s1.y = pk2(st[10], st[11]); s1.z = pk2(st[12], st[13]); s1.w = pk2(st[14], st[15]);
            *(uint4*)&ST[e_own * 72 + dpart * 16] = s0; *(uint4*)&ST[e_own * 72 + dpart * 16 + 8] = s1;
            const int j = lj, part = lpart;
            const uint4 q0 = pq0, q1 = pq1, k0 = pk0, k1 = pk1, v0 = pv0, v1 = pv1;
            *(uint4*)&Qs[j * 72 + part * 16] = q0; *(uint4*)&Qs[j * 72 + part * 16 + 8] = q1;
            *(uint4*)&Ks[j * 72 + part * 16] = k0; *(uint4*)&Ks[j * 72 + part * 16 + 8] = k1;
            const float qd = qd_c;
            float qf[16]; unpack8(q0, qf); unpack8(q1, qf + 8);
            uint4 d0, d1;
            d0.x = pk2(qf[0] * qd, qf[1] * qd); d0.y = pk2(qf[2] * qd, qf[3] * qd); d0.z = pk2(qf[4] * qd, qf[5] * qd); d0.w = pk2(qf[6] * qd, qf[7] * qd);
            d1.x = pk2(qf[8] * qd, qf[9] * qd); d1.y = pk2(qf[10] * qd, qf[11] * qd); d1.z = pk2(qf[12] * qd, qf[13] * qd); d1.w = pk2(qf[14] * qd, qf[15] * qd);
            *(uint4*)&Qds[j * 72 + part * 16] = d0; *(uint4*)&Qds[j * 72 + part * 16 + 8] = d1;
            *(uint4*)&VT[j * 72 + part * 16] = v0; *(uint4*)&VT[j * 72 + part * 16 + 8] = v1;
            if (c + 1 < 8) {
                const bf16_t* zr = zr0 + (size_t)(c + 1) * 64 * ZLD;
                pq0 = *(const uint4*)(zr + C_RQ); pq1 = *(const uint4*)(zr + C_RQ + 8); pk0 = *(const uint4*)(zr + C_RK); pk1 = *(const uint4*)(zr + C_RK + 8);
                pv0 = *(const uint4*)(vs0 + (c + 1) * 64); pv1 = *(const uint4*)(vs0 + (c + 1) * 64 + 8);
            }
            {
                const int i_ = (w & 1) * 32 + r, et_ = w >> 1;
                const bf16_t* gsrc = p.z + (size_t)(t0 + i_) * ZLD + C_RG + hd * 64 + et_ * 32 + 4 * h;
#pragma unroll
                for (int gq = 0; gq < 4; ++gq) sgr[gq] = *(const uint2*)(gsrc + 8 * gq);
            }
            __builtin_amdgcn_sched_barrier(0);
        }
        __syncthreads();
        {
            const int it = w & 1, jt = w >> 1;
            f32x16 acc = zero16();
#pragma unroll
            for (int ks = 0; ks < 4; ++ks) {
                const bf16x8 a = *(const bf16x8*)&Ks[(jt * 32 + r) * 72 + ks * 16 + h * 8];
                const bf16x8 bb = *(const bf16x8*)&Qs[(it * 32 + r) * 72 + ks * 16 + h * 8];
                acc = MFMA32(a, bb, acc);
            }
            const int i = it * 32 + r;
#pragma unroll
            for (int gq = 0; gq < 4; ++gq) {
                const int j0 = jt * 32 + 8 * gq + 4 * h;
                float pv[4];
#pragma unroll
                for (int u = 0; u < 4; ++u) pv[u] = acc[4 * gq + u] * dec[4 * gq + u];
                uint2 o; o.x = pk2(pv[0], pv[1]); o.y = pk2(pv[2], pv[3]);
                *(uint2*)&Ps[i * 72 + j0] = o;
            }
        }
        __syncthreads();
        const int it = w & 1, et = w >> 1;
        f32x16 acc = zero16();
#pragma unroll
        for (int ks = 0; ks < 4; ++ks) {
            const bf16x8 a = *(const bf16x8*)&VT[(et * 32 + r) * 72 + ks * 16 + h * 8];
            const bf16x8 bb = *(const bf16x8*)&Ps[(it * 32 + r) * 72 + ks * 16 + h * 8];
            acc = MFMA32(a, bb, acc);
        }
#pragma unroll
        for (int ks = 0; ks < 4; ++ks) {
            const bf16x8 a = *(const bf16x8*)&ST[(et * 32 + r) * 72 + ks * 16 + h * 8];
            const bf16x8 bb = *(const bf16x8*)&Qds[(it * 32 + r) * 72 + ks * 16 + h * 8];
            acc = MFMA32(a, bb, acc);
        }
        float s1 = 0.f, s2 = 0.f;
#pragma unroll
        for (int q = 0; q < 16; ++q) { s1 += acc[q]; s2 += acc[q] * acc[q]; }
        s1 += __shfl_xor(s1, 32); s2 += __shfl_xor(s2, 32);
        const int i = it * 32 + r;
        if (h == 0) { red[(et * 64 + i) * 2] = s1; red[(et * 64 + i) * 2 + 1] = s2; }
        __syncthreads();
        {
            const float t1 = red[i * 2] + red[(64 + i) * 2], t2 = red[i * 2 + 1] + red[(64 + i) * 2 + 1];
            const float mean = t1 * (1.f / 64.f);
            const float var = fmaxf(t2 * (1.f / 64.f) - mean * mean, 0.f);
            const float rstd = rsqrtf(var + EPS);
            const int tok = t0 + i;
#pragma unroll
            for (int gq = 0; gq < 4; ++gq) {
                const int e0 = et * 32 + 8 * gq + 4 * h;
                const uint2 sg = sgr[gq];
                uint2 o;
                o.x = pk2((acc[4 * gq] - mean) * rstd * lo_f(sg.x), (acc[4 * gq + 1] - mean) * rstd * hi_f(sg.x));
                o.y = pk2((acc[4 * gq + 2] - mean) * rstd * lo_f(sg.y), (acc[4 * gq + 3] - mean) * rstd * hi_f(sg.y));
                *(uint2*)(p.y + (size_t)tok * 1024 + 256 + hd * 64 + e0) = o;
            }
        }
        {
            float t[16]; unpack8(pkv0, t); unpack8(pkv1, t + 8);
#pragma unroll
            for (int i2 = 0; i2 < 16; ++i2) st[i2] = st[i2] * cd + t[i2];
            if (c + 1 < 8) { const uint4* s4 = (const uint4*)(kvs + (size_t)(c + 1) * 4096); pkv0 = s4[0]; pkv1 = s4[1]; }
            __builtin_amdgcn_sched_barrier(0);
        }
    }
    __syncthreads();
}

DI void attn_item(const Params& p, int item, char* smem) {
    const int qb = 15 - item / 48, bh = item % 48, hd = bh % 6, b = bh / 6;
    float* Fall = (float*)smem;
    LAS unsigned char* lds = (LAS unsigned char*)smem;
    const int tid = ltid(), w = tid >> 6, lane = tid & 63, r = lane & 31, h = lane >> 5;
    const int q0w = qb * 256 + w * 64;
    const float* cfb = p.cf + (size_t)bh * 4096;
    const int nkt = 4 * qb + 4;
    const bf16_t* kbase = p.z + (size_t)b * 4096 * ZLD + C_FK + hd * 64;
    const bf16_t* vbase = p.vTf + (size_t)bh * 64 * 4096;
#define ATT_DMA(kt_, s_) { const int ln_ = ltid() & 63; _Pragma("unroll") for (int i_ = 0; i_ < 2; ++i_) { \
        const int R_ = (w * 2 + i_) * 8 + (ln_ >> 3), c_ = ((ln_ & 7) ^ ((R_ >> 1) & 7)) * 8;     \
        __builtin_amdgcn_global_load_lds((const unsigned*)(kbase + (size_t)(kt_) * 64 * ZLD + R_ * ZLD + c_), (LAS unsigned*)(lds + 16384 + (s_) * 16384 + (w * 2 + i_) * 1024), 16, 0, 0); \
        __builtin_amdgcn_global_load_lds((const unsigned*)(vbase + (kt_) * 64 + R_ * 4096 + c_), (LAS unsigned*)(lds + 16384 + (s_) * 16384 + 8192 + (w * 2 + i_) * 1024), 16, 0, 0); } }
    __syncthreads();
    ATT_DMA(nkt - 1, (nkt - 1) % 3)
    ATT_DMA(nkt - 2, (nkt - 2) % 3)
#pragma unroll
    for (int i = 0; i < 4; ++i) {
        const int i4 = tid + i * NTHREADS;
        if (i4 * 4 < nkt * 64) { const f32x4 c = ((const f32x4*)cfb)[i4]; ((f32x4*)Fall)[i4] = c * LOG2E; }
    }
    bf16x8 qf[2][4];
    float* own = (float*)(smem + 66560) + tid * 4;
#pragma unroll
    for (int rg = 0; rg < 2; ++rg) {
        const size_t tq = (size_t)b * 4096 + q0w + rg * 32 + r;
#pragma unroll
        for (int ks = 0; ks < 4; ++ks) qf[rg][ks] = *(const bf16x8*)(p.z + tq * ZLD + C_FQ + hd * 64 + ks * 16 + h * 8);
        own[rg] = cfb[q0w + rg * 32 + r] * LOG2E;
    }
    float* knp = (float*)(smem + 65536);
    int* flg = (int*)(smem + 65536 + 256);
    if (w == 0) {
        float kv = (lane < nkt) ? p.kn[bh * 64 + lane] : 0.f;
#pragma unroll
        for (int o = 1; o < 64; o <<= 1) { const float y = __shfl_up(kv, o); if (lane >= o) kv = fmaxf(kv, y); }
        knp[lane] = kv * 1.02f;
    }
#pragma unroll
    for (int rg = 0; rg < 2; ++rg) {
        float ssq = 0.f;
#pragma unroll
        for (int ks = 0; ks < 4; ++ks)
#pragma unroll
            for (int j = 0; j < 8; ++j) { const float qv = bf2f((unsigned)(unsigned short)qf[rg][ks][j]); ssq += qv * qv; }
        ssq += __shfl_xor(ssq, 32);
        own[2 + rg] = sqrtf(ssq);
    }
    f32x16 O[2][2] = {{zero16(), zero16()}, {zero16(), zero16()}};
    float m[2] = {-INFINITY, -INFINITY}, l[2] = {0.f, 0.f};
    const int fsw = (r >> 1) & 7;
    for (int kt = nkt - 1; kt >= 0; --kt) {
        bool wdone = false;
        if (kt < nkt - 1) {
            const float fl_ = Fall[kt * 64 + 63], kp = knp[kt];
            const f32x4 ow = *(const f32x4*)own;
            const bool ok = (ow.z * kp + ow.x - fl_ < m[0] - SKIP_T) && (ow.w * kp + ow.y - fl_ < m[1] - SKIP_T);
            wdone = (__ballot(!ok) == 0ull);
        }
        if (lane == 0) flg[(kt & 3) * 4 + w] = wdone ? 1 : 0;
        if (kt > 0) asm volatile("s_waitcnt vmcnt(4)" ::: "memory"); else asm volatile("s_waitcnt vmcnt(0)" ::: "memory");
        __syncthreads();
        {
            const int4 fl = *(const int4*)&flg[(kt & 3) * 4];
            if (fl.x & fl.y & fl.z & fl.w) break;
        }
        if (kt >= 2) ATT_DMA(kt - 2, (kt - 2) % 3)
        const int kmin = kt * 64;
        if (!wdone && kmin <= q0w + 63) {
            const char* Kt = smem + 16384 + (kt % 3) * 16384;
            const char* Vt = Kt + 8192;
#pragma unroll
            for (int jt = 1; jt >= 0; --jt) {
                if (kmin + jt * 32 > q0w + 63) continue;
                bf16x8 kf[4];
#pragma unroll
                for (int ks = 0; ks < 4; ++ks) kf[ks] = *(const bf16x8*)(Kt + (jt * 32 + r) * 128 + (((2 * ks + h) ^ fsw) * 16));
#pragma unroll
                for (int rg = 0; rg < 2; ++rg) {
                    const int q0 = q0w + rg * 32, qrow = q0 + r;
                    if (kmin + jt * 32 > q0 + 31) continue;
                    const float Fi_rg = own[rg];
                    {
                        {
                        f32x16 S;
#pragma unroll
                        for (int gq = 0; gq < 4; ++gq) {
                            const f32x4 fk = *(const f32x4*)&Fall[kmin + jt * 32 + 8 * gq + 4 * h];
                            S[4 * gq] = Fi_rg - fk.x; S[4 * gq + 1] = Fi_rg - fk.y; S[4 * gq + 2] = Fi_rg - fk.z; S[4 * gq + 3] = Fi_rg - fk.w;
                        }
#pragma unroll
                        for (int ks = 0; ks < 4; ++ks) {
                            S = MFMA32(kf[ks], qf[rg][ks], S);
                        }
                        if (kmin + jt * 32 + 31 > q0) {
#pragma unroll
                            for (int q = 0; q < 16; ++q) { const int key = kmin + jt * 32 + crow(q, h); if (key > qrow) S[q] = -INFINITY; }
                        }
                        float mx = S[0];
#pragma unroll
                        for (int q = 1; q < 16; ++q) mx = fmaxf(mx, S[q]);
                        mx = fmaxf(mx, __shfl_xor(mx, 32));
                        if (__ballot(mx > m[rg] - SKIP_T) != 0ull) {
                            const float mnew = fmaxf(m[rg], mx);
                            const float alpha = __builtin_amdgcn_exp2f(m[rg] - mnew);
                            m[rg] = mnew;
                            float ls = 0.f;
#pragma unroll
                            for (int q = 0; q < 16; ++q) { const float pv = __builtin_amdgcn_exp2f(S[q] - mnew); S[q] = pv; ls += pv; }
                            l[rg] = l[rg] * alpha + ls;
                            if (__ballot(alpha != 1.f) != 0ull) {
#pragma unroll
                                for (int et = 0; et < 2; ++et)
#pragma unroll
                                    for (int q = 0; q < 16; ++q) O[rg][et][q] *= alpha;
                            }
#pragma unroll
                            for (int s2 = 0; s2 < 2; ++s2) {
                                uint4 pw;
                                pw.x = pk2(S[8 * s2], S[8 * s2 + 1]); pw.y = pk2(S[8 * s2 + 2], S[8 * s2 + 3]);
                                pw.z = pk2(S[8 * s2 + 4], S[8 * s2 + 5]); pw.w = pk2(S[8 * s2 + 6], S[8 * s2 + 7]);
                                const bf16x8 pf = __builtin_bit_cast(bf16x8, pw);
#pragma unroll
                                for (int et = 0; et < 2; ++et) {
                                    const char* vrow = Vt + (et * 32 + r) * 128 + 8 * h;
                                    const s16x4 lo = *(const s16x4*)(vrow + (((4 * jt + 2 * s2) ^ fsw) * 16)), hi = *(const s16x4*)(vrow + (((4 * jt + 2 * s2 + 1) ^ fsw) * 16));
                                    const bf16x8 vf = __builtin_shufflevector(lo, hi, 0, 1, 2, 3, 4, 5, 6, 7);
                                    O[rg][et] = MFMA32(vf, pf, O[rg][et]);
                                }
                            }
                        }
                    }
                    }
                }
            }
        }
    }
    asm volatile("s_waitcnt vmcnt(0)" ::: "memory");
#pragma unroll
    for (int rg = 0; rg < 2; ++rg) {
        const size_t tokq = (size_t)b * 4096 + q0w + rg * 32 + r;
        float lt = l[rg];
        lt += __shfl_xor(lt, 32);
        const float inv = 1.f / lt;
#pragma unroll
        for (int et = 0; et < 2; ++et)
#pragma unroll
            for (int gq = 0; gq < 4; ++gq) {
                const int e0 = et * 32 + 8 * gq + 4 * h;
                const uint2 sg = *(const uint2*)(p.z + tokq * ZLD + C_FG + hd * 64 + e0);
                uint2 o;
                o.x = pk2(O[rg][et][4 * gq] * inv * lo_f(sg.x), O[rg][et][4 * gq + 1] * inv * hi_f(sg.x));
                o.y = pk2(O[rg][et][4 * gq + 2] * inv * lo_f(sg.y), O[rg][et][4 * gq + 3] * inv * hi_f(sg.y));
                *(uint2*)(p.y + tokq * 1024 + 640 + hd * 64 + e0) = o;
            }
    }
}

DI void phase2b(const Params& p, int layer, char* smem, int cidx) {
    constexpr int N_ATT = 768, N_RET = 384, N_A = 1024;
    const int n_w = (layer == 0) ? I_IN + I_OUT : 0;
    int* s_item = (int*)(smem + LDS_MAIN + 16);
    for (;;) {
        if (threadIdx.x == 0) *s_item = (int)atomicAdd(p.ctr + cidx, 1u);
        __syncthreads();
        const int it = *s_item;
        __syncthreads();
        if (it >= N_RET + N_ATT + N_A + n_w) break;
        if (it < N_RET) ret_item(p, it, smem);
        else if (it < N_RET + N_ATT) attn_item(p, it - N_RET, smem);
        else if (it < N_RET + N_ATT + N_A) abranch_item(p, layer, it - N_RET - N_ATT, smem);
        else wt_item(p, 1, it - N_RET - N_ATT - N_A, (float*)smem);
        __syncthreads();
    }
}

DI void phase4(const Params& p, int layer, char* smem) {
    const int tid = ltid(), wv = tid >> 6, lane = tid & 63;
    const f32x4* pg = (const f32x4*)(p.post_g + layer * 1024);
    for (int row = (blockIdx.x * 4 + wv) * 2; row < NTOK; row += gridDim.x * 8) {
        f32x4 v[2][4], xv[2][4]; float ss[2] = {0.f, 0.f};
#pragma unroll
        for (int q = 0; q < 2; ++q)
#pragma unroll
            for (int j = 0; j < 2; ++j) { const uint4 ow = ((const uint4*)(p.o + (size_t)(row + q) * 1024))[lane + 64 * j]; v[q][2 * j] = (f32x4){lo_f(ow.x), hi_f(ow.x), lo_f(ow.y), hi_f(ow.y)}; v[q][2 * j + 1] = (f32x4){lo_f(ow.z), hi_f(ow.z), lo_f(ow.w), hi_f(ow.w)};
                if (layer == 0) { xv[q][2 * j] = ((const f32x4*)(p.x + (size_t)(row + q) * 1024))[IDX4(2 * j)]; xv[q][2 * j + 1] = ((const f32x4*)(p.x + (size_t)(row + q) * 1024))[IDX4(2 * j + 1)]; }
                else { const uint4 xw = ((const uint4*)(p.x1b + (size_t)(row + q) * 1024))[lane + 64 * j]; xv[q][2 * j] = (f32x4){lo_f(xw.x), hi_f(xw.x), lo_f(xw.y), hi_f(xw.y)}; xv[q][2 * j + 1] = (f32x4){lo_f(xw.z), hi_f(xw.z), lo_f(xw.w), hi_f(xw.w)}; } }
#pragma unroll
        for (int q = 0; q < 2; ++q)
#pragma unroll
            for (int j = 0; j < 4; ++j) ss[q] += (v[q][j].x * v[q][j].x + v[q][j].y * v[q][j].y) + (v[q][j].z * v[q][j].z + v[q][j].w * v[q][j].w);
#pragma unroll
        for (int o = 1; o < 64; o <<= 1) { ss[0] += __shfl_xor(ss[0], o); ss[1] += __shfl_xor(ss[1], o); }
        float s2[2] = {0.f, 0.f};
#pragma unroll
        for (int q = 0; q < 2; ++q) {
            const float rstd = rsqrtf(ss[q] * (1.f / 1024.f) + EPS);
#pragma unroll
            for (int j = 0; j < 4; ++j) {
                const f32x4 g = pg[IDX4(j)];
                v[q][j] = xv[q][j] + v[q][j] * rstd * g;
                if (layer != 0) ((f32x4*)(p.out + (size_t)(row + q) * 1024))[IDX4(j)] = v[q][j];
                s2[q] += (v[q][j].x * v[q][j].x + v[q][j].y * v[q][j].y) + (v[q][j].z * v[q][j].z + v[q][j].w * v[q][j].w);
            }
        }
        if (layer == 0) {
#pragma unroll
            for (int o = 1; o < 64; o <<= 1) { s2[0] += __shfl_xor(s2[0], o); s2[1] += __shfl_xor(s2[1], o); }
#pragma unroll
            for (int q = 0; q < 2; ++q) {
                if (lane == 0) p.rs[row + q] = rsqrtf(s2[q] * (1.f / 1024.f) + EPS);
#pragma unroll
                for (int j = 0; j < 2; ++j) {
                    const f32x4 va = v[q][2 * j], vb = v[q][2 * j + 1];
                    uint4 xw; xw.x = pk2(va.x, va.y); xw.y = pk2(va.z, va.w); xw.z = pk2(vb.x, vb.y); xw.w = pk2(vb.z, vb.w);
                    ((uint4*)(p.x1b + (size_t)(row + q) * 1024))[lane + 64 * j] = xw;
                }
            }
        }
    }
}

template <int PH>
__global__ void __launch_bounds__(NTHREADS, 2) __attribute__((amdgpu_waves_per_eu(2, 2))) k_phase(Params p, int layer) {
    extern __shared__ __attribute__((aligned(16))) char smem[];
    if (PH == 0) phase0(p, smem);
    else if (PH == 1) gemm_phase<0>(p, layer, smem);
    else if (PH == 2) phase2a(p, layer, smem);
    else if (PH == 3) phase2b(p, layer, smem, layer);
    else if (PH == 4) gemm_phase<1>(p, layer, smem);
    else phase4(p, layer, smem);
}

#if MEGA
__global__ void __launch_bounds__(NTHREADS, 2) __attribute__((amdgpu_waves_per_eu(2, 2))) k_mega(Params p) {
    extern __shared__ __attribute__((aligned(16))) char smem[];
    cg::grid_group grid = cg::this_grid();
    volatile LAS unsigned* st = (volatile LAS unsigned*)(smem + LDS_MAIN);
    if (threadIdx.x < 2) st[threadIdx.x] = 0u;
    __syncthreads();
    (void)xcd_barrier_post(p.bar, st);
#define XBAR() { XcdBarrier xb_; xb_.bar = p.bar; xb_.x = xb_xcc_id(); xb_.st = (volatile LAS unsigned*)(smem + LDS_MAIN); xcd_barrier(xb_); }
    phase0(p, smem);
    if (p.never) grid.sync();
    XBAR();
    if (PROBE_PH == 10) { for (int i = 0; i < 10; ++i) XBAR(); }
#pragma nounroll
    for (int layer = 0; layer < 2; ++layer) {
        gemm_phase<0>(p, layer, smem);
        XBAR();
        if ((PROBE_PH == 1 && layer == 0) || (PROBE_PH == 11 && layer == 1)) { gemm_phase<0>(p, layer, smem); XBAR(); }
        phase2a(p, layer, smem);
        XBAR();
        if (PROBE_PH == 2 && layer == 0) { phase2a(p, layer, smem); XBAR(); }
        phase2b(p, layer, smem, layer);
        XBAR();
        if (PROBE_PH == 3 && layer == 0) { phase2b(p, layer, smem, 2); XBAR(); }
        gemm_phase<1>(p, layer, smem);
        XBAR();
        if (PROBE_PH == 4 && layer == 0) { gemm_phase<1>(p, layer, smem); XBAR(); }
        phase4(p, layer, smem);
        if (PROBE_PH == 5 && layer == 0) { XBAR(); phase4(p, layer, smem); }
        if (layer == 0) XBAR();
    }
}
#endif

extern "C" void kernel_launch(void* const* d_in, const int* in_sizes, int n_in, void* d_out, int out_size, void* d_ws, size_t ws_size, hipStream_t stream) {
    static int grid_blocks = 0;
    if (grid_blocks == 0) {
        if (ws_size < WS_END) { fprintf(stderr, "kernel_launch: workspace too small: %zu < %zu\n", ws_size, (size_t)WS_END); grid_blocks = -1; return; }
        int dev = 0, cus = 0, per_cu = 0;
        hipGetDevice(&dev);
        hipDeviceGetAttribute(&cus, hipDeviceAttributeMultiprocessorCount, dev);
#if MEGA
        hipFuncSetAttribute((const void*)k_mega, hipFuncAttributeMaxDynamicSharedMemorySize, LDS_BYTES);
        hipOccupancyMaxActiveBlocksPerMultiprocessor(&per_cu, (const void*)k_mega, NTHREADS, LDS_BYTES);
#else
        hipFuncSetAttribute((const void*)k_phase<0>, hipFuncAttributeMaxDynamicSharedMemorySize, LDS_BYTES);
        hipFuncSetAttribute((const void*)k_phase<1>, hipFuncAttributeMaxDynamicSharedMemorySize, LDS_BYTES);
        hipFuncSetAttribute((const void*)k_phase<2>, hipFuncAttributeMaxDynamicSharedMemorySize, LDS_BYTES);
        hipFuncSetAttribute((const void*)k_phase<3>, hipFuncAttributeMaxDynamicSharedMemorySize, LDS_BYTES);
        hipFuncSetAttribute((const void*)k_phase<4>, hipFuncAttributeMaxDynamicSharedMemorySize, LDS_BYTES);
        hipFuncSetAttribute((const void*)k_phase<5>, hipFuncAttributeMaxDynamicSharedMemorySize, LDS_BYTES);
        per_cu = 2;
#endif
        if (per_cu < 1) per_cu = 1;
        if (per_cu > 2) per_cu = 2;
        grid_blocks = cus * per_cu;
    }
    if (grid_blocks < 0) return;
    Params p{};
    p.x = (const float*)d_in[0]; p.pre_g = (const float*)d_in[1]; p.post_g = (const float*)d_in[2]; p.w_in = (const float*)d_in[3];
    p.b_f = (const float*)d_in[4]; p.a_ng = (const float*)d_in[5]; p.a_sw = (const float*)d_in[6]; p.a_sb = (const float*)d_in[7]; p.w_out = (const float*)d_in[8];
    p.out = (float*)d_out;
    char* ws = (char*)d_ws;
    p.ctr = (unsigned*)(ws + WS_CTR);
    p.bar = (unsigned*)(ws + WS_BAR);
    p.WinT = (bf16_t*)(ws + WS_WINT); p.WoutT = (bf16_t*)(ws + WS_WOUTT); p.WsA = (bf16_t*)(ws + WS_WSA);
    p.rope = (float*)(ws + WS_ROPE); p.lf = (float*)(ws + WS_LF); p.cf = (float*)(ws + WS_CF);
    p.vTf = (bf16_t*)(ws + WS_VTF); p.vTr = (bf16_t*)(ws + WS_VTR);
    p.hb = (bf16_t*)(ws + WS_HB); p.y = (bf16_t*)(ws + WS_Y); p.kv = (float*)(ws + WS_KV);
    p.z = (bf16_t*)(ws + WS_Z); p.kn = (float*)(ws + WS_KN); p.rs = (float*)(ws + WS_RS); p.x1b = (bf16_t*)(ws + WS_X1B); p.o = (bf16_t*)(ws + WS_HB);
#if MEGA
    hipMemsetAsync(ws + WS_BAR, 0, XCD_BAR_WORDS * 4, stream);
    void* args[] = {&p};
    hipError_t e = hipLaunchCooperativeKernel((void*)k_mega, dim3(grid_blocks), dim3(NTHREADS), args, LDS_BYTES, stream);
    if (e != hipSuccess) fprintf(stderr, "cooperative launch failed: %s (grid %d)\n", hipGetErrorString(e), grid_blocks);
#else
    const dim3 g(grid_blocks), bl(NTHREADS);
    hipLaunchKernelGGL(k_phase<0>, g, bl, LDS_BYTES, stream, p, 0);
    for (int layer = 0; layer < 2; ++layer) {
        hipLaunchKernelGGL(k_phase<1>, g, bl, LDS_BYTES, stream, p, layer);
        hipLaunchKernelGGL(k_phase<2>, g, bl, LDS_BYTES, stream, p, layer);
        hipLaunchKernelGGL(k_phase<3>, g, bl, LDS_BYTES, stream, p, layer);
        hipLaunchKernelGGL(k_phase<4>, g, bl, LDS_BYTES, stream, p, layer);
        hipLaunchKernelGGL(k_phase<5>, g, bl, LDS_BYTES, stream, p, layer);
    }
#endif
}
```

```cpp
#include <hip/hip_runtime.h>
#include <hip/hip_cooperative_groups.h>
#include <cstdint>
#include <cstdio>
namespace cg = cooperative_groups;

#ifndef PROBE_PH
#define PROBE_PH -1
#endif
#ifndef MEGA
#define MEGA 1
#endif

#define DI __device__ __forceinline__
typedef unsigned short bf16_t;
typedef short bf16x8 __attribute__((ext_vector_type(8)));
typedef short s16x4 __attribute__((ext_vector_type(4)));
typedef float f32x4 __attribute__((ext_vector_type(4)));
typedef float f32x16 __attribute__((ext_vector_type(16)));

constexpr int NB = 8, SEQ = 4096, DM = 1024, NTOK = NB * SEQ, DIN = 3846, ZLD = 3072, NPAD = 3968;
constexpr int NTHREADS = 256;
constexpr float EPS = 1e-6f;
constexpr float LOG2E = 1.4426950408889634f;
constexpr float SKIP_T = 40.f;
constexpr int C_AU = 0, C_AV = 256, C_AG = 512, C_RQ = 768, C_RK = 1152, C_RG = 1536, C_FQ = 1920, C_FK = 2304, C_FG = 2688;
constexpr int LDS_MAIN = 2 * 2 * 128 * 72 * 2;
constexpr int LDS_BYTES = LDS_MAIN + 64;

struct Params {
    const float *x, *pre_g, *post_g, *w_in, *b_f, *a_ng, *a_sw, *a_sb, *w_out;
    float* out;
    bf16_t *WinT, *WoutT, *WsA, *hb, *z, *y, *vTf, *vTr, *x1b;
    bf16_t* o;
    float *kv, *lf, *cf, *rope, *kn, *rs;
    unsigned* ctr;
    unsigned* bar;
    int never;
    int pad0;
};

constexpr size_t WS_CTR = 0;
constexpr size_t WS_BAR = 256;
constexpr size_t WS_WINT = 256 + 16384;
constexpr size_t WS_WOUTT = WS_WINT + (size_t)2 * NPAD * 1024 * 2;
constexpr size_t WS_WSA = WS_WOUTT + (size_t)2 * 1024 * 1024 * 2;
constexpr size_t WS_ROPE = WS_WSA + (size_t)2 * 4 * 128 * 128 * 2;
constexpr size_t WS_LF = WS_ROPE + (size_t)4096 * 32 * 2 * 4;
constexpr size_t WS_CF = WS_LF + (size_t)48 * 4096 * 4;
constexpr size_t WS_VTF = WS_CF + (size_t)48 * 4096 * 4;
constexpr size_t WS_VTR = WS_VTF + (size_t)48 * 64 * 4096 * 2;
constexpr size_t WS_HB = WS_VTR + (size_t)48 * 64 * 4096 * 2;
constexpr size_t WS_Y = WS_HB + (size_t)NTOK * 1024 * 2;
constexpr size_t WS_KV = WS_Y + (size_t)NTOK * 1024 * 2;
constexpr size_t WS_Z = WS_KV + (size_t)3072 * 4096 * 4;
constexpr size_t WS_X1B = WS_Z + (size_t)NTOK * ZLD * 2;
constexpr size_t WS_KN = WS_X1B + (size_t)NTOK * 1024 * 2;
constexpr size_t WS_RS = WS_KN + 16384;
constexpr size_t WS_END = WS_RS + (size_t)NTOK * 4;

DI int ltid() { int t = threadIdx.x; asm volatile("" : "+v"(t)); return t; }
DI float bf2f(unsigned v) { return __uint_as_float(v << 16); }
typedef __bf16 bf16v2_t __attribute__((ext_vector_type(2)));
typedef float f32x2_t __attribute__((ext_vector_type(2)));
DI unsigned pk2(float lo, float hi) { const f32x2_t v = {lo, hi}; return __builtin_bit_cast(unsigned, __builtin_convertvector(v, bf16v2_t)); }
DI bf16_t f2bf(float x) { return (bf16_t)(pk2(x, 0.f) & 0xffffu); }
DI float lo_f(unsigned w) { return __uint_as_float(w << 16); }
DI float hi_f(unsigned w) { return __uint_as_float(w & 0xffff0000u); }
DI int crow(int reg, int h) { return (reg & 3) + 8 * (reg >> 2) + 4 * h; }
#define IDX4(jj) ((lane + 64 * ((jj) >> 1)) * 2 + ((jj) & 1))
DI float wave_sum(float v) {
#pragma unroll
    for (int o = 1; o < 64; o <<= 1) v += __shfl_xor(v, o);
    return v;
}
DI float silu_f(float x) { return x * __builtin_amdgcn_rcpf(1.f + __builtin_amdgcn_exp2f(-LOG2E * x)); }
DI float gelu_tanh_f(float x) { const float u = (-2.f * LOG2E * 0.7978845608028654f) * (x + 0.044715f * x * x * x); return x * __builtin_amdgcn_rcpf(1.f + __builtin_amdgcn_exp2f(u)); }
DI float logsigmoid_f(float x) { return fminf(x, 0.f) - log1pf(__expf(-fabsf(x))); }
#define MFMA32(a, b, c) __builtin_amdgcn_mfma_f32_32x32x16_bf16((a), (b), (c), 0, 0, 0)
#define MFMA16(a, b, c) __builtin_amdgcn_mfma_f32_16x16x32_bf16((a), (b), (c), 0, 0, 0)
DI f32x16 zero16() { f32x16 z; for (int i = 0; i < 16; ++i) z[i] = 0.f; return z; }

#define XB_TMO      128
#define XB_XCNT(j)  (256  + 64 * (j))
#define XB_XSUB(j)  (1280 + 64 * (j))
#define XB_XGEN(j)  (2304 + 64 * (j))
#define XB_TOP      3328
#define XB_TOPGEN   3392
#define XCD_BAR_WORDS 3456
#define XB_SPIN_CAP (1u << 18)
#define LAS __attribute__((address_space(3)))

__device__ __forceinline__ unsigned xb_ld(unsigned* p)              { return __hip_atomic_load(p, __ATOMIC_RELAXED, __HIP_MEMORY_SCOPE_AGENT); }
__device__ __forceinline__ unsigned xb_add(unsigned* p, unsigned v) { return __hip_atomic_fetch_add(p, v, __ATOMIC_RELAXED, __HIP_MEMORY_SCOPE_AGENT); }
__device__ __forceinline__ unsigned xb_xcc_id() { return (unsigned)__builtin_amdgcn_s_getreg((3 << 11) | 20) & 0xFu; }
#define XB_SPIN(cond, bar) do { unsigned _sp = 0; while (cond) { __builtin_amdgcn_s_sleep(1); \
    if ((++_sp & 255u) == 0u) { if (xb_ld(&(bar)[XB_TMO])) break; if (_sp > XB_SPIN_CAP) { atomicAdd(&(bar)[XB_TMO], 1u); break; } } } } while (0)

struct XcdBarrier {
    unsigned* bar; unsigned x;
    volatile LAS unsigned* st;
};

__device__ __forceinline__ XcdBarrier xcd_barrier_post(unsigned* bar, volatile LAS unsigned* st) {
    XcdBarrier b; b.bar = bar; b.x = xb_xcc_id(); b.st = st;
    if (threadIdx.x == 0) (void)xb_add(&bar[XB_XCNT(b.x)], 1u);
    return b;
}
__device__ __forceinline__ void xcd_barrier_complete(unsigned* bar, unsigned x, unsigned& nloc, unsigned& nx) {
    const unsigned G = gridDim.x * gridDim.y * gridDim.z;
    unsigned sum, cnt, mine, sp = 0u;
    for (;;) {
        sum = 0u; cnt = 0u; mine = 0u;
#pragma unroll
        for (unsigned j = 0; j < 16; ++j) { const unsigned c = xb_ld(&bar[XB_XCNT(j)]); sum += c; cnt += (c > 0u) ? 1u : 0u; mine = (j == x) ? c : mine; }
        if (sum == G) break;
        __builtin_amdgcn_s_sleep(1);
        if ((++sp & 255u) == 0u) { if (xb_ld(&bar[XB_TMO])) break; if (sp > XB_SPIN_CAP) { atomicAdd(&bar[XB_TMO], 1u); break; } }
    }
    nloc = mine > 0u ? mine : 1u; nx = cnt > 0u ? cnt : 1u;
}

__device__ __forceinline__ void xcd_barrier(const XcdBarrier& b) {
    asm volatile("s_waitcnt vmcnt(0)" ::: "memory");
    __syncthreads();
    if (threadIdx.x == 0) {
        unsigned* bar = b.bar;
        __builtin_amdgcn_s_waitcnt(0);
        unsigned nloc = b.st[0], nx = b.st[1];
        if (nloc == 0u) { xcd_barrier_complete(bar, b.x, nloc, nx); b.st[0] = nloc; b.st[1] = nx; }
        const unsigned old = xb_add(&bar[XB_XSUB(b.x)], 1u);
        const unsigned gen = old / nloc;
        if (old + 1u == (gen + 1u) * nloc) {
            __builtin_amdgcn_fence(__ATOMIC_RELEASE, "agent");
            asm volatile("s_waitcnt vmcnt(0)" ::: "memory");
            const unsigned og = xb_add(&bar[XB_TOP], 1u);
            const unsigned tg = og / nx;
            if (og + 1u == (tg + 1u) * nx) xb_add(&bar[XB_TOPGEN], 1u);
            else XB_SPIN(xb_ld(&bar[XB_TOPGEN]) == tg, bar);
            __builtin_amdgcn_fence(__ATOMIC_ACQUIRE, "agent");
            xb_add(&bar[XB_XGEN(b.x)], 1u);
            asm volatile("s_waitcnt vmcnt(0)" ::: "memory");
        } else {
            XB_SPIN(xb_ld(&bar[XB_XGEN(b.x)]) == gen, bar);
            __builtin_amdgcn_fence(__ATOMIC_ACQUIRE, "agent");
            asm volatile("s_waitcnt vmcnt(0)" ::: "memory");
        }
    }
    __syncthreads();
}

DI void transpose_item(const float* __restrict__ W, int N, int NP, bf16_t* __restrict__ WT, int item, float* scr, const float* __restrict__ gain = nullptr) {
    const int tid = ltid();
    const int nblk = NP / 64, kb = item / nblk, nb = item % nblk, k0 = kb * 64, n0 = nb * 64;
#pragma unroll
    for (int i = 0; i < 16; ++i) {
        const int kk = i * 4 + (tid >> 6), nn = tid & 63;
        scr[kk * 65 + nn] = (n0 + nn < N) ? W[(size_t)(k0 + kk) * N + n0 + nn] * (gain ? gain[k0 + kk] : 1.f) : 0.f;
    }
    __syncthreads();
    const int n = tid >> 2, c = tid & 3;
    uint4 o0, o1;
    const float* s = scr + (c * 16) * 65 + n;
    o0.x = pk2(s[0 * 65], s[1 * 65]); o0.y = pk2(s[2 * 65], s[3 * 65]); o0.z = pk2(s[4 * 65], s[5 * 65]); o0.w = pk2(s[6 * 65], s[7 * 65]);
    o1.x = pk2(s[8 * 65], s[9 * 65]); o1.y = pk2(s[10 * 65], s[11 * 65]); o1.z = pk2(s[12 * 65], s[13 * 65]); o1.w = pk2(s[14 * 65], s[15 * 65]);
    uint4* dst = (uint4*)(WT + (size_t)(n0 + n) * 1024 + k0 + c * 16);
    dst[0] = o0; dst[1] = o1;
    __syncthreads();
}

DI void rms_row_to_bf16(const float* xrow, const float* gain, bf16_t* orow, int lane) {
    f32x4 v[4]; float ss = 0.f;
#pragma unroll
    for (int j = 0; j < 4; ++j) { v[j] = ((const f32x4*)xrow)[lane + 64 * j]; ss += (v[j].x * v[j].x + v[j].y * v[j].y) + (v[j].z * v[j].z + v[j].w * v[j].w); }
    const float rstd = rsqrtf(wave_sum(ss) * (1.f / 1024.f) + EPS);
#pragma unroll
    for (int j = 0; j < 4; ++j) {
        const f32x4 g = ((const f32x4*)gain)[lane + 64 * j];
        uint2 w; w.x = pk2(v[j].x * rstd * g.x, v[j].y * rstd * g.y); w.y = pk2(v[j].z * rstd * g.z, v[j].w * rstd * g.w);
        ((uint2*)orow)[lane + 64 * j] = w;
    }
}

constexpr int I_IN = 16 * (NPAD / 64), I_OUT = 16 * 16;
DI void wt_item(const Params& p, int l, int it, float* scr) {
    if (it < I_IN) transpose_item(p.w_in + (size_t)l * 1024 * DIN, DIN, NPAD, p.WinT + (size_t)l * NPAD * 1024, it, scr, l == 1 ? p.pre_g + 1024 : nullptr);
    else transpose_item(p.w_out + (size_t)l * 1024 * 1024, 1024, 1024, p.WoutT + (size_t)l * 1024 * 1024, it - I_IN, scr);
}
DI void phase0(const Params& p, char* smem) {
    const int tid = ltid(), G = gridDim.x;
    if (blockIdx.x == 0 && tid < 8) p.ctr[tid] = 0u;
    float* scr = (float*)smem;
    for (int it = blockIdx.x; it < I_IN + I_OUT; it += G) wt_item(p, 0, it, scr);
    const int gt = blockIdx.x * NTHREADS + tid, GT = G * NTHREADS;
    for (int idx = gt; idx < 2 * 4 * 128 * 128; idx += GT) {
        const int i = (idx >> 7) & 127, j = idx & 127;
        const float w = p.a_sw[idx];
        p.WsA[idx] = f2bf(((j >> 6) <= (i >> 6)) ? w : 0.f);
    }
    for (int idx = gt; idx < 4096 * 32; idx += GT) {
        const int pos = idx >> 5, i = idx & 31;
        const float inv = powf(10000.f, -(float)i / 32.f);
        const float ang = (float)pos * inv;
        float sn, cs; sincosf(ang, &sn, &cs);
        p.rope[2 * idx] = cs; p.rope[2 * idx + 1] = sn;
    }
    const int wv = tid >> 6, lane = tid & 63;
    for (int row = (blockIdx.x * 4 + wv) * 2; row < NTOK; row += G * 8) {
        f32x4 v[2][4]; float ss[2] = {0.f, 0.f};
#pragma unroll
        for (int q = 0; q < 2; ++q)
#pragma unroll
            for (int j = 0; j < 4; ++j) v[q][j] = ((const f32x4*)(p.x + (size_t)(row + q) * 1024))[IDX4(j)];
#pragma unroll
        for (int q = 0; q < 2; ++q)
#pragma unroll
            for (int j = 0; j < 4; ++j) ss[q] += (v[q][j].x * v[q][j].x + v[q][j].y * v[q][j].y) + (v[q][j].z * v[q][j].z + v[q][j].w * v[q][j].w);
#pragma unroll
        for (int o = 1; o < 64; o <<= 1) { ss[0] += __shfl_xor(ss[0], o); ss[1] += __shfl_xor(ss[1], o); }
#pragma unroll
        for (int q = 0; q < 2; ++q) {
            const float rstd = rsqrtf(ss[q] * (1.f / 1024.f) + EPS);
#pragma unroll
            for (int j = 0; j < 2; ++j) {
                const f32x4 ga = ((const f32x4*)p.pre_g)[IDX4(2 * j)], gb = ((const f32x4*)p.pre_g)[IDX4(2 * j + 1)], va = v[q][2 * j], vb = v[q][2 * j + 1];
                uint4 w2; w2.x = pk2(va.x * rstd * ga.x, va.y * rstd * ga.y); w2.y = pk2(va.z * rstd * ga.z, va.w * rstd * ga.w);
                w2.z = pk2(vb.x * rstd * gb.x, vb.y * rstd * gb.y); w2.w = pk2(vb.z * rstd * gb.z, vb.w * rstd * gb.w);
                ((uint4*)(p.hb + (size_t)(row + q) * 1024))[lane + 64 * j] = w2;
            }
        }
    }
}

template <int MODE>
DI void gemm_phase(const Params& p, int layer, char* smem) {
    const bf16_t* __restrict__ A = MODE == 0 ? (layer == 0 ? p.hb : p.x1b) : p.y;
    const float* __restrict__ rsp = (MODE == 0 && layer != 0) ? p.rs : nullptr;
    const bf16_t* __restrict__ Bt = MODE == 0 ? p.WinT + (size_t)layer * NPAD * 1024 : p.WoutT + (size_t)layer * 1024 * 1024;
    constexpr int NTN = MODE == 0 ? 30 : 8, K = 1024, NKT = K / 64;
    const int ntiles = 256 * NTN;
    bf16_t* As = (bf16_t*)smem;
    bf16_t* Bs = As + 2 * 128 * 72;
    const int tid = ltid(), w = tid >> 6, lane = tid & 63, r = lane & 31, h = lane >> 5, wm = w >> 1, wn = w & 1;
    const bool xmap = (gridDim.x & 7) == 0;
    const int xcd = blockIdx.x & 7, nper = gridDim.x >> 3;
    const int tstart = xmap ? (int)(blockIdx.x >> 3) : (int)blockIdx.x, tend = xmap ? 32 * NTN : ntiles, tstep = xmap ? nper : (int)gridDim.x;
#define TILE_MN(t_, m0_, n0_, nt_) { const int grp_ = (t_) / (8 * NTN), rr_ = (t_) % (8 * NTN); nt_ = rr_ >> 3; m0_ = ((xmap ? xcd * 32 : 0) + grp_ * 8 + (rr_ & 7)) * 128; n0_ = nt_ * 128; }
    int goff[4];
#pragma unroll
    for (int i = 0; i < 4; ++i) { const int R = w * 32 + i * 8 + (lane >> 3); goff[i] = R * K + (((lane & 7) ^ ((R >> 1) & 7)) * 8); }
    LAS unsigned char* lds = (LAS unsigned char*)smem;
#define DMA_SLAB(pa, pb, koff, bufi) { _Pragma("unroll") for (int i_ = 0; i_ < 4; ++i_) { \
        __builtin_amdgcn_global_load_lds((const unsigned*)((pa) + goff[i_] + (koff)), (LAS unsigned*)(lds + (bufi) * 32768 + (w * 4 + i_) * 1024), 16, 0, 0); \
        __builtin_amdgcn_global_load_lds((const unsigned*)((pb) + goff[i_] + (koff)), (LAS unsigned*)(lds + (bufi) * 32768 + 16384 + (w * 4 + i_) * 1024), 16, 0, 0); } }
    const bf16_t *ga = A, *gb = Bt;
    if (tstart < tend) {
        int m0f, n0f, ntf;
        TILE_MN(tstart, m0f, n0f, ntf)
        ga = A + (size_t)m0f * K; gb = Bt + (size_t)n0f * K;
        DMA_SLAB(ga, gb, 0, 0)
    }
    asm volatile("s_waitcnt vmcnt(0)" ::: "memory");
    __syncthreads();
    const int l15 = lane & 15, q4 = lane >> 4, fsw = (l15 >> 1) & 7;
    for (int t = tstart; t < tend; t += tstep) {
        int m0, n0, nt;
        TILE_MN(t, m0, n0, nt)
        const bf16_t *gan = ga, *gbn = gb;
        if (t + tstep < tend) { int m0n, n0n, ntn; TILE_MN(t + tstep, m0n, n0n, ntn) gan = A + (size_t)m0n * K; gbn = Bt + (size_t)n0n * K; }
        const bool isv = MODE == 0 && ((nt >= 12 && nt < 15) || (nt >= 24 && nt < 27));
        const int offm = isv ? 16384 + (wn * 64 + l15) * 128 : (wm * 64 + l15) * 128;
        const int offn = isv ? (wm * 64 + l15) * 128 : 16384 + (wn * 64 + l15) * 128;
        f32x4 acc[4][4];
#pragma unroll
        for (int a = 0; a < 4; ++a)
#pragma unroll
            for (int b = 0; b < 4; ++b) acc[a][b] = (f32x4){0.f, 0.f, 0.f, 0.f};
#pragma unroll
        for (int kt = 0; kt < NKT; ++kt) {
            const int buf = kt & 1;
            if (kt + 1 < NKT) { DMA_SLAB(ga, gb, (kt + 1) * 64, buf ^ 1) } else { DMA_SLAB(gan, gbn, 0, buf ^ 1) }
            const char* as = smem + buf * 32768 + offm;
            const char* bs = smem + buf * 32768 + offn;
#pragma unroll
            for (int kk = 0; kk < 2; ++kk) {
                const int co = ((4 * kk + q4) ^ fsw) * 16;
                bf16x8 fn[4], fm[4];
#pragma unroll
                for (int t4 = 0; t4 < 4; ++t4) { fn[t4] = *(const bf16x8*)(bs + t4 * 16 * 128 + co); fm[t4] = *(const bf16x8*)(as + t4 * 16 * 128 + co); }
#pragma unroll
                for (int tn = 0; tn < 4; ++tn)
#pragma unroll
                    for (int tm = 0; tm < 4; ++tm) acc[tn][tm] = MFMA16(fn[tn], fm[tm], acc[tn][tm]);
            }
            asm volatile("s_waitcnt vmcnt(0)" ::: "memory");
            __syncthreads();
        }
        ga = gan; gb = gbn;
        if (MODE == 1) {
            bf16_t* Cs = (bf16_t*)(smem + 32768);
#pragma unroll
            for (int tm = 0; tm < 4; ++tm)
#pragma unroll
                for (int tn = 0; tn < 4; ++tn) {
                    uint2 v; v.x = pk2(acc[tn][tm][0], acc[tn][tm][1]); v.y = pk2(acc[tn][tm][2], acc[tn][tm][3]);
                    *(uint2*)(Cs + (wm * 64 + tm * 16 + l15) * 136 + wn * 64 + tn * 16 + 4 * q4) = v;
                }
            __syncthreads();
#pragma unroll
            for (int i = 0; i < 8; ++i) {
                const int c = tid + i * 256, row = c >> 4, cc = c & 15;
                *(uint4*)(p.o + (size_t)(m0 + row) * 1024 + n0 + cc * 8) = *(const uint4*)&Cs[row * 136 + cc * 8];
            }
            __syncthreads();
        } else {
            if (nt == 30) {
                if (wn == 0 && q4 < 2) {
#pragma unroll
                    for (int tm = 0; tm < 4; ++tm) {
                        const int tok = m0 + wm * 64 + tm * 16 + l15, b = tok >> 12, sq = tok & 4095;
#pragma unroll
                        for (int u = 0; u < 4; ++u) {
                            const int n = 4 * q4 + u;
                            if (n < 6) p.lf[(size_t)(b * 6 + n) * 4096 + sq] = logsigmoid_f(acc[0][tm][u] + p.b_f[layer * 6 + n]);
                        }
                    }
                }
            } else {
                int kind;
                if (nt < 4) kind = 1; else if (nt < 6) kind = 2; else if (nt < 9) kind = 3; else if (nt < 12) kind = 4; else if (nt < 15) kind = 0;
                else if (nt < 18) kind = 2; else if (nt < 21) kind = 5; else if (nt < 27) kind = 0; else kind = 2;
                if (rsp) {
                    if (isv) {
#pragma unroll
                        for (int a2 = 0; a2 < 4; ++a2) {
                            const f32x4 rv = *(const f32x4*)(rsp + m0 + wm * 64 + a2 * 16 + 4 * q4);
#pragma unroll
                            for (int b2 = 0; b2 < 4; ++b2) acc[a2][b2] = acc[a2][b2] * rv;
                        }
                    } else {
#pragma unroll
                        for (int tm = 0; tm < 4; ++tm) {
                            const float rv = rsp[m0 + wm * 64 + tm * 16 + l15];
#pragma unroll
                            for (int tn = 0; tn < 4; ++tn) acc[tn][tm] = acc[tn][tm] * rv;
                        }
                    }
                }
                if (nt >= 21 && nt < 24) {
                    float mxn = 0.f;
#pragma unroll
                    for (int tm = 0; tm < 4; ++tm) {
                        float ssq = 0.f;
#pragma unroll
                        for (int tn = 0; tn < 4; ++tn)
#pragma unroll
                            for (int i = 0; i < 4; ++i) ssq += acc[tn][tm][i] * acc[tn][tm][i];
                        ssq += __shfl_xor(ssq, 16); ssq += __shfl_xor(ssq, 32);
                        mxn = fmaxf(mxn, ssq);
                    }
#pragma unroll
                    for (int o = 1; o < 16; o <<= 1) mxn = fmaxf(mxn, __shfl_xor(mxn, o));
                    if (lane == 0) p.kn[((m0 >> 12) * 6 + (nt - 21) * 2 + wn) * 64 + (((m0 & 4095) + wm * 64) >> 6)] = sqrtf(mxn);
                }
                bf16_t* Cs = (bf16_t*)(smem + 32768);
#pragma unroll
                for (int tm = 0; tm < 4; ++tm) {
                    if (kind == 3 || kind == 4) {
                        const float sc = kind == 3 ? 0.125f : 1.f;
                        const int pos = (m0 + wm * 64 + tm * 16 + l15) & 4095;
                        const float* rp = p.rope + (size_t)pos * 64 + 8 * q4;
#pragma unroll
                        for (int tn = 0; tn < 2; ++tn) {
                            const f32x4 c0 = *(const f32x4*)(rp + 32 * tn), c1 = *(const f32x4*)(rp + 32 * tn + 4);
                            const float cs[4] = {c0.x, c0.z, c1.x, c1.z}, sn[4] = {c0.y, c0.w, c1.y, c1.w};
#pragma unroll
                            for (int u = 0; u < 4; ++u) {
                                const float x1 = acc[tn][tm][u], x2 = acc[tn + 2][tm][u];
                                acc[tn][tm][u] = (x1 * cs[u] - x2 * sn[u]) * sc;
                                acc[tn + 2][tm][u] = (x1 * sn[u] + x2 * cs[u]) * sc;
                            }
                        }
                    }
#pragma unroll
                    for (int tn = 0; tn < 4; ++tn) {
                        if (kind == 1) {
#pragma unroll
                            for (int i = 0; i < 4; ++i) acc[tn][tm][i] = gelu_tanh_f(acc[tn][tm][i]);
                        } else if (kind == 2) {
#pragma unroll
                            for (int i = 0; i < 4; ++i) acc[tn][tm][i] = silu_f(acc[tn][tm][i]);
                        } else if (kind == 5) {
#pragma unroll
                            for (int i = 0; i < 4; ++i) acc[tn][tm][i] *= 0.125f * LOG2E;
                        }
                        uint2 v; v.x = pk2(acc[tn][tm][0], acc[tn][tm][1]); v.y = pk2(acc[tn][tm][2], acc[tn][tm][3]);
                        if (isv) *(uint2*)(Cs + (wn * 64 + tm * 16 + l15) * 136 + wm * 64 + tn * 16 + 4 * q4) = v;
                        else *(uint2*)(Cs + (wm * 64 + tm * 16 + l15) * 136 + wn * 64 + tn * 16 + 4 * q4) = v;
                    }
                    __builtin_amdgcn_sched_barrier(0);
                }
                __syncthreads();
                if (isv) {
                    const int te = ltid();
#pragma unroll
                    for (int i = 0; i < 8; ++i) {
                        const int c = te + i * 256, n = c >> 4, cc = c & 15;
                        const int hd = (nt >= 24 ? nt - 24 : nt - 12) * 2 + (n >> 6), e = n & 63;
                        bf16_t* dst = (nt >= 24 ? p.vTf : p.vTr) + ((size_t)((m0 >> 12) * 6 + hd) * 64 + e) * 4096 + (m0 & 4095) + cc * 8;
                        *(uint4*)dst = *(const uint4*)&Cs[n * 136 + cc * 8];
                    }
                } else {
                    const int n0z = n0 - (nt >= 27 ? 768 : (nt >= 15 ? 384 : 0));
#pragma unroll
                    for (int i = 0; i < 8; ++i) {
                        const int c = tid + i * 256, row = c >> 4, cc = c & 15;
                        *(uint4*)(p.z + (size_t)(m0 + row) * ZLD + n0z + cc * 8) = *(const uint4*)&Cs[row * 136 + cc * 8];
                    }
                }
                __syncthreads();
            }
        }
    }
    if (MODE == 0) {
        const bf16_t* gbl = Bt + (size_t)3840 * K;
        const int wb = w & 1;
        const int goffb = (wb * 8 + (lane >> 3)) * K + (((lane & 7) ^ (((wb * 8 + (lane >> 3)) >> 1) & 7)) * 8);
#define LG_DMA(pa, st, sl) { _Pragma("unroll") for (int i_ = 0; i_ < 4; ++i_) \
        __builtin_amdgcn_global_load_lds((const unsigned*)((pa) + goff[i_] + (st) * 64), (LAS unsigned*)(lds + (sl) * 16384 + (w * 4 + i_) * 1024), 16, 0, 0); \
        __builtin_amdgcn_global_load_lds((const unsigned*)(gbl + goffb + (st) * 64), (LAS unsigned*)(lds + 65536 + (sl) * 2048 + wb * 1024), 16, 0, 0); }
        for (int mt = blockIdx.x; mt < NTOK / 128; mt += gridDim.x) {
            const int m0 = mt * 128;
            const bf16_t* gal = A + (size_t)m0 * K;
            f32x4 lacc[2] = {(f32x4){0.f, 0.f, 0.f, 0.f}, (f32x4){0.f, 0.f, 0.f, 0.f}};
            LG_DMA(gal, 0, 0) LG_DMA(gal, 1, 1) LG_DMA(gal, 2, 2)
#pragma unroll
            for (int kt = 0; kt < NKT; ++kt) {
                if (kt + 2 < NKT) asm volatile("s_waitcnt vmcnt(10)" ::: "memory"); else if (kt + 1 < NKT) asm volatile("s_waitcnt vmcnt(5)" ::: "memory"); else asm volatile("s_waitcnt vmcnt(0)" ::: "memory");
                __syncthreads();
                if (kt + 3 < NKT) LG_DMA(gal, kt + 3, (kt + 3) & 3)
                const char* as = smem + (kt & 3) * 16384 + (w * 32 + l15) * 128;
                const char* bs = smem + 65536 + (kt & 3) * 2048 + l15 * 128;
#pragma unroll
                for (int kk = 0; kk < 2; ++kk) {
                    const int co = ((4 * kk + q4) ^ fsw) * 16;
                    const bf16x8 fnl = *(const bf16x8*)(bs + co);
                    const bf16x8 fm0 = *(const bf16x8*)(as + co), fm1 = *(const bf16x8*)(as + 16 * 128 + co);
                    lacc[0] = MFMA16(fnl, fm0, lacc[0]); lacc[1] = MFMA16(fnl, fm1, lacc[1]);
                }
            }
            __syncthreads();
            if (q4 < 2) {
#pragma unroll
                for (int tm = 0; tm < 2; ++tm) {
                    const int tok = m0 + w * 32 + tm * 16 + l15, b = tok >> 12, sq = tok & 4095;
#pragma unroll
                    for (int u = 0; u < 4; ++u) {
                        const int n = 4 * q4 + u;
                        if (n < 6) p.lf[(size_t)(b * 6 + n) * 4096 + sq] = logsigmoid_f(lacc[tm][u] * (rsp ? rsp[tok] : 1.f) + p.b_f[layer * 6 + n]);
                    }
                }
            }
        }
    }
}

DI void unpack8(const uint4 v, float* f) { f[0] = lo_f(v.x); f[1] = hi_f(v.x); f[2] = lo_f(v.y); f[3] = hi_f(v.y); f[4] = lo_f(v.z); f[5] = hi_f(v.z); f[6] = lo_f(v.w); f[7] = hi_f(v.w); }

DI void abranch_item(const Params& p, int layer, int item, char* smem) {
    const int g = item & 3, nb = (item >> 2) & 31, b = item >> 7;
    const int t0 = b * 4096 + nb * 128;
    bf16_t* vnT = (bf16_t*)smem;
    const int tid = ltid(), w = tid >> 6, lane = tid & 63, r = lane & 31, h = lane >> 5;
    {
        const int tok = tid >> 1, half = tid & 1;
        const uint4* src = (const uint4*)(p.z + (size_t)(t0 + tok) * ZLD + C_AV + g * 64 + half * 32);
        float v[32];
#pragma unroll
        for (int i = 0; i < 4; ++i) unpack8(src[i], v + 8 * i);
        float s = 0.f;
#pragma unroll
        for (int i = 0; i < 32; ++i) s += v[i];
        s += __shfl_xor(s, 1);
        const float mean = s * (1.f / 64.f);
        float q = 0.f;
#pragma unroll
        for (int i = 0; i < 32; ++i) { v[i] -= mean; q += v[i] * v[i]; }
        q += __shfl_xor(q, 1);
        const float rstd = rsqrtf(q * (1.f / 64.f) + EPS);
        const float* gain = p.a_ng + layer * 256 + g * 64 + half * 32;
#pragma unroll
        for (int i = 0; i < 32; ++i) vnT[(half * 32 + i) * 136 + tok] = f2bf(v[i] * rstd * gain[i]);
    }
    __syncthreads();
    f32x16 acc[2] = {zero16(), zero16()};
    const bf16_t* wrow = p.WsA + ((size_t)(layer * 4 + g) * 128 + w * 32 + r) * 128 + h * 8;
    const int kmax = (w < 2) ? 4 : 8;
    for (int ks = 0; ks < kmax; ++ks) {
        const bf16x8 bfr = *(const bf16x8*)(wrow + ks * 16);
#pragma unroll
        for (int ct = 0; ct < 2; ++ct) {
            const bf16x8 afr = *(const bf16x8*)&vnT[(ct * 32 + r) * 136 + ks * 16 + h * 8];
            acc[ct] = MFMA32(afr, bfr, acc[ct]);
        }
    }
    const int i = w * 32 + r, tok = t0 + i;
    const float bias = p.a_sb[(layer * 4 + g) * 128 + i];
#pragma unroll
    for (int ct = 0; ct < 2; ++ct)
#pragma unroll
        for (int gq = 0; gq < 4; ++gq) {
            const int c0 = ct * 32 + 8 * gq + 4 * h;
            const uint2 u = *(const uint2*)(p.z + (size_t)tok * ZLD + C_AU + g * 64 + c0);
            const uint2 sg = *(const uint2*)(p.z + (size_t)tok * ZLD + C_AG + g * 64 + c0);
            const float o0 = lo_f(u.x) * (acc[ct][4 * gq] + bias) * lo_f(sg.x), o1 = hi_f(u.x) * (acc[ct][4 * gq + 1] + bias) * hi_f(sg.x);
            const float o2 = lo_f(u.y) * (acc[ct][4 * gq + 2] + bias) * lo_f(sg.y), o3 = hi_f(u.y) * (acc[ct][4 * gq + 3] + bias) * hi_f(sg.y);
            uint2 ov; ov.x = pk2(o0, o1); ov.y = pk2(o2, o3);
            *(uint2*)(p.y + (size_t)tok * 1024 + g * 64 + c0) = ov;
        }
    __syncthreads();
}

DI void kv_item(const Params& p, int item, char* smem) {
    const int n = item & 63, bh = item >> 6, hd = bh % 6, b = bh / 6;
    const int t0 = b * 4096 + n * 64;
    bf16_t* KT = (bf16_t*)smem;
    bf16_t* VT = KT + 64 * 72;
    const int tid = ltid(), w = tid >> 6, lane = tid & 63, r = lane & 31, h = lane >> 5;
    {
        const int j = tid >> 2, part = tid & 3;
        const uint4* ks = (const uint4*)(p.z + (size_t)(t0 + j) * ZLD + C_RK + hd * 64 + part * 16);
        const uint4* vs = (const uint4*)(p.vTr + ((size_t)bh * 64 + j) * 4096 + n * 64 + part * 16);
        float kf[16]; unpack8(ks[0], kf); unpack8(ks[1], kf + 8);
        *(uint4*)&VT[j * 72 + part * 16] = vs[0]; *(uint4*)&VT[j * 72 + part * 16 + 8] = vs[1];
        const float lg = logf(1.f - exp2f(-5.f - (float)hd));
        const float kd = expf(lg * (float)(63 - j));
#pragma unroll
        for (int q = 0; q < 16; ++q) {
            KT[(part * 16 + q) * 72 + j] = f2bf(kf[q] * kd);
        }
    }
    __syncthreads();
    const int dt = w >> 1, et = w & 1;
    f32x16 acc = zero16();
#pragma unroll
    for (int ks = 0; ks < 4; ++ks) {
        const bf16x8 a = *(const bf16x8*)&KT[(dt * 32 + r) * 72 + ks * 16 + h * 8];
        const bf16x8 bb = *(const bf16x8*)&VT[(et * 32 + r) * 72 + ks * 16 + h * 8];
        acc = MFMA32(a, bb, acc);
    }
    bf16_t* dst = (bf16_t*)p.kv + (size_t)item * 4096 + (et * 32 + r) * 64 + dt * 32 + 4 * h;
#pragma unroll
    for (int gq = 0; gq < 4; ++gq) { uint2 v; v.x = pk2(acc[4 * gq], acc[4 * gq + 1]); v.y = pk2(acc[4 * gq + 2], acc[4 * gq + 3]); *(uint2*)(dst + 8 * gq) = v; }
    __syncthreads();
}

DI void cumsum_item(const Params& p, int item, char* smem) {
    const float* src = p.lf + (size_t)item * 4096;
    float* dst = p.cf + (size_t)item * 4096;
    float* wt = (float*)smem;
    const int tid = ltid(), w = tid >> 6, lane = tid & 63;
    float v[16];
#pragma unroll
    for (int i = 0; i < 4; ++i) { const f32x4 t = ((const f32x4*)src)[tid * 4 + i]; v[4 * i] = t.x; v[4 * i + 1] = t.y; v[4 * i + 2] = t.z; v[4 * i + 3] = t.w; }
#pragma unroll
    for (int i = 1; i < 16; ++i) v[i] += v[i - 1];
    const float total = v[15];
    float x = total;
#pragma unroll
    for (int o = 1; o < 64; o <<= 1) { const float y = __shfl_up(x, o); if (lane >= o) x += y; }
    if (lane == 63) wt[w] = x;
    __syncthreads();
    float off = x - total;
    for (int i = 0; i < w; ++i) off += wt[i];
#pragma unroll
    for (int i = 0; i < 4; ++i) { f32x4 t = {v[4 * i] + off, v[4 * i + 1] + off, v[4 * i + 2] + off, v[4 * i + 3] + off}; ((f32x4*)dst)[tid * 4 + i] = t; }
    __syncthreads();
}

DI void phase2a(const Params& p, int layer, char* smem) {
    constexpr int N_CS = 48, N_KV = 3072;
    for (int it = blockIdx.x; it < N_CS + N_KV; it += gridDim.x) {
        if (it < N_CS) cumsum_item(p, it, smem);
        else kv_item(p, it - N_CS, smem);
    }
}

DI void ret_item(const Params& p, int item, char* smem) {
    const int seg = item & 7, bh = item >> 3, hd = bh % 6, b = bh / 6;
    bf16_t* Qs = (bf16_t*)smem;
    bf16_t* Qds = Qs + 64 * 72;
    bf16_t* Ks = Qds + 64 * 72;
    bf16_t* VT = Ks + 64 * 72;
    bf16_t* ST = VT + 64 * 72;
    bf16_t* Ps = ST + 64 * 72;
    float* red = (float*)(Ps + 64 * 72);
    const int tid = ltid(), w = tid >> 6, lane = tid & 63, r = lane & 31, h = lane >> 5;
    const float lg = logf(1.f - exp2f(-5.f - (float)hd));
    const float cd = expf(lg * 64.f);
    const int e_own = tid >> 2, dpart = tid & 3;
    float st[16];
#pragma unroll
    for (int q = 0; q < 16; ++q) st[q] = 0.f;
    const bf16_t* kvb = (const bf16_t*)p.kv + (size_t)bh * 64 * 4096 + e_own * 64 + dpart * 16;
    const int pcut = (int)ceilf(SKIP_T / (-lg * 64.f * LOG2E)) + 1;
    const int m_first = (seg * 8 > pcut) ? seg * 8 - pcut : 0;
#pragma unroll 8
    for (int m = m_first; m < seg * 8; ++m) {
        const uint4* s4 = (const uint4*)(kvb + (size_t)m * 4096);
        float t[16]; unpack8(s4[0], t); unpack8(s4[1], t + 8);
#pragma unroll
        for (int i = 0; i < 16; ++i) st[i] = st[i] * cd + t[i];
    }
    const int lj = tid >> 2, lpart = tid & 3;
    const bf16_t* zr0 = p.z + (size_t)(b * 4096 + seg * 512 + lj) * ZLD + hd * 64 + lpart * 16;
    const bf16_t* vs0 = p.vTr + ((size_t)bh * 64 + lj) * 4096 + seg * 512 + lpart * 16;
    const bf16_t* kvs = kvb + (size_t)(seg * 8) * 4096;
    uint4 pq0 = *(const uint4*)(zr0 + C_RQ), pq1 = *(const uint4*)(zr0 + C_RQ + 8), pk0 = *(const uint4*)(zr0 + C_RK), pk1 = *(const uint4*)(zr0 + C_RK + 8);
    uint4 pv0 = *(const uint4*)vs0, pv1 = *(const uint4*)(vs0 + 8);
    uint4 pkv0 = ((const uint4*)kvs)[0], pkv1 = ((const uint4*)kvs)[1];
    const float qd_c = expf(lg * (float)(lj + 1));
    float dec[16];
    {
        const int i_ = (w & 1) * 32 + r, jt_ = w >> 1;
#pragma unroll
        for (int q = 0; q < 16; ++q) { const int dd = i_ - (jt_ * 32 + crow(q, h)); dec[q] = expf(lg * (float)(dd < 0 ? -dd : dd)); }
    }
    for (int c = 0; c < 8; ++c) {
        const int n = seg * 8 + c, t0 = b * 4096 + n * 64;
        uint2 sgr[4];
        {
            uint4 s0, s1;
            s0.x = pk2(st[0], st[1]); s0.y = pk2(st[2], st[3]); s0.z = pk2(st[4], st[5]); s0.w = pk2(st[6], st[7]);
            s1.x = pk2(st[8], st[9]); s1.y = pk2(st[10], st[11]); s1.z = pk2(st[12], st[13]); s1.w = pk2(st[14], st[15]);
            *(uint4*)&ST[e_own * 72 + dpart * 16] = s0; *(uint4*)&ST[e_own * 72 + dpart * 16 + 8] = s1;
            const int j = lj, part = lpart;
            const uint4 q0 = pq0, q1 = pq1, k0 = pk0, k1 = pk1, v0 = pv0, v1 = pv1;
            *(uint4*)&Qs[j * 72 + part * 16] = q0; *(uint4*)&Qs[j * 72 + part * 16 + 8] = q1;
            *(uint4*)&Ks[j * 72 + part * 16] = k0; *(uint4*)&Ks[j * 72 + part * 16 + 8] = k1;
            const float qd = qd_c;
            float qf[16]; unpack8(q0, qf); unpack8(q1, qf + 8);
            uint4 d0, d1;
            d0.x = pk2(qf[0] * qd, qf[1] * qd); d0.y = pk2(qf[2] * qd, qf[3] * qd); d0.z = pk2(qf[4] * qd, qf[5] * qd); d0.w = pk2(qf[6] * qd, qf[7] * qd);
            d1.x = pk2(qf[8] * qd, qf[9] * qd); d1.y = pk2(qf[10] * qd, qf[11] * qd); d1.z = pk2(qf[12] * qd, qf[13] * qd); d1.w = pk2(qf[14] * qd, qf[15] * qd);
            *(uint4*)&Qds[j * 72 + part * 16] = d0; *(uint4*)&Qds[j * 72 + part * 16 + 8] = d1;
            *(uint4*)&VT[j * 72 + part * 16] = v0; *(uint4*)&VT[j * 72 + part * 16 + 8] = v1;
            if (c + 1 < 8) {
                const bf16_t* zr = zr0 + (size_t)(c + 1) * 64 * ZLD;
                pq0 = *(const uint4*)(zr + C_RQ); pq1 = *(const uint4*)(zr + C_RQ + 8); pk0 = *(const uint4*)(zr + C_RK); pk1 = *(const uint4*)(zr + C_RK + 8);
                pv0 = *(const uint4*)(vs0 + (c + 1) * 64); pv1 = *(const uint4*)(vs0 + (c + 1) * 64 + 8);
            }
            {
                const int i_ = (w & 1) * 32 + r, et_ = w >> 1;
                const bf16_t* gsrc = p.z + (size_t)(t0 + i_) * ZLD + C_RG + hd * 64 + et_ * 32 + 4 * h;
#pragma unroll
                for (int gq = 0; gq < 4; ++gq) sgr[gq] = *(const uint2*)(gsrc + 8 * gq);
            }
            __builtin_amdgcn_sched_barrier(0);
        }
        __syncthreads();
        {
            const int it = w & 1, jt = w >> 1;
            f32x16 acc = zero16();
#pragma unroll
            for (int ks = 0; ks < 4; ++ks) {
                const bf16x8 a = *(const bf16x8*)&Ks[(jt * 32 + r) * 72 + ks * 16 + h * 8];
                const bf16x8 bb = *(const bf16x8*)&Qs[(it * 32 + r) * 72 + ks * 16 + h * 8];
                acc = MFMA32(a, bb, acc);
            }
            const int i = it * 32 + r;
#pragma unroll
            for (int gq = 0; gq < 4; ++gq) {
                const int j0 = jt * 32 + 8 * gq + 4 * h;
                float pv[4];
#pragma unroll
                for (int u = 0; u < 4; ++u) pv[u] = acc[4 * gq + u] * dec[4 * gq + u];
                uint2 o; o.x = pk2(pv[0], pv[1]); o.y = pk2(pv[2], pv[3]);
                *(uint2*)&Ps[i * 72 + j0] = o;
            }
        }
        __syncthreads();
        const int it = w & 1, et = w >> 1;
        f32x16 acc = zero16();
#pragma unroll
        for (int ks = 0; ks < 4; ++ks) {
            const bf16x8 a = *(const bf16x8*)&VT[(et * 32 + r) * 72 + ks * 16 + h * 8];
            const bf16x8 bb = *(const bf16x8*)&Ps[(it * 32 + r) * 72 + ks * 16 + h * 8];
            acc = MFMA32(a, bb, acc);
        }
#pragma unroll
        for (int ks = 0; ks < 4; ++ks) {
            const bf16x8 a = *(const bf16x8*)&ST[(et * 32 + r) * 72 + ks * 16 + h * 8];
            const bf16x8 bb = *(const bf16x8*)&Qds[(it * 32 + r) * 72 + ks * 16 + h * 8];
            acc = MFMA32(a, bb, acc);
        }
        float s1 = 0.f, s2 = 0.f;
#pragma unroll
        for (int q = 0; q < 16; ++q) { s1 += acc[q]; s2 += acc[q] * acc[q]; }
        s1 += __shfl_xor(s1, 32); s2 += __shfl_xor(s2, 32);
        const int i = it * 32 + r;
        if (h == 0) { red[(et * 64 + i) * 2] = s1; red[(et * 64 + i) * 2 + 1] = s2; }
        __syncthreads();
        {
            const float t1 = red[i * 2] + red[(64 + i) * 2], t2 = red[i * 2 + 1] + red[(64 + i) * 2 + 1];
            const float mean = t1 * (1.f / 64.f);
            const float var = fmaxf(t2 * (1.f / 64.f) - mean * mean, 0.f);
            const float rstd = rsqrtf(var + EPS);
            const int tok = t0 + i;
#pragma unroll
            for (int gq = 0; gq < 4; ++gq) {
                const int e0 = et * 32 + 8 * gq + 4 * h;
                const uint2 sg = sgr[gq];
                uint2 o;
                o.x = pk2((acc[4 * gq] - mean) * rstd * lo_f(sg.x), (acc[4 * gq + 1] - mean) * rstd * hi_f(sg.x));
                o.y = pk2((acc[4 * gq + 2] - mean) * rstd * lo_f(sg.y), (acc[4 * gq + 3] - mean) * rstd * hi_f(sg.y));
                *(uint2*)(p.y + (size_t)tok * 1024 + 256 + hd * 64 + e0) = o;
            }
        }
        {
            float t[16]; unpack8(pkv0, t); unpack8(pkv1, t + 8);
#pragma unroll
            for (int i2 = 0; i2 < 16; ++i2) st[i2] = st[i2] * cd + t[i2];
            if (c + 1 < 8) { const uint4* s4 = (const uint4*)(kvs + (size_t)(c + 1) * 4096); pkv0 = s4[0]; pkv1 = s4[1]; }
            __builtin_amdgcn_sched_barrier(0);
        }
    }
    __syncthreads();
}

DI void attn_item(const Params& p, int item, char* smem) {
    const int qb = 15 - item / 48, bh = item % 48, hd = bh % 6, b = bh / 6;
    float* Fall = (float*)smem;
    LAS unsigned char* lds = (LAS unsigned char*)smem;
    const int tid = ltid(), w = tid >> 6, lane = tid & 63, r = lane & 31, h = lane >> 5;
    const int q0w = qb * 256 + w * 64;
    const float* cfb = p.cf + (size_t)bh * 4096;
    const int nkt = 4 * qb + 4;
    const bf16_t* kbase = p.z + (size_t)b * 4096 * ZLD + C_FK + hd * 64;
    const bf16_t* vbase = p.vTf + (size_t)bh * 64 * 4096;
#define ATT_DMA(kt_, s_) { const int ln_ = ltid() & 63; _Pragma("unroll") for (int i_ = 0; i_ < 2; ++i_) { \
        const int R_ = (w * 2 + i_) * 8 + (ln_ >> 3), c_ = ((ln_ & 7) ^ ((R_ >> 1) & 7)) * 8;     \
        __builtin_amdgcn_global_load_lds((const unsigned*)(kbase + (size_t)(kt_) * 64 * ZLD + R_ * ZLD + c_), (LAS unsigned*)(lds + 16384 + (s_) * 16384 + (w * 2 + i_) * 1024), 16, 0, 0); \
        __builtin_amdgcn_global_load_lds((const unsigned*)(vbase + (kt_) * 64 + R_ * 4096 + c_), (LAS unsigned*)(lds + 16384 + (s_) * 16384 + 8192 + (w * 2 + i_) * 1024), 16, 0, 0); } }
    __syncthreads();
    ATT_DMA(nkt - 1, (nkt - 1) % 3)
    ATT_DMA(nkt - 2, (nkt - 2) % 3)
#pragma unroll
    for (int i = 0; i < 4; ++i) {
        const int i4 = tid + i * NTHREADS;
        if (i4 * 4 < nkt * 64) { const f32x4 c = ((const f32x4*)cfb)[i4]; ((f32x4*)Fall)[i4] = c * LOG2E; }
    }
    bf16x8 qf[2][4];
    float* own = (float*)(smem + 66560) + tid * 4;
#pragma unroll
    for (int rg = 0; rg < 2; ++rg) {
        const size_t tq = (size_t)b * 4096 + q0w + rg * 32 + r;
#pragma unroll
        for (int ks = 0; ks < 4; ++ks) qf[rg][ks] = *(const bf16x8*)(p.z + tq * ZLD + C_FQ + hd * 64 + ks * 16 + h * 8);
        own[rg] = cfb[q0w + rg * 32 + r] * LOG2E;
    }
    float* knp = (float*)(smem + 65536);
    int* flg = (int*)(smem + 65536 + 256);
    if (w == 0) {
        float kv = (lane < nkt) ? p.kn[bh * 64 + lane] : 0.f;
#pragma unroll
        for (int o = 1; o < 64; o <<= 1) { const float y = __shfl_up(kv, o); if (lane >= o) kv = fmaxf(kv, y); }
        knp[lane] = kv * 1.02f;
    }
#pragma unroll
    for (int rg = 0; rg < 2; ++rg) {
        float ssq = 0.f;
#pragma unroll
        for (int ks = 0; ks < 4; ++ks)
#pragma unroll
            for (int j = 0; j < 8; ++j) { const float qv = bf2f((unsigned)(unsigned short)qf[rg][ks][j]); ssq += qv * qv; }
        ssq += __shfl_xor(ssq, 32);
        own[2 + rg] = sqrtf(ssq);
    }
    f32x16 O[2][2] = {{zero16(), zero16()}, {zero16(), zero16()}};
    float m[2] = {-INFINITY, -INFINITY}, l[2] = {0.f, 0.f};
    const int fsw = (r >> 1) & 7;
    for (int kt = nkt - 1; kt >= 0; --kt) {
        bool wdone = false;
        if (kt < nkt - 1) {
            const float fl_ = Fall[kt * 64 + 63], kp = knp[kt];
            const f32x4 ow = *(const f32x4*)own;
            const bool ok = (ow.z * kp + ow.x - fl_ < m[0] - SKIP_T) && (ow.w * kp + ow.y - fl_ < m[1] - SKIP_T);
            wdone = (__ballot(!ok) == 0ull);
        }
        if (lane == 0) flg[(kt & 3) * 4 + w] = wdone ? 1 : 0;
        if (kt > 0) asm volatile("s_waitcnt vmcnt(4)" ::: "memory"); else asm volatile("s_waitcnt vmcnt(0)" ::: "memory");
        __syncthreads();
        {
            const int4 fl = *(const int4*)&flg[(kt & 3) * 4];
            if (fl.x & fl.y & fl.z & fl.w) break;
        }
        if (kt >= 2) ATT_DMA(kt - 2, (kt - 2) % 3)
        const int kmin = kt * 64;
        if (!wdone && kmin <= q0w + 63) {
            const char* Kt = smem + 16384 + (kt % 3) * 16384;
            const char* Vt = Kt + 8192;
#pragma unroll
            for (int jt = 1; jt >= 0; --jt) {
                if (kmin + jt * 32 > q0w + 63) continue;
                bf16x8 kf[4];
#pragma unroll
                for (int ks = 0; ks < 4; ++ks) kf[ks] = *(const bf16x8*)(Kt + (jt * 32 + r) * 128 + (((2 * ks + h) ^ fsw) * 16));
#pragma unroll
                for (int rg = 0; rg < 2; ++rg) {
                    const int q0 = q0w + rg * 32, qrow = q0 + r;
                    if (kmin + jt * 32 > q0 + 31) continue;
                    const float Fi_rg = own[rg];
                    {
                        {
                        f32x16 S;
#pragma unroll
                        for (int gq = 0; gq < 4; ++gq) {
                            const f32x4 fk = *(const f32x4*)&Fall[kmin + jt * 32 + 8 * gq + 4 * h];
                            S[4 * gq] = Fi_rg - fk.x; S[4 * gq + 1] = Fi_rg - fk.y; S[4 * gq + 2] = Fi_rg - fk.z; S[4 * gq + 3] = Fi_rg - fk.w;
                        }
#pragma unroll
                        for (int ks = 0; ks < 4; ++ks) {
                            S = MFMA32(kf[ks], qf[rg][ks], S);
                        }
                        if (kmin + jt * 32 + 31 > q0) {
#pragma unroll
                            for (int q = 0; q < 16; ++q) { const int key = kmin + jt * 32 + crow(q, h); if (key > qrow) S[q] = -INFINITY; }
                        }
                        float mx = S[0];
#pragma unroll
                        for (int q = 1; q < 16; ++q) mx = fmaxf(mx, S[q]);
                        mx = fmaxf(mx, __shfl_xor(mx, 32));
                        if (__ballot(mx > m[rg] - SKIP_T) != 0ull) {
                            const float mnew = fmaxf(m[rg], mx);
                            const float alpha = __builtin_amdgcn_exp2f(m[rg] - mnew);
                            m[rg] = mnew;
                            float ls = 0.f;
#pragma unroll
                            for (int q = 0; q < 16; ++q) { const float pv = __builtin_amdgcn_exp2f(S[q] - mnew); S[q] = pv; ls += pv; }
                            l[rg] = l[rg] * alpha + ls;
                            if (__ballot(alpha != 1.f) != 0ull) {
#pragma unroll
                                for (int et = 0; et < 2; ++et)
#pragma unroll
                                    for (int q = 0; q < 16; ++q) O[rg][et][q] *= alpha;
                            }
#pragma unroll
                            for (int s2 = 0; s2 < 2; ++s2) {
                                uint4 pw;
                                pw.x = pk2(S[8 * s2], S[8 * s2 + 1]); pw.y = pk2(S[8 * s2 + 2], S[8 * s2 + 3]);
                                pw.z = pk2(S[8 * s2 + 4], S[8 * s2 + 5]); pw.w = pk2(S[8 * s2 + 6], S[8 * s2 + 7]);
                                const bf16x8 pf = __builtin_bit_cast(bf16x8, pw);
#pragma unroll
                                for (int et = 0; et < 2; ++et) {
                                    const char* vrow = Vt + (et * 32 + r) * 128 + 8 * h;
                                    const s16x4 lo = *(const s16x4*)(vrow + (((4 * jt + 2 * s2) ^ fsw) * 16)), hi = *(const s16x4*)(vrow + (((4 * jt + 2 * s2 + 1) ^ fsw) * 16));
                                    const bf16x8 vf = __builtin_shufflevector(lo, hi, 0, 1, 2, 3, 4, 5, 6, 7);
                                    O[rg][et] = MFMA32(vf, pf, O[rg][et]);
                                }
                            }
                        }
                    }
                    }
                }
            }
        }
    }
    asm volatile("s_waitcnt vmcnt(0)" ::: "memory");
#pragma unroll
    for (int rg = 0; rg < 2; ++rg) {
        const size_t tokq = (size_t)b * 4096 + q0w + rg * 32 + r;
        float lt = l[rg];
        lt += __shfl_xor(lt, 32);
        const float inv = 1.f / lt;
#pragma unroll
        for (int et = 0; et < 2; ++et)
#pragma unroll
            for (int gq = 0; gq < 4; ++gq) {
                const int e0 = et * 32 + 8 * gq + 4 * h;
                const uint2 sg = *(const uint2*)(p.z + tokq * ZLD + C_FG + hd * 64 + e0);
                uint2 o;
                o.x = pk2(O[rg][et][4 * gq] * inv * lo_f(sg.x), O[rg][et][4 * gq + 1] * inv * hi_f(sg.x));
                o.y = pk2(O[rg][et][4 * gq + 2] * inv * lo_f(sg.y), O[rg][et][4 * gq + 3] * inv * hi_f(sg.y));
                *(uint2*)(p.y + tokq * 1024 + 640 + hd * 64 + e0) = o;
            }
    }
}

DI void phase2b(const Params& p, int layer, char* smem, int cidx) {
    constexpr int N_ATT = 768, N_RET = 384, N_A = 1024;
    const int n_w = (layer == 0) ? I_IN + I_OUT : 0;
    int* s_item = (int*)(smem + LDS_MAIN + 16);
    for (;;) {
        if (threadIdx.x == 0) *s_item = (int)atomicAdd(p.ctr + cidx, 1u);
        __syncthreads();
        const int it = *s_item;
        __syncthreads();
        if (it >= N_RET + N_ATT + N_A + n_w) break;
        if (it < N_RET) ret_item(p, it, smem);
        else if (it < N_RET + N_ATT) attn_item(p, it - N_RET, smem);
        else if (it < N_RET + N_ATT + N_A) abranch_item(p, layer, it - N_RET - N_ATT, smem);
        else wt_item(p, 1, it - N_RET - N_ATT - N_A, (float*)smem);
        __syncthreads();
    }
}

DI void phase4(const Params& p, int layer, char* smem) {
    const int tid = ltid(), wv = tid >> 6, lane = tid & 63;
    const f32x4* pg = (const f32x4*)(p.post_g + layer * 1024);
    for (int row = (blockIdx.x * 4 + wv) * 2; row < NTOK; row += gridDim.x * 8) {
        f32x4 v[2][4], xv[2][4]; float ss[2] = {0.f, 0.f};
#pragma unroll
        for (int q = 0; q < 2; ++q)
#pragma unroll
            for (int j = 0; j < 2; ++j) { const uint4 ow = ((const uint4*)(p.o + (size_t)(row + q) * 1024))[lane + 64 * j]; v[q][2 * j] = (f32x4){lo_f(ow.x), hi_f(ow.x), lo_f(ow.y), hi_f(ow.y)}; v[q][2 * j + 1] = (f32x4){lo_f(ow.z), hi_f(ow.z), lo_f(ow.w), hi_f(ow.w)};
                if (layer == 0) { xv[q][2 * j] = ((const f32x4*)(p.x + (size_t)(row + q) * 1024))[IDX4(2 * j)]; xv[q][2 * j + 1] = ((const f32x4*)(p.x + (size_t)(row + q) * 1024))[IDX4(2 * j + 1)]; }
                else { const uint4 xw = ((const uint4*)(p.x1b + (size_t)(row + q) * 1024))[lane + 64 * j]; xv[q][2 * j] = (f32x4){lo_f(xw.x), hi_f(xw.x), lo_f(xw.y), hi_f(xw.y)}; xv[q][2 * j + 1] = (f32x4){lo_f(xw.z), hi_f(xw.z), lo_f(xw.w), hi_f(xw.w)}; } }
#pragma unroll
        for (int q = 0; q < 2; ++q)
#pragma unroll
            for (int j = 0; j < 4; ++j) ss[q] += (v[q][j].x * v[q][j].x + v[q][j].y * v[q][j].y) + (v[q][j].z * v[q][j].z + v[q][j].w * v[q][j].w);
#pragma unroll
        for (int o = 1; o < 64; o <<= 1) { ss[0] += __shfl_xor(ss[0], o); ss[1] += __shfl_xor(ss[1], o); }
        float s2[2] = {0.f, 0.f};
#pragma unroll
        for (int q = 0; q < 2; ++q) {
            const float rstd = rsqrtf(ss[q] * (1.f / 1024.f) + EPS);
#pragma unroll
            for (int j = 0; j < 4; ++j) {
                const f32x4 g = pg[IDX4(j)];
                v[q][j] = xv[q][j] + v[q][j] * rstd * g;
                if (layer != 0) ((f32x4*)(p.out + (size_t)(row + q) * 1024))[IDX4(j)] = v[q][j];
                s2[q] += (v[q][j].x * v[q][j].x + v[q][j].y * v[q][j].y) + (v[q][j].z * v[q][j].z + v[q][j].w * v[q][j].w);
            }
        }
        if (layer == 0) {
#pragma unroll
            for (int o = 1; o < 64; o <<= 1) { s2[0] += __shfl_xor(s2[0], o); s2[1] += __shfl_xor(s2[1], o); }
#pragma unroll
            for (int q = 0; q < 2; ++q) {
                if (lane == 0) p.rs[row + q] = rsqrtf(s2[q] * (1.f / 1024.f) + EPS);
#pragma unroll
                for (int j = 0; j < 2; ++j) {
                    const f32x4 va = v[q][2 * j], vb = v[q][2 * j + 1];
                    uint4 xw; xw.x = pk2(va.x, va.y); xw.y = pk2(va.z, va.w); xw.z = pk2(vb.x, vb.y); xw.w = pk2(vb.z, vb.w);
                    ((uint4*)(p.x1b + (size_t)(row + q) * 1024))[lane + 64 * j] = xw;
                }
            }
        }
    }
}

template <int PH>
__global__ void __launch_bounds__(NTHREADS, 2) __attribute__((amdgpu_waves_per_eu(2, 2))) k_phase(Params p, int layer) {
    extern __shared__ __attribute__((aligned(16))) char smem[];
    if (PH == 0) phase0(p, smem);
    else if (PH == 1) gemm_phase<0>(p, layer, smem);
    else if (PH == 2) phase2a(p, layer, smem);
    else if (PH == 3) phase2b(p, layer, smem, layer);
    else if (PH == 4) gemm_phase<1>(p, layer, smem);
    else phase4(p, layer, smem);
}

#if MEGA
__global__ void __launch_bounds__(NTHREADS, 2) __attribute__((amdgpu_waves_per_eu(2, 2))) k_mega(Params p) {
    extern __shared__ __attribute__((aligned(16))) char smem[];
    cg::grid_group grid = cg::this_grid();
    volatile LAS unsigned* st = (volatile LAS unsigned*)(smem + LDS_MAIN);
    if (threadIdx.x < 2) st[threadIdx.x] = 0u;
    __syncthreads();
    (void)xcd_barrier_post(p.bar, st);
#define XBAR() { XcdBarrier xb_; xb_.bar = p.bar; xb_.x = xb_xcc_id(); xb_.st = (volatile LAS unsigned*)(smem + LDS_MAIN); xcd_barrier(xb_); }
    phase0(p, smem);
    if (p.never) grid.sync();
    XBAR();
    if (PROBE_PH == 10) { for (int i = 0; i < 10; ++i) XBAR(); }
#pragma nounroll
    for (int layer = 0; layer < 2; ++layer) {
        gemm_phase<0>(p, layer, smem);
        XBAR();
        if ((PROBE_PH == 1 && layer == 0) || (PROBE_PH == 11 && layer == 1)) { gemm_phase<0>(p, layer, smem); XBAR(); }
        phase2a(p, layer, smem);
        XBAR();
        if (PROBE_PH == 2 && layer == 0) { phase2a(p, layer, smem); XBAR(); }
        phase2b(p, layer, smem, layer);
        XBAR();
        if (PROBE_PH == 3 && layer == 0) { phase2b(p, layer, smem, 2); XBAR(); }
        gemm_phase<1>(p, layer, smem);
        XBAR();
        if (PROBE_PH == 4 && layer == 0) { gemm_phase<1>(p, layer, smem); XBAR(); }
        phase4(p, layer, smem);
        if (PROBE_PH == 5 && layer == 0) { XBAR(); phase4(p, layer, smem); }
        if (layer == 0) XBAR();
    }
}
#endif

extern "C" void kernel_launch(void* const* d_in, const int* in_sizes, int n_in, void* d_out, int out_size, void* d_ws, size_t ws_size, hipStream_t stream) {
    static int grid_blocks = 0;
    if (grid_blocks == 0) {
        if (ws_size < WS_END) { fprintf(stderr, "kernel_launch: workspace too small: %zu < %zu\n", ws_size, (size_t)WS_END); grid_blocks = -1; return; }
        int dev = 0, cus = 0, per_cu = 0;
        hipGetDevice(&dev);
        hipDeviceGetAttribute(&cus, hipDeviceAttributeMultiprocessorCount, dev);
#if MEGA
        hipFuncSetAttribute((const void*)k_mega, hipFuncAttributeMaxDynamicSharedMemorySize, LDS_BYTES);
        hipOccupancyMaxActiveBlocksPerMultiprocessor(&per_cu, (const void*)k_mega, NTHREADS, LDS_BYTES);
#else
        hipFuncSetAttribute((const void*)k_phase<0>, hipFuncAttributeMaxDynamicSharedMemorySize, LDS_BYTES);
        hipFuncSetAttribute((const void*)k_phase<1>, hipFuncAttributeMaxDynamicSharedMemorySize, LDS_BYTES);
        hipFuncSetAttribute((const void*)k_phase<2>, hipFuncAttributeMaxDynamicSharedMemorySize, LDS_BYTES);
        hipFuncSetAttribute((const void*)k_phase<3>, hipFuncAttributeMaxDynamicSharedMemorySize, LDS_BYTES);
        hipFuncSetAttribute((const void*)k_phase<4>, hipFuncAttributeMaxDynamicSharedMemorySize, LDS_BYTES);
        hipFuncSetAttribute((const void*)k_phase<5>, hipFuncAttributeMaxDynamicSharedMemorySize, LDS_BYTES);
        per_cu = 2;
#endif
        if (per_cu < 1) per_cu = 1;
        if (per_cu > 2) per_cu = 2;
        grid_blocks = cus * per_cu;
    }
    if (grid_blocks < 0) return;
    Params p{};
    p.x = (const float*)d_in[0]; p.pre_g = (const float*)d_in[1]; p.post_g = (const float*)d_in[2]; p.w_in = (const float*)d_in[3];
    p.b_f = (const float*)d_in[4]; p.a_ng = (const float*)d_in[5]; p.a_sw = (const float*)d_in[6]; p.a_sb = (const float*)d_in[7]; p.w_out = (const float*)d_in[8];
    p.out = (float*)d_out;
    char* ws = (char*)d_ws;
    p.ctr = (unsigned*)(ws + WS_CTR);
    p.bar = (unsigned*)(ws + WS_BAR);
    p.WinT = (bf16_t*)(ws + WS_WINT); p.WoutT = (bf16_t*)(ws + WS_WOUTT); p.WsA = (bf16_t*)(ws + WS_WSA);
    p.rope = (float*)(ws + WS_ROPE); p.lf = (float*)(ws + WS_LF); p.cf = (float*)(ws + WS_CF);
    p.vTf = (bf16_t*)(ws + WS_VTF); p.vTr = (bf16_t*)(ws + WS_VTR);
    p.hb = (bf16_t*)(ws + WS_HB); p.y = (bf16_t*)(ws + WS_Y); p.kv = (float*)(ws + WS_KV);
    p.z = (bf16_t*)(ws + WS_Z); p.kn = (float*)(ws + WS_KN); p.rs = (float*)(ws + WS_RS); p.x1b = (bf16_t*)(ws + WS_X1B); p.o = (bf16_t*)(ws + WS_HB);
#if MEGA
    hipMemsetAsync(ws + WS_BAR, 0, XCD_BAR_WORDS * 4, stream);
    void* args[] = {&p};
    hipError_t e = hipLaunchCooperativeKernel((void*)k_mega, dim3(grid_blocks), dim3(NTHREADS), args, LDS_BYTES, stream);
    if (e != hipSuccess) fprintf(stderr, "cooperative launch failed: %s (grid %d)\n", hipGetErrorString(e), grid_blocks);
#else
    const dim3 g(grid_blocks), bl(NTHREADS);
    hipLaunchKernelGGL(k_phase<0>, g, bl, LDS_BYTES, stream, p, 0);
    for (int layer = 0; layer < 2; ++layer) {
        hipLaunchKernelGGL(k_phase<1>, g, bl, LDS_BYTES, stream, p, layer);
        hipLaunchKernelGGL(k_phase<2>, g, bl, LDS_BYTES, stream, p, layer);
        hipLaunchKernelGGL(k_phase<3>, g, bl, LDS_BYTES, stream, p, layer);
        hipLaunchKernelGGL(k_phase<4>, g, bl, LDS_BYTES, stream, p, layer);
        hipLaunchKernelGGL(k_phase<5>, g, bl, LDS_BYTES, stream, p, layer);
    }
#endif
}
```
